# Optimizing an MI355X kernel written in HIP

```python
import math
import jax, jax.numpy as jnp
from jax import lax
import numpy as np

D_MODEL = 2048
BATCH = 8
SEQ = 2048
DEPTH = 2
DEC_BATCH = 32
DEC_SEQ = 64
PAST_LEN = 1024

CHUNK = 64
N_A = DEPTH // 2
N_B = DEPTH - N_A
D_FF = 5632
RET_HEADS = 8
RET_DK = D_MODEL // RET_HEADS
RET_DV = 2 * D_MODEL // RET_HEADS
MLA_HEADS = 16
QK_NOPE = 128
QK_ROPE = 64
QK_HEAD = QK_NOPE + QK_ROPE
V_HEAD = 128
KV_LORA = 512
Q_LORA = 512
Q_BLOCK = 128
ROPE_BASE = 10000.0
EPS = 1e-6
NEG_INF = -1e30

kernel_name = "yoco_retention_mla_macaron_stream_step"

F32 = jnp.float32


def rmsnorm(x, g):
    xf = x.astype(F32)
    y = xf * lax.rsqrt(jnp.mean(xf * xf, axis=-1, keepdims=True) + EPS)
    return (y * g.astype(F32)).astype(x.dtype)


def rope(x, pos):
    half = x.shape[-1] // 2
    inv = jnp.power(ROPE_BASE, -jnp.arange(half, dtype=F32) / half)
    ang = pos.astype(F32)[:, None] * inv[None, :]
    cos = jnp.cos(ang)[:, None, :]
    sin = jnp.sin(ang)[:, None, :]
    x1 = x[..., :half].astype(F32)
    x2 = x[..., half:].astype(F32)
    return jnp.concatenate([x1 * cos - x2 * sin, x1 * sin + x2 * cos], axis=-1).astype(x.dtype)


def swiglu(x, g, w_in, w_out):
    a, b = jnp.split(rmsnorm(x, g) @ w_in, 2, axis=-1)
    return (jax.nn.silu(a) * b) @ w_out


def retention_block(q, k, v, S, log_gamma):
    L = q.shape[2]
    n = jnp.arange(L, dtype=F32)
    diff = n[:, None] - n[None, :]
    lg = log_gamma[:, None, None]
    decay = jnp.where(diff >= 0, jnp.exp(lg * jnp.maximum(diff, 0.0)), 0.0).astype(q.dtype)
    inner = jnp.einsum('bhqd,bhkd->bhqk', q, k) * decay
    cross = jnp.exp(log_gamma[:, None] * (n + 1.0))[:, :, None].astype(q.dtype)
    o = jnp.einsum('bhqk,bhkv->bhqv', inner, v) + cross * jnp.einsum('bhqd,bhdv->bhqv', q, S)
    kdec = jnp.exp(log_gamma[:, None] * (L - 1.0 - n))[:, :, None].astype(q.dtype)
    S_new = jnp.exp(log_gamma * L)[:, None, None].astype(S.dtype) * S + \
        jnp.einsum('bhkd,bhkv->bhdv', k * kdec, v).astype(S.dtype)
    return o, S_new


def retention(xn, pos, state, w_in, gn_gain, w_out, prompt):
    B, T, _ = xn.shape
    hk, hv = RET_HEADS * RET_DK, RET_HEADS * RET_DV
    q, k, v, g = jnp.split(xn @ w_in, [hk, 2 * hk, 2 * hk + hv], axis=-1)
    q = rope(q.reshape(B, T, RET_HEADS, RET_DK), pos) * (RET_DK ** -0.5)
    k = rope(k.reshape(B, T, RET_HEADS, RET_DK), pos)
    v = v.reshape(B, T, RET_HEADS, RET_DV)
    q, k, v = jnp.swapaxes(q, 1, 2), jnp.swapaxes(k, 1, 2), jnp.swapaxes(v, 1, 2)
    log_gamma = jnp.log1p(-jnp.exp2(-5.0 - jnp.arange(RET_HEADS, dtype=F32)))
    if prompt:
        nC = T // CHUNK

        def to_chunks(t):
            return jnp.moveaxis(t.reshape(B, RET_HEADS, nC, CHUNK, t.shape[-1]), 2, 0)

        def step(S, blk):
            qb, kb, vb = blk
            o_b, S = retention_block(qb, kb, vb, S, log_gamma)
            return S, o_b

        S0 = jnp.zeros((B, RET_HEADS, RET_DK, RET_DV), q.dtype)
        S_fin, o = lax.scan(step, S0, (to_chunks(q), to_chunks(k), to_chunks(v)))
        o = jnp.moveaxis(o, 0, 2).reshape(B, RET_HEADS, T, RET_DV)
    else:
        o, S_fin = retention_block(q, k, v, state, log_gamma)
    of = jnp.swapaxes(o, 1, 2).astype(F32)
    mu = jnp.mean(of, axis=-1, keepdims=True)
    var = jnp.mean(jnp.square(of - mu), axis=-1, keepdims=True)
    of = ((of - mu) * lax.rsqrt(var + EPS)).reshape(B, T, hv) * gn_gain.astype(F32)
    y = jax.nn.silu(g) * of.astype(g.dtype)
    return y @ w_out, S_fin


def shared_latent(h, pos, kv_norm, w_dkv, kv_lat_norm):
    ckr = rmsnorm(h, kv_norm) @ w_dkv
    c = rmsnorm(ckr[..., :KV_LORA], kv_lat_norm)
    kr = rope(ckr[..., KV_LORA:][:, :, None, :], pos)[:, :, 0, :]
    return c, kr


def mla_keys_values(c, kr, w_ukv, k_norm):
    B, T, _ = c.shape
    kv = (c @ w_ukv).reshape(B, T, MLA_HEADS, QK_NOPE + V_HEAD)
    k = jnp.concatenate([kv[..., :QK_NOPE],
                         jnp.broadcast_to(kr[:, :, None, :], (B, T, MLA_HEADS, QK_ROPE))], axis=-1)
    return rmsnorm(k, k_norm), kv[..., QK_NOPE:]


def mla_queries(hn, pos, w_dq, q_lat_norm, w_uq, q_norm):
    B, T, _ = hn.shape
    q = (rmsnorm(hn @ w_dq, q_lat_norm) @ w_uq).reshape(B, T, MLA_HEADS, QK_HEAD)
    q = jnp.concatenate([q[..., :QK_NOPE], rope(q[..., QK_NOPE:], pos)], axis=-1)
    return rmsnorm(q, q_norm) * (QK_HEAD ** -0.5)


def attend(q, k, v, mask):
    s = jnp.einsum('bqhd,bkhd->bhqk', q, k).astype(F32)
    if mask is not None:
        s = jnp.where(mask[None, None], s, NEG_INF)
    p = jax.nn.softmax(s, axis=-1).astype(v.dtype)
    return jnp.einsum('bhqk,bkhd->bqhd', p, v)


def prompt_attention(q, k, v):
    B, T, _, _ = q.shape
    nq = T // Q_BLOCK
    kchunk = jnp.arange(T) // CHUNK
    qb = jnp.moveaxis(q.reshape(B, nq, Q_BLOCK, MLA_HEADS, QK_HEAD), 1, 0)
    starts = jnp.arange(nq) * Q_BLOCK

    def one(args):
        qi, s0 = args
        qchunk = (s0 + jnp.arange(Q_BLOCK)) // CHUNK
        return attend(qi, k, v, kchunk[None, :] <= qchunk[:, None])

    o = lax.map(one, (qb, starts))
    return jnp.moveaxis(o, 0, 1).reshape(B, T, MLA_HEADS * V_HEAD)


def run_trunk(x, pos, ret_state, ckv_past, krope_past, prompt, p):
    h = x
    new_ret = []
    c_new = kr_new = k_sh = v_sh = None
    for l in range(DEPTH):
        h = h + 0.5 * swiglu(h, p['ffn1_norm'][l], p['ffn1_w_in'][l], p['ffn1_w_out'][l])
        hn = rmsnorm(h, p['mix_norm'][l])
        if l < N_A:
            o, S = retention(hn, pos, None if prompt else ret_state[l],
                             p['ret_w_in'][l], p['ret_gn_gain'][l], p['ret_w_out'][l], prompt)
            new_ret.append(S)
        else:
            j = l - N_A
            q = mla_queries(hn, pos, p['w_dq'][j], p['q_lat_norm'][j], p['w_uq'][j], p['q_norm'][j])
            if prompt:
                o = prompt_attention(q, k_sh, v_sh)
            else:
                B, T = q.shape[0], q.shape[1]
                o = attend(q, k_sh, v_sh, None).reshape(B, T, MLA_HEADS * V_HEAD)
            o = o @ p['w_o'][j]
        h = h + o
        h = h + 0.5 * swiglu(h, p['ffn2_norm'][l], p['ffn2_w_in'][l], p['ffn2_w_out'][l])
        if l == N_A - 1:
            c_new, kr_new = shared_latent(h, pos, p['kv_norm'], p['w_dkv'], p['kv_lat_norm'])
            if prompt:
                c_all, kr_all = c_new, kr_new
            else:
                c_all = jnp.concatenate([ckv_past.astype(c_new.dtype), c_new], axis=1)
                kr_all = jnp.concatenate([krope_past.astype(kr_new.dtype), kr_new], axis=1)
            k_sh, v_sh = mla_keys_values(c_all, kr_all, p['w_ukv'], p['k_norm'])
    return h, jnp.stack(new_ret), c_new, kr_new


def setup_inputs(seed: int = 0) -> dict:
    key = jax.random.key(seed)
    ks = iter(jax.random.split(key, 40))

    def nrm(shape, scale):
        return jax.random.normal(next(ks), shape, F32) * scale

    def gain(shape):
        return 1.0 + 0.02 * jax.random.normal(next(ks), shape, F32)

    D = D_MODEL
    ret_in = 2 * RET_HEADS * RET_DK + 2 * RET_HEADS * RET_DV
    return {
        "x_prompt": nrm((BATCH, SEQ, D), 1.0),
        "x_sample": nrm((DEC_BATCH, DEC_SEQ, D), 1.0),
        "state_ret": nrm((N_A, DEC_BATCH, RET_HEADS, RET_DK, RET_DV), 1.0),
        "cache_ckv": nrm((DEC_BATCH, PAST_LEN, KV_LORA), 1.0),
        "cache_krope": nrm((DEC_BATCH, PAST_LEN, QK_ROPE), 1.0),
        "ffn1_norm": gain((DEPTH, D)),
        "ffn1_w_in": nrm((DEPTH, D, 2 * D_FF), D ** -0.5),
        "ffn1_w_out": nrm((DEPTH, D_FF, D), D_FF ** -0.5),
        "mix_norm": gain((DEPTH, D)),
        "ffn2_norm": gain((DEPTH, D)),
        "ffn2_w_in": nrm((DEPTH, D, 2 * D_FF), D ** -0.5),
        "ffn2_w_out": nrm((DEPTH, D_FF, D), D_FF ** -0.5),
        "ret_w_in": nrm((N_A, D, ret_in), D ** -0.5),
        "ret_gn_gain": gain((N_A, RET_HEADS * RET_DV)),
        "ret_w_out": nrm((N_A, RET_HEADS * RET_DV, D), (RET_HEADS * RET_DV) ** -0.5),
        "kv_norm": gain((D,)),
        "w_dkv": nrm((D, KV_LORA + QK_ROPE), D ** -0.5),
        "kv_lat_norm": gain((KV_LORA,)),
        "w_ukv": nrm((KV_LORA, MLA_HEADS * (QK_NOPE + V_HEAD)), KV_LORA ** -0.5),
        "k_norm": gain((QK_HEAD,)),
        "w_dq": nrm((N_B, D, Q_LORA), D ** -0.5),
        "q_lat_norm": gain((N_B, Q_LORA)),
        "w_uq": nrm((N_B, Q_LORA, MLA_HEADS * QK_HEAD), Q_LORA ** -0.5),
        "q_norm": gain((N_B, QK_HEAD)),
        "w_o": nrm((N_B, MLA_HEADS * V_HEAD, D), (MLA_HEADS * V_HEAD) ** -0.5),
    }


def reference(x_prompt, x_sample, state_ret, cache_ckv, cache_krope,
              ffn1_norm, ffn1_w_in, ffn1_w_out, mix_norm, ffn2_norm, ffn2_w_in, ffn2_w_out,
              ret_w_in, ret_gn_gain, ret_w_out,
              kv_norm, w_dkv, kv_lat_norm, w_ukv, k_norm,
              w_dq, q_lat_norm, w_uq, q_norm, w_o):
    p = dict(ffn1_norm=ffn1_norm, ffn1_w_in=ffn1_w_in, ffn1_w_out=ffn1_w_out,
             mix_norm=mix_norm, ffn2_norm=ffn2_norm, ffn2_w_in=ffn2_w_in, ffn2_w_out=ffn2_w_out,
             ret_w_in=ret_w_in, ret_gn_gain=ret_gn_gain, ret_w_out=ret_w_out,
             kv_norm=kv_norm, w_dkv=w_dkv, kv_lat_norm=kv_lat_norm, w_ukv=w_ukv, k_norm=k_norm,
             w_dq=w_dq, q_lat_norm=q_lat_norm, w_uq=w_uq, q_norm=q_norm, w_o=w_o)
    pos_prompt = jnp.arange(x_prompt.shape[1])
    past = cache_ckv.shape[1]
    pos_sample = past + jnp.arange(x_sample.shape[1])
    y_prompt, ret_p, ckv_p, kr_p = run_trunk(x_prompt, pos_prompt, None, None, None, True, p)
    y_sample, ret_s, ckv_s, kr_s = run_trunk(x_sample, pos_sample, state_ret, cache_ckv,
                                             cache_krope, False, p)
    return (y_prompt, y_sample, ret_p, ckv_p, kr_p, ret_s, ckv_s, kr_s)
```

```cpp
#include <hip/hip_runtime.h>
#include <cstdio>
#include <cstdint>

#ifndef MK_ONE_LAUNCH
#define MK_ONE_LAUNCH 1
#endif
#ifndef MK_LAST_PHASE
#define MK_LAST_PHASE 1000
#endif

namespace pg8 {
#define PG8_LAS __attribute__((address_space(3)))
typedef unsigned short bf16_t;
typedef short bf16x8 __attribute__((ext_vector_type(8)));
typedef float f32x4 __attribute__((ext_vector_type(4)));
typedef unsigned u32x4 __attribute__((ext_vector_type(4)));
constexpr int BM = 256, BK = 64, HALF = 128, HTB = HALF * BK * 2  , STAGE_BYTES = 8 * HTB, NXCD = 8, WGM = 8;

__host__ __device__ __forceinline__ int lds_byte(int r, int c) { const int st = (r >> 4) * 2 + (c >> 5), rr = r & 15, cc = c & 31, ob = rr * 64 + cc * 2; return st * 1024 + (ob ^ (((ob >> 9) & 1) << 5)); }
__host__ __device__ __forceinline__ void stage_rc(int b, int& R, int& C) { const int st = b / 1024, sb = b % 1024, swz = sb ^ (((sb >> 9) & 1) << 5); R = (st >> 1) * 16 + swz / 64; C = (st & 1) * 32 + (swz % 64) / 2; }
__host__ __device__ __forceinline__ int perm32(int rho) { const int n = rho >> 4, i = rho & 15; return 8 * (i >> 2) + 4 * n + (i & 3); }

struct Unit { int pm, pn; };
struct Gemm { const bf16_t* A; const bf16_t* Bt; int M, N, K, lda; };

struct StaticOrder {
    int nM, nN, nwg, G, c;
    __host__ __device__ void init(int M, int N, int G_, int c_) { nM = M / BM; nN = N / BM; nwg = nM * nN; G = G_; c = c_; }
    __host__ __device__ bool next(int i, Unit& u) const {
        const long L = (long)i * G + c; if (L >= nwg) return false;
        int wgid = (int)L; { const int q = nwg / NXCD, r = nwg % NXCD, xcd = wgid % NXCD, off = wgid / NXCD; wgid = (xcd < r ? xcd * (q + 1) : r * (q + 1) + (xcd - r) * q) + off; }
        const int nig = WGM * nN, gid = wgid / nig, fm = gid * WGM, gsz = (nM - fm) < WGM ? (nM - fm) : WGM;
        u.pm = fm + ((wgid % nig) % gsz); u.pn = (wgid % nig) / gsz; return true;
    }
    __device__ __forceinline__ void a_ready(const Unit&) const {}
    __device__ __forceinline__ void done(const Unit&) const {}
};


template <class Epi, class Sched, bool ALIGN_EPI = false, bool SP2 = false>
__device__ __forceinline__ void gemm_phase(PG8_LAS unsigned char* lds, const Gemm g, const Sched& S, const Epi& E, int tid_) {
    const int tid = tid_, wid = __builtin_amdgcn_readfirstlane(tid >> 6), lane = tid & 63, wr = wid >> 2, wc = wid & 3, fr = lane & 15, fq = lane >> 4;
    const int K = g.K, nt = K / BK, lda = g.lda;
    unsigned voffA[2], voffB[2];
#pragma unroll
    for (int i = 0; i < 2; ++i) { int R, C; stage_rc(tid * 16 + i * 8192, R, C); const int Rb = Epi::PERM ? ((R & ~31) + perm32(R & 31)) : R;
        voffA[i] = (unsigned)(R * lda + C) * 2u; voffB[i] = (unsigned)(Rb * K + C) * 2u; }
    const size_t kstep = (size_t)(BK * 2);
    const size_t hstepA = (size_t)HALF * lda * 2, hstepB = (size_t)HALF * K * 2;
    const size_t tstepA = 2 * hstepA, tstepB = 2 * hstepB;
    const unsigned ldsw = (unsigned)wid * 1024u;
    const int aoff = lds_byte(wr * 64 + fr, fq * 8), boff = lds_byte(wc * 32 + fr, fq * 8);
#define PG8_SA(b, h) (((b) * 2 + (h)) * HTB)
#define PG8_SB(b, h) ((4 + (b) * 2 + (h)) * HTB)
#define PG8_STAGE(bufoff, gbase, voff) do { _Pragma("unroll") for (int _i = 0; _i < 2; ++_i) \
        __builtin_amdgcn_global_load_lds((const unsigned*)((const char*)(gbase) + (voff)[_i]), (PG8_LAS unsigned*)(lds + (bufoff) + ldsw + _i * 8192), 16, 0, 0); } while (0)
#define PG8_LDA(dst, b, h) do { _Pragma("unroll") for (int m = 0; m < 4; ++m) _Pragma("unroll") for (int k = 0; k < 2; ++k) dst[m][k] = *(const PG8_LAS bf16x8*)(lds + PG8_SA(b, h) + aoff + m * 2048 + k * 1024); } while (0)
#define PG8_LDB(dst, b, h) do { _Pragma("unroll") for (int n = 0; n < 2; ++n) _Pragma("unroll") for (int k = 0; k < 2; ++k) dst[n][k] = *(const PG8_LAS bf16x8*)(lds + PG8_SB(b, h) + boff + n * 2048 + k * 1024); } while (0)
#define PG8_MMA(ai, bj, At, Bt) do { __builtin_amdgcn_s_setprio(1); _Pragma("unroll") for (int m = 0; m < 4; ++m) _Pragma("unroll") for (int n = 0; n < 2; ++n) _Pragma("unroll") for (int k = 0; k < 2; ++k) \
        acc[ai][bj][m][n] = __builtin_amdgcn_mfma_f32_16x16x32_bf16(Bt[n][k], At[m][k], acc[ai][bj][m][n], 0, 0, 0); __builtin_amdgcn_s_setprio(0); } while (0)
#define PG8_WAIT_V(n) asm volatile("s_waitcnt vmcnt(" #n ")" ::: "memory")
#define PG8_WAIT_L(n) asm volatile("s_waitcnt lgkmcnt(" #n ")" ::: "memory")
#define PG8_BAR __builtin_amdgcn_s_barrier()
#define PG8_SCHED __builtin_amdgcn_sched_barrier(0)
    Unit cur, nxt; int ui = 0;
    if (!S.next(0, cur)) return;
    f32x4 acc[2][2][4][2];
#pragma unroll
    for (int a = 0; a < 2; ++a)
#pragma unroll
        for (int b = 0; b < 2; ++b)
#pragma unroll
            for (int m = 0; m < 4; ++m)
#pragma unroll
                for (int n = 0; n < 2; ++n) acc[a][b][m][n] = (f32x4){0.f, 0.f, 0.f, 0.f};
    bf16x8 At[4][2], B0[2][2], B1[2][2];
    const char* cA = (const char*)g.A + (size_t)cur.pm * tstepA; const char* cB = (const char*)g.Bt + (size_t)cur.pn * tstepB;
    S.a_ready(cur);
    if constexpr (SP2) {
        PG8_STAGE(PG8_SB(0, 0), cB, voffB); PG8_STAGE(PG8_SB(0, 1), cB + hstepB, voffB); PG8_STAGE(PG8_SA(0, 0), cA, voffA); PG8_STAGE(PG8_SA(0, 1), cA + hstepA, voffA);
        if (wr == 1) PG8_BAR;
        PG8_WAIT_V(2); PG8_BAR;
        PG8_STAGE(PG8_SB(1, 0), cB + kstep, voffB); PG8_STAGE(PG8_SA(1, 0), cA + kstep, voffA); PG8_STAGE(PG8_SB(1, 1), cB + hstepB + kstep, voffB);
        PG8_WAIT_V(6); PG8_BAR;
    } else {
        PG8_STAGE(PG8_SB(0, 0), cB, voffB); PG8_STAGE(PG8_SA(0, 0), cA, voffA); PG8_STAGE(PG8_SB(0, 1), cB + hstepB, voffB); PG8_STAGE(PG8_SA(0, 1), cA + hstepA, voffA);
        if (wr == 1) PG8_BAR;
        PG8_WAIT_V(4); PG8_BAR;
        PG8_STAGE(PG8_SB(1, 0), cB + kstep, voffB); PG8_STAGE(PG8_SA(1, 0), cA + kstep, voffA); PG8_STAGE(PG8_SB(1, 1), cB + hstepB + kstep, voffB);
        PG8_WAIT_V(6); PG8_BAR;
    }
    for (;;) {
        const bool has_next = S.next(ui + 1, nxt);
        const char* nA = has_next ? (const char*)g.A + (size_t)nxt.pm * tstepA : cA; const char* nB = has_next ? (const char*)g.Bt + (size_t)nxt.pn * tstepB : cB;
        for (int t = 0; t < nt; t += 2) {
            const bool last = (t == nt - 2);
            const char* a1 = cA + (size_t)(t + 1) * kstep;
            const char* a2 = last ? nA : cA + (size_t)(t + 2) * kstep; const char* b2 = last ? nB : cB + (size_t)(t + 2) * kstep;
            const char* a3 = a2 + kstep; const char* b3 = b2 + kstep;
            if (last && has_next) S.a_ready(nxt);
            if constexpr (SP2) {
            PG8_LDB(B0, 0, 0); PG8_LDB(B1, 0, 1); PG8_SCHED; PG8_LDA(At, 0, 0); PG8_STAGE(PG8_SA(1, 1), a1 + hstepA, voffA);
            PG8_WAIT_V(8); PG8_WAIT_L(0); PG8_BAR; PG8_MMA(0, 0, At, B0); PG8_MMA(0, 1, At, B1); PG8_BAR; PG8_SCHED;
            PG8_LDA(At, 0, 1); PG8_STAGE(PG8_SB(0, 0), b2, voffB); PG8_STAGE(PG8_SB(0, 1), b2 + hstepB, voffB); PG8_STAGE(PG8_SA(0, 0), a2, voffA);
            PG8_WAIT_V(8); PG8_WAIT_L(0); PG8_BAR; PG8_MMA(1, 0, At, B0); PG8_MMA(1, 1, At, B1); PG8_BAR; PG8_SCHED;
            PG8_LDB(B0, 1, 0); PG8_LDB(B1, 1, 1); PG8_SCHED; PG8_LDA(At, 1, 0); PG8_STAGE(PG8_SA(0, 1), a2 + hstepA, voffA);
            PG8_WAIT_V(8); PG8_WAIT_L(0); PG8_BAR; PG8_MMA(0, 0, At, B0); PG8_MMA(0, 1, At, B1); PG8_BAR; PG8_SCHED;
            PG8_LDA(At, 1, 1); PG8_STAGE(PG8_SB(1, 0), b3, voffB); PG8_STAGE(PG8_SB(1, 1), b3 + hstepB, voffB); PG8_STAGE(PG8_SA(1, 0), a3, voffA);
            PG8_WAIT_V(8); PG8_WAIT_L(0); PG8_BAR; PG8_MMA(1, 0, At, B0); PG8_MMA(1, 1, At, B1); PG8_BAR; PG8_SCHED;
            } else {
            PG8_LDB(B0, 0, 0); PG8_SCHED; PG8_LDA(At, 0, 0); PG8_STAGE(PG8_SA(1, 1), a1 + hstepA, voffA);
            PG8_WAIT_L(8); PG8_BAR; PG8_WAIT_L(0); PG8_MMA(0, 0, At, B0); PG8_BAR; PG8_SCHED;
            PG8_LDB(B1, 0, 1); PG8_STAGE(PG8_SB(0, 0), b2, voffB);
            PG8_BAR; PG8_WAIT_L(0); PG8_MMA(0, 1, At, B1); PG8_BAR;
            PG8_LDA(At, 0, 1); PG8_STAGE(PG8_SA(0, 0), a2, voffA);
            PG8_BAR; PG8_WAIT_L(0); PG8_MMA(1, 0, At, B0); PG8_BAR; PG8_SCHED;
            PG8_STAGE(PG8_SB(0, 1), b2 + hstepB, voffB);
            PG8_WAIT_V(6); PG8_BAR; PG8_MMA(1, 1, At, B1); PG8_BAR;
            PG8_LDB(B0, 1, 0); PG8_SCHED; PG8_LDA(At, 1, 0); PG8_STAGE(PG8_SA(0, 1), a2 + hstepA, voffA);
            PG8_WAIT_L(8); PG8_BAR; PG8_WAIT_L(0); PG8_MMA(0, 0, At, B0); PG8_BAR; PG8_SCHED;
            PG8_LDB(B1, 1, 1); PG8_STAGE(PG8_SB(1, 0), b3, voffB);
            PG8_BAR; PG8_WAIT_L(0); PG8_MMA(0, 1, At, B1); PG8_BAR;
            PG8_LDA(At, 1, 1); PG8_STAGE(PG8_SA(1, 0), a3, voffA);
            PG8_BAR; PG8_WAIT_L(0); PG8_MMA(1, 0, At, B0); PG8_BAR; PG8_SCHED;
            PG8_STAGE(PG8_SB(1, 1), b3 + hstepB, voffB);
            PG8_WAIT_V(6); PG8_BAR; PG8_MMA(1, 1, At, B1); PG8_BAR;
            }
        }
        if constexpr (ALIGN_EPI) { if (wr == 0) PG8_BAR; }
        E(acc, cur, wr, wc, fr, fq);
        if (!has_next) break;
#pragma unroll
        for (int a = 0; a < 2; ++a)
#pragma unroll
            for (int b = 0; b < 2; ++b)
#pragma unroll
                for (int m = 0; m < 4; ++m)
#pragma unroll
                    for (int n = 0; n < 2; ++n) acc[a][b][m][n] = (f32x4){0.f, 0.f, 0.f, 0.f};
        cur = nxt; cA = nA; cB = nB; ++ui;
        if constexpr (ALIGN_EPI) { if (wr == 1) PG8_BAR; }
    }
    PG8_WAIT_V(0);
    if constexpr (!ALIGN_EPI) { if (wr == 0) PG8_BAR; }
    PG8_BAR;
#undef PG8_SA
#undef PG8_SB
#undef PG8_STAGE
#undef PG8_LDA
#undef PG8_LDB
#undef PG8_MMA
#undef PG8_WAIT_V
#undef PG8_WAIT_L
#undef PG8_BAR
#undef PG8_SCHED
}
}
constexpr int DM = 2048, NBP = 8, SEQ = 2048, NBS = 32, DSEQ = 64, PAST = 1024, DFF = 5632;
constexpr int MP = NBP * SEQ, MS = NBS * DSEQ, MT = MP + MS;
constexpr int RH = 8, RDK = 256, RDV = 512, RIN = 2 * RH * RDK + 2 * RH * RDV, RHV = RH * RDV;
constexpr int MH = 16, NOPE = 128, ROPE = 64, QKH = 192, VHD = 128, KVL = 512, QLR = 512, QW = MH * QKH;
constexpr int KVT = PAST + DSEQ, KVROWS = MP + NBS * KVT;
constexpr int DKVP = 768, KVW = MH * (NOPE + VHD);
constexpr float EPS = 1e-6f;

constexpr size_t OUT_YP = 0, OUT_YS = (size_t)MP * DM, OUT_RETP = OUT_YS + (size_t)MS * DM, OUT_CKVP = OUT_RETP + (size_t)NBP * RH * RDK * RDV,
                 OUT_KRP = OUT_CKVP + (size_t)MP * KVL, OUT_RETS = OUT_KRP + (size_t)MP * ROPE, OUT_CKVS = OUT_RETS + (size_t)NBS * RH * RDK * RDV,
                 OUT_KRS = OUT_CKVS + (size_t)MS * KVL, OUT_END = OUT_KRS + (size_t)MS * ROPE;
static_assert(OUT_END == 90308608, "output size");

constexpr size_t MiB = 1u << 20;
constexpr size_t WS_CTL = 0, CTL_ZERO_BYTES = 1 * MiB;
constexpr size_t WS_COSR = 1 * MiB, WS_SINR = 2 * MiB;
constexpr size_t WS_COSM = 3 * MiB, WS_SINM = 3 * MiB + 256 * 1024;
constexpr size_t WS_SSQKR = 3 * MiB + 512 * 1024;
constexpr size_t WS_RS = 4 * MiB;
constexpr size_t WS_SSQP = 8 * MiB;
constexpr size_t WS_KRALL = 21 * MiB;
constexpr size_t WS_CALL = 28 * MiB;
constexpr size_t WS_XN = 78 * MiB;
constexpr size_t WS_SMALL = 150 * MiB;
constexpr size_t WS_QLN = WS_SMALL + 36 * MiB;
constexpr size_t WS_WL1 = 204 * MiB;
constexpr size_t SZ_WIN = (size_t)2 * DFF * DM * 2, SZ_WOUT = (size_t)DM * DFF * 2;
constexpr size_t WS_WIN10 = WS_WL1, WS_WOUT10 = WS_WIN10 + SZ_WIN, WS_WIN11 = WS_WOUT10 + SZ_WOUT, WS_WOUT11 = WS_WIN11 + SZ_WIN;
constexpr size_t WS_WDQ = WS_WOUT11 + SZ_WOUT, WS_WUQ = WS_WDQ + 2 * MiB, WS_WO = WS_WUQ + 3 * MiB, WS_WUKV = WS_WO + 8 * MiB;
constexpr size_t WS_WL0 = WS_WUKV + 4 * MiB;
static_assert(WS_WL0 == 353 * MiB, "ws map");
constexpr size_t WS_WIN00 = WS_WL0, WS_WOUT00 = WS_WIN00 + SZ_WIN, WS_WIN01 = WS_WOUT00 + SZ_WOUT, WS_WOUT01 = WS_WIN01 + SZ_WIN;
constexpr size_t WS_WRIN = WS_WOUT01 + SZ_WOUT, WS_WROUT = WS_WRIN + 48 * MiB, WS_WDKV = WS_WROUT + 16 * MiB;
constexpr size_t WS_Q = WS_WL0, WS_O = WS_WL0 + 108 * MiB;
constexpr size_t WS_BIG = WS_WDKV + 3 * MiB;
static_assert(WS_BIG == 552 * MiB && WS_O + (size_t)MT * DM * 2 <= WS_BIG, "ws map");
constexpr size_t WS_END = WS_BIG + (size_t)MT * RIN * 2;
static_assert(WS_END == 984 * MiB, "ws map");
constexpr int CW_BAR = 4096;

constexpr int RING_OFF = 0, RING_BYTES = 136 * 1024;
constexpr int LDSCTL_OFF = RING_BYTES, MISC_OFF = LDSCTL_OFF + 320;
constexpr int LDS_BYTES = 147456;
constexpr int NWAVES = 8;

#define GAS __attribute__((address_space(1)))
#define LAS __attribute__((address_space(3)))
typedef unsigned short bf16;
typedef unsigned v4u __attribute__((ext_vector_type(4)));
typedef unsigned v2u __attribute__((ext_vector_type(2)));
typedef float f32x4 __attribute__((ext_vector_type(4)));
typedef float f32x16 __attribute__((ext_vector_type(16)));
typedef short bf16x8 __attribute__((ext_vector_type(8)));
typedef short s16x4 __attribute__((ext_vector_type(4)));
typedef GAS unsigned gu32;
#define RLX_AGENT __ATOMIC_RELAXED, __HIP_MEMORY_SCOPE_AGENT
#define LDS_WAIT() asm volatile("s_waitcnt lgkmcnt(0)" ::: "memory")
#define VM_WAIT() asm volatile("s_waitcnt vmcnt(0)" ::: "memory")
typedef float f32x2_t __attribute__((ext_vector_type(2)));
typedef __bf16 bf16x2_t __attribute__((ext_vector_type(2)));
__device__ __forceinline__ unsigned cvtpk(float lo, float hi) { const f32x2_t v = {lo, hi}; const bf16x2_t b = __builtin_convertvector(v, bf16x2_t); return __builtin_bit_cast(unsigned, b); }
__device__ __forceinline__ float bflo(unsigned w) { return __uint_as_float(w << 16); }
__device__ __forceinline__ float bfhi(unsigned w) { return __uint_as_float(w & 0xffff0000u); }
__device__ __forceinline__ float shfl_xor_l(float v, int o, int lane) { return __int_as_float(__builtin_amdgcn_ds_bpermute((lane ^ o) << 2, __float_as_int(v))); }
__device__ __forceinline__ float wave_sum(float v, int lane) {
#pragma unroll
    for (int o = 1; o < 64; o <<= 1) v += shfl_xor_l(v, o, lane);
    return v;
}
__device__ __forceinline__ float silu_f(float a) { return a * __builtin_amdgcn_rcpf(1.0f + __builtin_amdgcn_exp2f(-1.4426950408889634f * a)); }
__device__ __forceinline__ float lg2gamma(int h) {
    return h == 0 ? -0.04580368961312479f : h == 1 ? -0.02272007650008353f : h == 2 ? -0.011315313227834146f : h == 3 ? -0.005646563141142063f :
           h == 4 ? -0.0028205190623786626f : h == 5 ? -0.0014095702546713536f : h == 6 ? -0.0007046129765893727f : -0.0003522634716290214f;
}

#define XB_TMO      128
#define XB_XCNT(j)  (256  + 64 * (j))
#define XB_XSUB(j)  (1280 + 64 * (j))
#define XB_XGEN(j)  (2304 + 64 * (j))
#define XB_TOP      3328
#define XB_TOPGEN   3392
#define XCD_BAR_WORDS 3456
#define XB_SPIN_CAP (1u << 18)

__device__ __forceinline__ unsigned xb_ld(unsigned* p)              { return __hip_atomic_load(p, __ATOMIC_RELAXED, __HIP_MEMORY_SCOPE_AGENT); }
__device__ __forceinline__ unsigned xb_add(unsigned* p, unsigned v) { return __hip_atomic_fetch_add(p, v, __ATOMIC_RELAXED, __HIP_MEMORY_SCOPE_AGENT); }
__device__ __forceinline__ unsigned xb_xcc_id() { return (unsigned)__builtin_amdgcn_s_getreg((3 << 11) | 20) & 0xFu; }
#define XB_SPIN(cond, bar) do { unsigned _sp = 0; while (cond) { __builtin_amdgcn_s_sleep(1); \
    if ((++_sp & 255u) == 0u) { if (xb_ld(&(bar)[XB_TMO])) break; if (_sp > XB_SPIN_CAP) { atomicAdd(&(bar)[XB_TMO], 1u); break; } } } } while (0)

struct XcdBarrier {
    unsigned* bar; unsigned x;
    volatile LAS unsigned* st;
};
__device__ __forceinline__ XcdBarrier xcd_barrier_post(unsigned* bar, volatile LAS unsigned* st) {
    XcdBarrier b; b.bar = bar; b.x = xb_xcc_id(); b.st = st;
    if (threadIdx.x == 0) (void)xb_add(&bar[XB_XCNT(b.x)], 1u);
    return b;
}
__device__ __forceinline__ void xcd_barrier_complete(unsigned* bar, unsigned x, unsigned& nloc, unsigned& nx) {
    const unsigned G = gridDim.x * gridDim.y * gridDim.z;
    unsigned sum, cnt, mine, sp = 0u;
    for (;;) {
        sum = 0u; cnt = 0u; mine = 0u;
#pragma unroll
        for (unsigned j = 0; j < 16; ++j) { const unsigned c = xb_ld(&bar[XB_XCNT(j)]); sum += c; cnt += (c > 0u) ? 1u : 0u; mine = (j == x) ? c : mine; }
        if (sum == G) break;
        __builtin_amdgcn_s_sleep(1);
        if ((++sp & 255u) == 0u) { if (xb_ld(&bar[XB_TMO])) break; if (sp > XB_SPIN_CAP) { atomicAdd(&bar[XB_TMO], 1u); break; } }
    }
    nloc = mine > 0u ? mine : 1u; nx = cnt > 0u ? cnt : 1u;
}
__device__ __forceinline__ void xcd_barrier(const XcdBarrier& b) {
    asm volatile("s_waitcnt vmcnt(0)" ::: "memory");
    __syncthreads();
    if (threadIdx.x == 0) {
        unsigned* bar = b.bar;
        __builtin_amdgcn_s_waitcnt(0);
        unsigned nloc = b.st[0], nx = b.st[1];
        if (nloc == 0u) { xcd_barrier_complete(bar, b.x, nloc, nx); b.st[0] = nloc; b.st[1] = nx; }
        const unsigned old = xb_add(&bar[XB_XSUB(b.x)], 1u);
        const unsigned gen = old / nloc;
        if (old + 1u == (gen + 1u) * nloc) {
            __builtin_amdgcn_fence(__ATOMIC_RELEASE, "agent");
            asm volatile("s_waitcnt vmcnt(0)" ::: "memory");
            const unsigned og = xb_add(&bar[XB_TOP], 1u);
            const unsigned tg = og / nx;
            if (og + 1u == (tg + 1u) * nx) xb_add(&bar[XB_TOPGEN], 1u);
            else XB_SPIN(xb_ld(&bar[XB_TOPGEN]) == tg, bar);
            __builtin_amdgcn_fence(__ATOMIC_ACQUIRE, "agent");
            xb_add(&bar[XB_XGEN(b.x)], 1u);
            asm volatile("s_waitcnt vmcnt(0)" ::: "memory");
        } else {
            XB_SPIN(xb_ld(&bar[XB_XGEN(b.x)]) == gen, bar);
            __builtin_amdgcn_fence(__ATOMIC_ACQUIRE, "agent");
            asm volatile("s_waitcnt vmcnt(0)" ::: "memory");
        }
    }
    __syncthreads();
}

using pg8::Unit; using pg8::HALF; using pg8::BM;
struct EpiSwiGLU {
    static constexpr bool PERM = true;
    bf16* O; int ldc;
    __device__ __forceinline__ void operator()(const f32x4 (&acc)[2][2][4][2], const Unit& u, int wr, int wc, int fr, int fq) const {
        const int row0 = u.pm * BM + wr * 64 + fr, col0 = u.pn * HALF + wc * 32 + 8 * fq;
#pragma unroll
        for (int ai = 0; ai < 2; ++ai)
#pragma unroll
            for (int m = 0; m < 4; ++m) {
                bf16* rowp = O + (size_t)(row0 + ai * HALF + m * 16) * ldc + col0;
                const f32x4 a0 = acc[ai][0][m][0], a1 = acc[ai][0][m][1], b0 = acc[ai][1][m][0], b1 = acc[ai][1][m][1];
                v4u w;
                w.x = cvtpk(silu_f(a0[0]) * b0[0], silu_f(a0[1]) * b0[1]); w.y = cvtpk(silu_f(a0[2]) * b0[2], silu_f(a0[3]) * b0[3]);
                w.z = cvtpk(silu_f(a1[0]) * b1[0], silu_f(a1[1]) * b1[1]); w.w = cvtpk(silu_f(a1[2]) * b1[2], silu_f(a1[3]) * b1[3]);
                *(GAS v4u*)rowp = w; }
    }
};
struct EpiResid {
    static constexpr bool PERM = false;
    float* H; int ldc; float scale;
    __device__ __forceinline__ void operator()(const f32x4 (&acc)[2][2][4][2], const Unit& u, int wr, int wc, int fr, int fq) const {
        const int row0 = u.pm * BM + wr * 64 + fr, col0 = u.pn * BM + wc * 32 + 4 * fq;
#pragma unroll
        for (int ai = 0; ai < 2; ++ai)
#pragma unroll
            for (int m = 0; m < 4; ++m) {
                float* rowp = H + (size_t)(row0 + ai * HALF + m * 16) * ldc + col0;
                f32x4 h[2][2];
#pragma unroll
                for (int bj = 0; bj < 2; ++bj)
#pragma unroll
                    for (int n = 0; n < 2; ++n) h[bj][n] = *(const GAS f32x4*)(rowp + bj * HALF + n * 16);
#pragma unroll
                for (int bj = 0; bj < 2; ++bj)
#pragma unroll
                    for (int n = 0; n < 2; ++n) *(GAS f32x4*)(rowp + bj * HALF + n * 16) = h[bj][n] + scale * acc[ai][bj][m][n];
                asm volatile("" ::: "memory"); }
    }
};
struct EpiF32 {
    static constexpr bool PERM = false;
    float* C; int ldc;
    __device__ __forceinline__ void operator()(const f32x4 (&acc)[2][2][4][2], const Unit& u, int wr, int wc, int fr, int fq) const {
        const int row0 = u.pm * BM + wr * 64 + fr, col0 = u.pn * BM + wc * 32 + 4 * fq;
#pragma unroll
        for (int ai = 0; ai < 2; ++ai)
#pragma unroll
            for (int m = 0; m < 4; ++m) { float* rowp = C + (size_t)(row0 + ai * HALF + m * 16) * ldc + col0;
#pragma unroll
                for (int bj = 0; bj < 2; ++bj)
#pragma unroll
                    for (int n = 0; n < 2; ++n) *(GAS f32x4*)(rowp + bj * HALF + n * 16) = acc[ai][bj][m][n]; }
    }
};
struct EpiBf16 {
    static constexpr bool PERM = true;
    bf16* O; int ldc;
    __device__ __forceinline__ void operator()(const f32x4 (&acc)[2][2][4][2], const Unit& u, int wr, int wc, int fr, int fq) const {
        const int row0 = u.pm * BM + wr * 64 + fr, col0 = u.pn * BM + wc * 32 + 8 * fq;
#pragma unroll
        for (int ai = 0; ai < 2; ++ai)
#pragma unroll
            for (int m = 0; m < 4; ++m) { bf16* rowp = O + (size_t)(row0 + ai * HALF + m * 16) * ldc + col0;
#pragma unroll
                for (int bj = 0; bj < 2; ++bj) { const f32x4 v0 = acc[ai][bj][m][0], v1 = acc[ai][bj][m][1];
                    v4u w; w.x = cvtpk(v0[0], v0[1]); w.y = cvtpk(v0[2], v0[3]); w.z = cvtpk(v1[0], v1[1]); w.w = cvtpk(v1[2], v1[3]);
                    *(GAS v4u*)(rowp + bj * HALF) = w; } }
    }
};
struct EpiKV {
    static constexpr bool PERM = true;
    bf16* O; int ldc; float* ssqp;
    __device__ __forceinline__ void operator()(const f32x4 (&acc)[2][2][4][2], const Unit& u, int wr, int wc, int fr, int fq) const {
        const int row0 = u.pm * BM + wr * 64 + fr, col0 = u.pn * BM + wc * 32 + 8 * fq;
#pragma unroll
        for (int ai = 0; ai < 2; ++ai)
#pragma unroll
            for (int m = 0; m < 4; ++m) { const int row = row0 + ai * HALF + m * 16; bf16* rowp = O + (size_t)row * ldc + col0;
#pragma unroll
                for (int bj = 0; bj < 2; ++bj) { const f32x4 v0 = acc[ai][bj][m][0], v1 = acc[ai][bj][m][1];
                    v4u w; w.x = cvtpk(v0[0], v0[1]); w.y = cvtpk(v0[2], v0[3]); w.z = cvtpk(v1[0], v1[1]); w.w = cvtpk(v1[2], v1[3]);
                    *(GAS v4u*)(rowp + bj * HALF) = w; }
                const f32x4 k0 = acc[ai][0][m][0], k1 = acc[ai][0][m][1];
                float s = (k0[0] * k0[0] + k0[1] * k0[1]) + (k0[2] * k0[2] + k0[3] * k0[3]) + (k1[0] * k1[0] + k1[1] * k1[1]) + (k1[2] * k1[2] + k1[3] * k1[3]);
                { const int ln_ = fq * 16 + fr; s += shfl_xor_l(s, 16, ln_); s += shfl_xor_l(s, 32, ln_); }
                if (fq == 0) ssqp[((size_t)row * 16 + u.pn) * 4 + wc] = s; }
    }
};
struct EpiRet {
    static constexpr bool PERM = true;
    bf16* O; int ldc; const float* cosT; const float* sinT;
    __device__ __forceinline__ void operator()(const f32x4 (&acc)[2][2][4][2], const Unit& u, int wr, int wc, int fr, int fq) const {
        const int row0 = u.pm * BM + wr * 64 + fr, col0 = u.pn * BM + wc * 32 + 8 * fq, j0 = wc * 32 + 8 * fq;
        if (u.pn < 16) {
            const int h = u.pn & 7; const bool isq = u.pn < 8; const float lg = lg2gamma(h);
#pragma unroll
            for (int ai = 0; ai < 2; ++ai)
#pragma unroll
                for (int m = 0; m < 4; ++m) { const int row = row0 + ai * HALF + m * 16; bf16* rowp = O + (size_t)row * ldc + col0;
                    const int pos = row < MP ? (row & (SEQ - 1)) : PAST + (row & (DSEQ - 1)); const float e = (float)((row & 63) + 1) * lg;
                    const float fac = isq ? __builtin_amdgcn_exp2f(e) * 0.0625f : __builtin_amdgcn_exp2f(-e);
                    const f32x4 c0 = *(const GAS f32x4*)(cosT + pos * 128 + j0), c1 = *(const GAS f32x4*)(cosT + pos * 128 + j0 + 4);
                    const f32x4 s0 = *(const GAS f32x4*)(sinT + pos * 128 + j0), s1 = *(const GAS f32x4*)(sinT + pos * 128 + j0 + 4);
                    const f32x4 x10 = acc[ai][0][m][0], x11 = acc[ai][0][m][1], x20 = acc[ai][1][m][0], x21 = acc[ai][1][m][1];
                    const f32x4 a0 = (x10 * c0 - x20 * s0) * fac, a1 = (x11 * c1 - x21 * s1) * fac, b0 = (x10 * s0 + x20 * c0) * fac, b1 = (x11 * s1 + x21 * c1) * fac;
                    v4u w; w.x = cvtpk(a0[0], a0[1]); w.y = cvtpk(a0[2], a0[3]); w.z = cvtpk(a1[0], a1[1]); w.w = cvtpk(a1[2], a1[3]);
                    *(GAS v4u*)rowp = w;
                    w.x = cvtpk(b0[0], b0[1]); w.y = cvtpk(b0[2], b0[3]); w.z = cvtpk(b1[0], b1[1]); w.w = cvtpk(b1[2], b1[3]);
                    *(GAS v4u*)(rowp + HALF) = w;
                    asm volatile("" ::: "memory"); }
        } else {
            const bool isg = u.pn >= 32;
#pragma unroll
            for (int ai = 0; ai < 2; ++ai)
#pragma unroll
                for (int m = 0; m < 4; ++m) { bf16* rowp = O + (size_t)(row0 + ai * HALF + m * 16) * ldc + col0;
#pragma unroll
                    for (int bj = 0; bj < 2; ++bj) { f32x4 v0 = acc[ai][bj][m][0], v1 = acc[ai][bj][m][1];
                        if (isg) {
#pragma unroll
                            for (int i = 0; i < 4; ++i) { v0[i] = silu_f(v0[i]); v1[i] = silu_f(v1[i]); } }
                        v4u w; w.x = cvtpk(v0[0], v0[1]); w.y = cvtpk(v0[2], v0[3]); w.z = cvtpk(v1[0], v1[1]); w.w = cvtpk(v1[2], v1[3]);
                        *(GAS v4u*)(rowp + bj * HALF) = w; } }
        }
    }
};
struct Args { const float* in[25]; float* out; unsigned char* ws; int ph_lo, ph_hi; };
enum { I_XP = 0, I_XS, I_STATE, I_CCKV, I_CKR, I_F1N, I_F1IN, I_F1OUT, I_MIXN, I_F2N, I_F2IN, I_F2OUT, I_RIN, I_RGN, I_ROUT, I_KVN, I_WDKV, I_KVLN, I_WUKV, I_KN,
       I_WDQ, I_QLN, I_WUQ, I_QN, I_WO };
struct Frame { LAS unsigned char* lds; int tid, lane, wave, vcu, G; };

__device__ __forceinline__ int dst_row_map(int mode, int n) {
    if (mode == 1) { const int hf = n >= DFF ? 1 : 0; const int nn = n - hf * DFF; return (nn >> 7) * 256 + hf * 128 + (nn & 127); }
    return n;
}
__device__ __forceinline__ void conv_item(const float* W, int K, int N, bf16* WT, int mode, LAS float* scr, int item, int lane) {
    const int nblk = N >> 6, kb = item / nblk, nb = item - kb * nblk, k0 = 64 * kb, n0 = 64 * nb;
    const GAS float* src = (const GAS float*)W + (size_t)k0 * N + n0 + lane;
#pragma unroll 16
    for (int i = 0; i < 64; ++i) scr[i * 65 + lane] = src[(size_t)i * N];
    LDS_WAIT(); asm volatile("" ::: "memory");
    const int c = lane & 7;
#pragma unroll
    for (int j = 0; j < 8; ++j) { const int n = (lane >> 3) + 8 * j; const LAS float* s = scr + (8 * c) * 65 + n;
        v4u o; o.x = cvtpk(s[0 * 65], s[1 * 65]); o.y = cvtpk(s[2 * 65], s[3 * 65]); o.z = cvtpk(s[4 * 65], s[5 * 65]); o.w = cvtpk(s[6 * 65], s[7 * 65]);
        *(GAS v4u*)(WT + (size_t)dst_row_map(mode, n0 + n) * K + k0 + 8 * c) = o; }
    LDS_WAIT(); asm volatile("" ::: "memory");
}
__device__ __forceinline__ void sincos_d(double a, float& s, float& c) {
    const double q = __builtin_rint(a * 0.63661977236758134308);
    double r = __builtin_fma(-q, 1.57079632679489655800e+00, a); r = __builtin_fma(-q, 6.12323399573676603587e-17, r);
    const double r2 = r * r;
    const double sp = r * (1.0 + r2 * (-1.0 / 6 + r2 * (1.0 / 120 + r2 * (-1.0 / 5040 + r2 * (1.0 / 362880 + r2 * (-1.0 / 39916800 + r2 * (1.0 / 6227020800.0)))))));
    const double cp = 1.0 + r2 * (-0.5 + r2 * (1.0 / 24 + r2 * (-1.0 / 720 + r2 * (1.0 / 40320 + r2 * (-1.0 / 3628800 + r2 * (1.0 / 479001600.0))))));
    const int qi = (int)q & 3;
    s = (float)(qi == 0 ? sp : qi == 1 ? cp : qi == 2 ? -sp : -cp);
    c = (float)(qi == 0 ? cp : qi == 1 ? -sp : qi == 2 ? -cp : sp);
}
__device__ __forceinline__ double powi_d(double r, int j) { double o = 1.0, b = r; for (int k = 0; k < 8; ++k) { if (j & (1 << k)) o *= b; b *= b; } return o; }

__device__ __forceinline__ void rms_row_2048(const float* xrow, const float* g, bf16* orow, float* hrow, int lane) {
    const GAS f32x4* xr = (const GAS f32x4*)xrow + lane; const GAS f32x4* gr = (const GAS f32x4*)g + lane;
    f32x4 v[8]; float s = 0.f;
#pragma unroll
    for (int j = 0; j < 8; ++j) { v[j] = xr[64 * j]; s += (v[j].x * v[j].x + v[j].y * v[j].y) + (v[j].z * v[j].z + v[j].w * v[j].w); }
    const float rs = 1.0f / sqrtf(wave_sum(s, lane) * (1.0f / DM) + EPS);
    GAS v2u* o8 = (GAS v2u*)orow + lane;
#pragma unroll
    for (int j = 0; j < 8; ++j) { const f32x4 gg = gr[64 * j]; v2u w; w.x = cvtpk(v[j].x * rs * gg.x, v[j].y * rs * gg.y); w.y = cvtpk(v[j].z * rs * gg.z, v[j].w * rs * gg.w); o8[64 * j] = w; }
    if (hrow) { GAS f32x4* hr = (GAS f32x4*)hrow + lane;
#pragma unroll
        for (int j = 0; j < 8; ++j) hr[64 * j] = v[j]; }
}
__device__ __forceinline__ void norm_phase(const Frame& F, const float* h, const float* g, bf16* xn) {
    const int gw = F.vcu * NWAVES + F.wave, NGW = F.G * NWAVES;
    for (int m = gw; m < MT; m += NGW) rms_row_2048(h + (size_t)m * DM, g, xn + (size_t)m * DM, nullptr, F.lane);
}
__device__ __forceinline__ int kv_row_of_token(int tok) { return tok < MP ? tok : MP + ((tok - MP) >> 6) * KVT + PAST + (tok & 63); }
__device__ __forceinline__ int pos_of_token(int tok) { return tok < MP ? (tok & (SEQ - 1)) : PAST + (tok & (DSEQ - 1)); }

__device__ __forceinline__ void p0_prologue(const Args& A, const Frame& F) {
    unsigned char* ws = A.ws;
    const int gw = F.vcu * NWAVES + F.wave, NGW = F.G * NWAVES;
    LAS float* scr = (LAS float*)(F.lds + RING_OFF + F.wave * 16640);
    int base = 0;
#define CONV(Wp, Kk, Nn, dst, mode) do { const int nitems = ((Kk) >> 6) * ((Nn) >> 6); \
        for (int it = ((gw - base) % NGW + NGW) % NGW; it < nitems; it += NGW) conv_item((Wp), (Kk), (Nn), (bf16*)(ws + (dst)), (mode), scr, it, F.lane); base = (base + nitems) % NGW; } while (0)
    CONV(A.in[I_F1IN], DM, 2 * DFF, WS_WIN00, 1);
    CONV(A.in[I_F1IN] + (size_t)DM * 2 * DFF, DM, 2 * DFF, WS_WIN10, 1);
    CONV(A.in[I_F2IN], DM, 2 * DFF, WS_WIN01, 1);
    CONV(A.in[I_F2IN] + (size_t)DM * 2 * DFF, DM, 2 * DFF, WS_WIN11, 1);
    CONV(A.in[I_F1OUT], DFF, DM, WS_WOUT00, 0);
    CONV(A.in[I_F1OUT] + (size_t)DFF * DM, DFF, DM, WS_WOUT10, 0);
    CONV(A.in[I_F2OUT], DFF, DM, WS_WOUT01, 0);
    CONV(A.in[I_F2OUT] + (size_t)DFF * DM, DFF, DM, WS_WOUT11, 0);
    CONV(A.in[I_RIN], DM, RIN, WS_WRIN, 0);
    CONV(A.in[I_ROUT], RHV, DM, WS_WROUT, 0);
    CONV(A.in[I_WDKV], DM, KVL + ROPE, WS_WDKV, 0);
    CONV(A.in[I_WUKV], KVL, KVW, WS_WUKV, 0);
    CONV(A.in[I_WDQ], DM, QLR, WS_WDQ, 0);
    CONV(A.in[I_WUQ], QLR, QW, WS_WUQ, 0);
    CONV(A.in[I_WO], DM, DM, WS_WO, 0);
#undef CONV
    const int gt = gw * 64 + F.lane, NGT = NGW * 64;
    for (int i = gt; i < (DKVP - KVL - ROPE) * DM / 8; i += NGT) *((GAS v4u*)(ws + WS_WDKV + (size_t)(KVL + ROPE) * DM * 2) + i) = (v4u){0u, 0u, 0u, 0u};
    for (int i = gt; i < 2048 * 128; i += NGT) { const int pos = i >> 7, j = i & 127; float s, c; sincos_d((double)pos * powi_d(0.930572040929699, j), s, c);
        ((GAS float*)(ws + WS_COSR))[i] = c; ((GAS float*)(ws + WS_SINR))[i] = s; }
    for (int i = gt; i < 2048 * 32; i += NGT) { const int pos = i >> 5, j = i & 31; float s, c; sincos_d((double)pos * powi_d(0.7498942093324559, j), s, c);
        ((GAS float*)(ws + WS_COSM))[i] = c; ((GAS float*)(ws + WS_SINM))[i] = s; }
    for (int r = gw; r < NBS * PAST; r += NGW) { const int b = r >> 10, s = r & (PAST - 1), kvrow = MP + b * KVT + s;
        const GAS f32x4* src = (const GAS f32x4*)(A.in[I_CCKV] + (size_t)r * KVL) + 2 * F.lane; const f32x4 a = src[0], bb = src[1];
        v4u w; w.x = cvtpk(a.x, a.y); w.y = cvtpk(a.z, a.w); w.z = cvtpk(bb.x, bb.y); w.w = cvtpk(bb.z, bb.w);
        *((GAS v4u*)(ws + WS_CALL + (size_t)kvrow * KVL * 2) + F.lane) = w;
        const float kr = ((const GAS float*)A.in[I_CKR])[(size_t)r * ROPE + F.lane];
        ((GAS bf16*)(ws + WS_KRALL))[(size_t)kvrow * ROPE + F.lane] = (bf16)(cvtpk(kr, 0.f) & 0xffffu);
        const float q = wave_sum(kr * kr, F.lane); if (F.lane == 0) ((GAS float*)(ws + WS_SSQKR))[kvrow] = q; }
    for (int m = gw; m < MT; m += NGW) { const float* xrow = m < MP ? A.in[I_XP] + (size_t)m * DM : A.in[I_XS] + (size_t)(m - MP) * DM;
        rms_row_2048(xrow, A.in[I_F1N], (bf16*)(ws + WS_XN) + (size_t)m * DM, A.out + (size_t)m * DM, F.lane); }
}

__device__ __forceinline__ void gn_gate_phase(const Args& A, const Frame& F) {
    const int gw = F.vcu * NWAVES + F.wave, NGW = F.G * NWAVES; bf16* QKVG = (bf16*)(A.ws + WS_BIG);
    for (int it = gw; it < MT * RH; it += NGW) { const int tok = it >> 3, h = it & 7;
        bf16* op = QKVG + (size_t)tok * RIN + 4096 + h * RDV + 8 * F.lane;
        const v4u ow = *(const GAS v4u*)op, gwv = *(const GAS v4u*)(op + 4096);
        float x[8] = {bflo(ow.x), bfhi(ow.x), bflo(ow.y), bfhi(ow.y), bflo(ow.z), bfhi(ow.z), bflo(ow.w), bfhi(ow.w)};
        const float sg[8] = {bflo(gwv.x), bfhi(gwv.x), bflo(gwv.y), bfhi(gwv.y), bflo(gwv.z), bfhi(gwv.z), bflo(gwv.w), bfhi(gwv.w)};
        float s = 0.f;
#pragma unroll
        for (int i = 0; i < 8; ++i) s += x[i];
        const float mu = wave_sum(s, F.lane) * (1.0f / RDV); float q = 0.f;
#pragma unroll
        for (int i = 0; i < 8; ++i) { x[i] -= mu; q += x[i] * x[i]; }
        const float rstd = 1.0f / sqrtf(wave_sum(q, F.lane) * (1.0f / RDV) + EPS);
        const GAS f32x4* gp = (const GAS f32x4*)(A.in[I_RGN] + h * RDV + 8 * F.lane); const f32x4 g0 = gp[0], g1 = gp[1];
        const float gg[8] = {g0.x, g0.y, g0.z, g0.w, g1.x, g1.y, g1.z, g1.w};
        float y[8];
#pragma unroll
        for (int i = 0; i < 8; ++i) y[i] = sg[i] * (x[i] * rstd * gg[i]);
        v4u w; w.x = cvtpk(y[0], y[1]); w.y = cvtpk(y[2], y[3]); w.z = cvtpk(y[4], y[5]); w.w = cvtpk(y[6], y[7]);
        *(GAS v4u*)op = w; }
}

__device__ __forceinline__ void latent_phase(const Args& A, const Frame& F) {
    const int gw = F.vcu * NWAVES + F.wave, NGW = F.G * NWAVES; unsigned char* ws = A.ws;
    for (int tok = gw; tok < MT; tok += NGW) {
        const GAS float* row = (const GAS float*)(ws + WS_SMALL) + (size_t)tok * DKVP;
        const f32x4 a = ((const GAS f32x4*)row)[F.lane], b = ((const GAS f32x4*)row)[64 + F.lane];
        const float ss = wave_sum((a.x * a.x + a.y * a.y) + (a.z * a.z + a.w * a.w) + (b.x * b.x + b.y * b.y) + (b.z * b.z + b.w * b.w), F.lane);
        const float rs = 1.0f / sqrtf(ss * (1.0f / KVL) + EPS);
        const f32x4 ga = ((const GAS f32x4*)A.in[I_KVLN])[F.lane], gb = ((const GAS f32x4*)A.in[I_KVLN])[64 + F.lane];
        const f32x4 ca = a * rs * ga, cb = b * rs * gb;
        float* cout = tok < MP ? A.out + OUT_CKVP + (size_t)tok * KVL : A.out + OUT_CKVS + (size_t)(tok - MP) * KVL;
        ((GAS f32x4*)cout)[F.lane] = ca; ((GAS f32x4*)cout)[64 + F.lane] = cb;
        const int kvrow = kv_row_of_token(tok), pos = pos_of_token(tok);
        GAS v2u* cb16 = (GAS v2u*)(ws + WS_CALL + (size_t)kvrow * KVL * 2);
        v2u w; w.x = cvtpk(ca.x, ca.y); w.y = cvtpk(ca.z, ca.w); cb16[F.lane] = w; w.x = cvtpk(cb.x, cb.y); w.y = cvtpk(cb.z, cb.w); cb16[64 + F.lane] = w;
        const int j = F.lane & 31;
        const float x1 = row[KVL + j], x2 = row[KVL + 32 + j];
        const float c = ((const GAS float*)(ws + WS_COSM))[pos * 32 + j], s = ((const GAS float*)(ws + WS_SINM))[pos * 32 + j];
        const float o1 = x1 * c - x2 * s, o2 = x1 * s + x2 * c;
        float* kout = tok < MP ? A.out + OUT_KRP + (size_t)tok * ROPE : A.out + OUT_KRS + (size_t)(tok - MP) * ROPE;
        GAS bf16* kb = (GAS bf16*)(ws + WS_KRALL) + (size_t)kvrow * ROPE;
        if (F.lane < 32) { ((GAS float*)kout)[j] = o1; ((GAS float*)kout)[32 + j] = o2; kb[j] = (bf16)(cvtpk(o1, 0.f) & 0xffffu); kb[32 + j] = (bf16)(cvtpk(o2, 0.f) & 0xffffu); }
        const float q = wave_sum(F.lane < 32 ? (o1 * o1 + o2 * o2) : 0.f, F.lane);
        if (F.lane == 0) ((GAS float*)(ws + WS_SSQKR))[kvrow] = q;
    }
}
__device__ __forceinline__ void qlat_norm_phase(const Args& A, const Frame& F) {
    const int gw = F.vcu * NWAVES + F.wave, NGW = F.G * NWAVES; unsigned char* ws = A.ws;
    for (int tok = gw; tok < MT; tok += NGW) {
        const GAS f32x4* row = (const GAS f32x4*)(ws + WS_SMALL) + (size_t)tok * (QLR / 4);
        const f32x4 a = row[F.lane], b = row[64 + F.lane];
        const float ss = wave_sum((a.x * a.x + a.y * a.y) + (a.z * a.z + a.w * a.w) + (b.x * b.x + b.y * b.y) + (b.z * b.z + b.w * b.w), F.lane);
        const float rs = 1.0f / sqrtf(ss * (1.0f / QLR) + EPS);
        const f32x4 ga = ((const GAS f32x4*)A.in[I_QLN])[F.lane], gb = ((const GAS f32x4*)A.in[I_QLN])[64 + F.lane];
        const f32x4 ca = a * rs * ga, cb = b * rs * gb;
        GAS v2u* o = (GAS v2u*)(ws + WS_QLN + (size_t)tok * QLR * 2);
        v2u w; w.x = cvtpk(ca.x, ca.y); w.y = cvtpk(ca.z, ca.w); o[F.lane] = w; w.x = cvtpk(cb.x, cb.y); w.y = cvtpk(cb.z, cb.w); o[64 + F.lane] = w;
    }
}
__device__ __forceinline__ void qfin_phase(const Args& A, const Frame& F) {
    const int gw = F.vcu * NWAVES + F.wave, NGW = F.G * NWAVES; unsigned char* ws = A.ws;
    const int head = F.lane >> 2, sub = F.lane & 3;
    for (int tok = gw; tok < MT; tok += NGW) {
        bf16* base = (bf16*)(ws + WS_Q) + (size_t)tok * QW + head * QKH;
        v4u nw[4];
#pragma unroll
        for (int i = 0; i < 4; ++i) nw[i] = *(const GAS v4u*)(base + 32 * sub + 8 * i);
        const v4u r1 = *(const GAS v4u*)(base + NOPE + 8 * sub), r2 = *(const GAS v4u*)(base + NOPE + 32 + 8 * sub);
        const int pos = pos_of_token(tok);
        const GAS f32x4* cp = (const GAS f32x4*)((const GAS float*)(ws + WS_COSM) + pos * 32 + 8 * sub); const GAS f32x4* sp = (const GAS f32x4*)((const GAS float*)(ws + WS_SINM) + pos * 32 + 8 * sub);
        const f32x4 c0 = cp[0], c1 = cp[1], s0 = sp[0], s1 = sp[1];
        const float cc[8] = {c0.x, c0.y, c0.z, c0.w, c1.x, c1.y, c1.z, c1.w}, sn[8] = {s0.x, s0.y, s0.z, s0.w, s1.x, s1.y, s1.z, s1.w};
        const float a[8] = {bflo(r1.x), bfhi(r1.x), bflo(r1.y), bfhi(r1.y), bflo(r1.z), bfhi(r1.z), bflo(r1.w), bfhi(r1.w)};
        const float b[8] = {bflo(r2.x), bfhi(r2.x), bflo(r2.y), bfhi(r2.y), bflo(r2.z), bfhi(r2.z), bflo(r2.w), bfhi(r2.w)};
        float ra[8], rb[8], ss = 0.f;
#pragma unroll
        for (int i = 0; i < 8; ++i) { ra[i] = a[i] * cc[i] - b[i] * sn[i]; rb[i] = a[i] * sn[i] + b[i] * cc[i]; ss += ra[i] * ra[i] + rb[i] * rb[i]; }
        float nf[32];
#pragma unroll
        for (int i = 0; i < 4; ++i) { nf[8 * i + 0] = bflo(nw[i].x); nf[8 * i + 1] = bfhi(nw[i].x); nf[8 * i + 2] = bflo(nw[i].y); nf[8 * i + 3] = bfhi(nw[i].y);
            nf[8 * i + 4] = bflo(nw[i].z); nf[8 * i + 5] = bfhi(nw[i].z); nf[8 * i + 6] = bflo(nw[i].w); nf[8 * i + 7] = bfhi(nw[i].w); }
#pragma unroll
        for (int i = 0; i < 32; ++i) ss += nf[i] * nf[i];
        ss += shfl_xor_l(ss, 1, F.lane); ss += shfl_xor_l(ss, 2, F.lane);
        const float rs = (1.0f / sqrtf(ss * (1.0f / QKH) + EPS)) * 0.10411754627697264f;
        const GAS float* gq = (const GAS float*)A.in[I_QN]; const GAS float* gk = (const GAS float*)A.in[I_KN];
#pragma unroll
        for (int i = 0; i < 4; ++i) { float o[8];
#pragma unroll
            for (int e = 0; e < 8; ++e) { const int d = 32 * sub + 8 * i + e; o[e] = nf[8 * i + e] * rs * gq[d] * gk[d]; }
            v4u w; w.x = cvtpk(o[0], o[1]); w.y = cvtpk(o[2], o[3]); w.z = cvtpk(o[4], o[5]); w.w = cvtpk(o[6], o[7]);
            *(GAS v4u*)(base + 32 * sub + 8 * i) = w; }
        { float o[8], p[8];
#pragma unroll
            for (int e = 0; e < 8; ++e) { const int d = NOPE + 8 * sub + e; o[e] = ra[e] * rs * gq[d] * gk[d]; p[e] = rb[e] * rs * gq[d + 32] * gk[d + 32]; }
            v4u w; w.x = cvtpk(o[0], o[1]); w.y = cvtpk(o[2], o[3]); w.z = cvtpk(o[4], o[5]); w.w = cvtpk(o[6], o[7]);
            *(GAS v4u*)(base + NOPE + 8 * sub) = w;
            w.x = cvtpk(p[0], p[1]); w.y = cvtpk(p[2], p[3]); w.z = cvtpk(p[4], p[5]); w.w = cvtpk(p[6], p[7]);
            *(GAS v4u*)(base + NOPE + 32 + 8 * sub) = w; }
    }
    const int gt = gw * 64 + F.lane, NGT = NGW * 64;
    for (int i = gt; i < KVROWS * MH; i += NGT) { const f32x4 p = ((const GAS f32x4*)(ws + WS_SSQP))[i];
        const float s = (p.x + p.y) + (p.z + p.w) + ((const GAS float*)(ws + WS_SSQKR))[i >> 4];
        ((GAS float*)(ws + WS_RS))[i] = 1.0f / sqrtf(s * (1.0f / QKH) + EPS); }
}

constexpr int SC_QS = 264, SC_VS = 136, SC_PS = 72;
constexpr int SC_Q = 0, SC_K = SC_Q + 64 * SC_QS * 2, SC_V = SC_K + 64 * SC_QS * 2, SC_P = SC_V + 64 * SC_VS * 2, SC_END = SC_P + 64 * SC_PS * 2;
static_assert(SC_END <= RING_BYTES, "scan LDS");
__device__ __forceinline__ s16x4 tr16(const LAS unsigned char* p) {
    typedef short v4i16_t __attribute__((ext_vector_type(4)));
    return __builtin_bit_cast(s16x4, __builtin_amdgcn_ds_read_tr16_b64_v4i16((LAS v4i16_t*)p)); }
__device__ __forceinline__ bf16x8 cat4(s16x4 l, s16x4 h) { return (bf16x8){l[0], l[1], l[2], l[3], h[0], h[1], h[2], h[3]}; }

__device__ __forceinline__ void scan_unit(LAS unsigned char* lds, bf16* QKVG, size_t tok0, int nch, int h, int jv, const float* Sin, float* Sout, int tid) {
    const int wid = __builtin_amdgcn_readfirstlane(tid >> 6), lane = tid & 63, fr = lane & 15, fq = lane >> 4;
    f32x4 S[16];
    const int dvcol = jv * 128 + wid * 16 + fr;
    if (Sin) {
#pragma unroll
        for (int T = 0; T < 16; ++T)
#pragma unroll
            for (int i = 0; i < 4; ++i) S[T][i] = ((const GAS float*)Sin)[(size_t)(16 * T + 4 * fq + i) * RDV + dvcol];
    } else {
#pragma unroll
        for (int T = 0; T < 16; ++T) S[T] = (f32x4){0.f, 0.f, 0.f, 0.f};
    }
    const float g64 = __builtin_amdgcn_exp2f(64.0f * lg2gamma(h));
    const GAS bf16* gq = (const GAS bf16*)QKVG + tok0 * RIN + h * RDK;
    const GAS bf16* gk = gq + 2048;
    GAS bf16* gv = (GAS bf16*)QKVG + tok0 * RIN + 4096 + h * RDV + jv * 128;
    bf16x8 pq[4], pk[4], pv[2];
#define SC_LOAD(cc) do { _Pragma("unroll") for (int i = 0; i < 4; ++i) { const int idx = tid + 512 * i, r = idx >> 5, c = idx & 31; \
            pq[i] = *(const GAS bf16x8*)(gq + (size_t)((cc) * 64 + r) * RIN + 8 * c); pk[i] = *(const GAS bf16x8*)(gk + (size_t)((cc) * 64 + r) * RIN + 8 * c); } \
        _Pragma("unroll") for (int i = 0; i < 2; ++i) { const int idx = tid + 512 * i, r = idx >> 4, c = idx & 15; pv[i] = *(const GAS bf16x8*)(gv + (size_t)((cc) * 64 + r) * RIN + 8 * c); } } while (0)
#define SC_WRITE() do { _Pragma("unroll") for (int i = 0; i < 4; ++i) { const int idx = tid + 512 * i, r = idx >> 5, c = idx & 31; \
            *(LAS bf16x8*)(lds + SC_Q + (r * SC_QS + 8 * c) * 2) = pq[i]; *(LAS bf16x8*)(lds + SC_K + (r * SC_QS + 8 * c) * 2) = pk[i]; } \
        _Pragma("unroll") for (int i = 0; i < 2; ++i) { const int idx = tid + 512 * i, r = idx >> 4, c = idx & 15; *(LAS bf16x8*)(lds + SC_V + (r * SC_VS + 8 * c) * 2) = pv[i]; } } while (0)
    SC_LOAD(0);
    const int tq = fr >> 2, tp = fr & 3;
    for (int cc = 0; cc < nch; ++cc) {
        SC_WRITE();
        if (cc + 1 < nch) SC_LOAD(cc + 1);
        __syncthreads();
#pragma unroll
        for (int e = 0; e < 2; ++e) { const int idx = 2 * wid + e, ts = idx >> 2, tt = idx & 3;
            f32x4 a = (f32x4){0.f, 0.f, 0.f, 0.f};
            if (ts <= tt) {
#pragma unroll
                for (int ks = 0; ks < 8; ++ks) { const bf16x8 ak = *(const LAS bf16x8*)(lds + SC_K + ((16 * ts + fr) * SC_QS + 32 * ks + 8 * fq) * 2);
                    const bf16x8 bq = *(const LAS bf16x8*)(lds + SC_Q + ((16 * tt + fr) * SC_QS + 32 * ks + 8 * fq) * 2);
                    a = __builtin_amdgcn_mfma_f32_16x16x32_bf16(ak, bq, a, 0, 0, 0); }
            }
            float v[4];
#pragma unroll
            for (int i = 0; i < 4; ++i) v[i] = (ts < tt || (ts == tt && fr >= 4 * fq + i)) ? a[i] : 0.f;
            v2u w; w.x = cvtpk(v[0], v[1]); w.y = cvtpk(v[2], v[3]);
            *(LAS v2u*)(lds + SC_P + ((16 * tt + fr) * SC_PS + 16 * ts + 4 * fq) * 2) = w; }
        __syncthreads();
#if defined(MK_DEBUG)
        if (cc == 0 && jv == 0) { const int pidx = Sin ? 64 + (int)((tok0 - MP) >> 6) * 8 + h : (int)(tok0 >> 11) * 8 + h;
            *(GAS v4u*)((GAS unsigned char*)QKVG + (size_t)(985 + 24) * 1048576 - (size_t)552 * 1048576 + (size_t)pidx * 8192 + (tid >> 3) * 128 + (tid & 7) * 16) = *(const LAS v4u*)(lds + SC_P + ((tid >> 3) * SC_PS + 8 * (tid & 7)) * 2); }
#endif
        f32x4 O[4];
#pragma unroll
        for (int tt = 0; tt < 4; ++tt) O[tt] = (f32x4){0.f, 0.f, 0.f, 0.f};
#pragma unroll
        for (int ks = 0; ks < 8; ++ks) {
            v4u aw; aw.x = cvtpk(S[2 * ks][0], S[2 * ks][1]); aw.y = cvtpk(S[2 * ks][2], S[2 * ks][3]); aw.z = cvtpk(S[2 * ks + 1][0], S[2 * ks + 1][1]); aw.w = cvtpk(S[2 * ks + 1][2], S[2 * ks + 1][3]);
            const bf16x8 av = __builtin_bit_cast(bf16x8, aw);
#pragma unroll
            for (int tt = 0; tt < 4; ++tt) { const LAS unsigned char* qp = lds + SC_Q + ((16 * tt + fr) * SC_QS + 32 * ks + 4 * fq) * 2;
                const v2u lo = *(const LAS v2u*)qp, hi = *(const LAS v2u*)(qp + 32);
                v4u bw; bw.x = lo.x; bw.y = lo.y; bw.z = hi.x; bw.w = hi.y;
                O[tt] = __builtin_amdgcn_mfma_f32_16x16x32_bf16(av, __builtin_bit_cast(bf16x8, bw), O[tt], 0, 0, 0); } }
        bf16x8 vA[2];
#pragma unroll
        for (int k2 = 0; k2 < 2; ++k2) { const LAS unsigned char* vp = lds + SC_V + ((32 * k2 + 8 * fq + tq) * SC_VS + 16 * wid + 4 * tp) * 2;
            vA[k2] = cat4(tr16(vp), tr16(vp + 4 * SC_VS * 2)); }
#pragma unroll
        for (int tt = 0; tt < 4; ++tt)
#pragma unroll
            for (int k2 = 0; k2 < 2; ++k2) { if (k2 == 1 && tt < 2) continue;
                const bf16x8 bp = *(const LAS bf16x8*)(lds + SC_P + ((16 * tt + fr) * SC_PS + 32 * k2 + 8 * fq) * 2);
                O[tt] = __builtin_amdgcn_mfma_f32_16x16x32_bf16(vA[k2], bp, O[tt], 0, 0, 0); }
#pragma unroll
        for (int tt = 0; tt < 4; ++tt) { v2u w; w.x = cvtpk(O[tt][0], O[tt][1]); w.y = cvtpk(O[tt][2], O[tt][3]);
            *(GAS v2u*)(gv + (size_t)(cc * 64 + 16 * tt + fr) * RIN + 16 * wid + 4 * fq) = w; }
#pragma unroll
        for (int T = 0; T < 16; ++T)
#pragma unroll
            for (int k2 = 0; k2 < 2; ++k2) { const LAS unsigned char* kp = lds + SC_K + ((32 * k2 + 8 * fq + tq) * SC_QS + 16 * T + 4 * tp) * 2;
                const bf16x8 ak = cat4(tr16(kp), tr16(kp + 4 * SC_QS * 2));
                S[T] = __builtin_amdgcn_mfma_f32_16x16x32_bf16(ak, vA[k2], S[T], 0, 0, 0); }
#pragma unroll
        for (int T = 0; T < 16; ++T) S[T] = S[T] * g64;
        __syncthreads();
    }
#undef SC_LOAD
#undef SC_WRITE
#pragma unroll
    for (int T = 0; T < 16; ++T)
#pragma unroll
        for (int i = 0; i < 4; ++i) ((GAS float*)Sout)[(size_t)(16 * T + 4 * fq + i) * RDV + dvcol] = S[T][i];
}
constexpr int AT_VB = 64 * VHD * 2, AT_KNB = 64 * NOPE * 2, AT_KRB = 64 * ROPE * 2;
constexpr int AT_V = 0, AT_KN = AT_V + 2 * AT_VB, AT_KR = AT_KN + 2 * AT_KNB, AT_RS = AT_KR + 2 * AT_KRB, AT_SCR = AT_RS + 2 * 256, AT_END = AT_SCR + NWAVES * 256;
static_assert(AT_END <= RING_BYTES, "attention LDS");
__device__ __forceinline__ int crow(int r, int hi) { return (r & 3) + 8 * (r >> 2) + 4 * hi; }
__device__ __forceinline__ int v_rd_base(int lane) { return ((lane & 3) << 3) | (((lane >> 2) & 3) << 6) | (((lane >> 4) & 1) << 5) | (((lane >> 5) & 1) << 8); }
constexpr int v_rd_off(int d0, int ks, int half) { return d0 * 512 + ks * 4096 + half * 2048; }
template <int OFF> __device__ __forceinline__ s16x4 tr_read(int vb) {
    s16x4 r; asm volatile("ds_read_b64_tr_b16 %0, %1 offset:%2" : "=&v"(r) : "v"(vb), "i"(OFF) : "memory"); return r;
}
template <int D0, int HF> __device__ __forceinline__ void pv_half(f32x16& od, int vb, bf16x8 pa0, bf16x8 pa1) {
    const s16x4 l0 = tr_read<v_rd_off(D0, 2 * HF, 0)>(vb), h0 = tr_read<v_rd_off(D0, 2 * HF, 1)>(vb), l1 = tr_read<v_rd_off(D0, 2 * HF + 1, 0)>(vb), h1 = tr_read<v_rd_off(D0, 2 * HF + 1, 1)>(vb);
    asm volatile("s_waitcnt lgkmcnt(0)" ::: "memory"); __builtin_amdgcn_sched_barrier(0);
    od = __builtin_amdgcn_mfma_f32_32x32x16_bf16(pa0, cat4(l0, h0), od, 0, 0, 0);
    od = __builtin_amdgcn_mfma_f32_32x32x16_bf16(pa1, cat4(l1, h1), od, 0, 0, 0);
}
__device__ __forceinline__ void attn_unit(LAS unsigned char* lds, const bf16* Q, const bf16* KV, const bf16* KR, const float* RSs, bf16* Ob,
                                          int qrow0, int kvrow0, int NT, int h, int nact, int lim0, bool prompt, int tid) {
    const int wid = __builtin_amdgcn_readfirstlane(tid >> 6), lane = tid & 63, r32 = lane & 31, hi = lane >> 5;
    const bool active = wid < nact; const int limit = prompt ? lim0 + (wid >> 1) : lim0;
    LAS float* scrw = (LAS float*)(lds + AT_SCR + wid * 256); LAS float* li_l = scrw; LAS float* al_l = scrw + 32;
    float m_reg = -1e30f, l_reg = 0.f; f32x16 o[4];
#pragma unroll
    for (int d = 0; d < 4; ++d)
#pragma unroll
        for (int r = 0; r < 16; ++r) o[d][r] = 0.f;
    bf16x8 qr[12];
    { const GAS bf16* Qw = (const GAS bf16*)Q + (size_t)(qrow0 + (active ? wid * 32 + r32 : 0)) * QW + h * QKH + hi * 8;
#pragma unroll
      for (int d0 = 0; d0 < 12; ++d0) qr[d0] = *(const GAS bf16x8*)(Qw + d0 * 16); }
    const GAS unsigned char* kvb = (const GAS unsigned char*)KV + ((size_t)kvrow0 * KVW + h * 256) * 2;
    const GAS unsigned char* krb = (const GAS unsigned char*)KR + (size_t)kvrow0 * ROPE * 2;
    unsigned offV[2], offKn[2], offKr;
#pragma unroll
    for (int i = 0; i < 2; ++i) { const int P = (wid + 8 * i) * 64 + lane;
        { const int sub = P >> 5, within = P & 31, kk = ((sub >> 2) << 3) | (within >> 2), k = (kk & ~0xC) | ((kk & 4) << 1) | ((kk & 8) >> 1), c = (sub & 3) * 32 + (within & 3) * 8;
          offV[i] = (unsigned)(k * KVW + NOPE + c) * 2u; }
        { const int r = P >> 4, cpos = P & 15, c = (cpos & 8) | ((cpos & 7) ^ (r & 7)); offKn[i] = (unsigned)(r * KVW + 8 * c) * 2u; } }
    { const int P = wid * 64 + lane, r = P >> 3, cpos = P & 7, c = cpos ^ (r & 7); offKr = (unsigned)(r * ROPE + 8 * c) * 2u; }
    const GAS float* rsp = (const GAS float*)RSs + (size_t)(kvrow0 + lane) * MH + h;
#define AT_DMA(j, b) do { const size_t tk_ = (size_t)(j) * 64 * KVW * 2; \
        _Pragma("unroll") for (int i = 0; i < 2; ++i) { \
            __builtin_amdgcn_global_load_lds((const GAS unsigned*)(kvb + tk_ + offKn[i]), (LAS unsigned*)(lds + AT_KN + (b) * AT_KNB + (wid + 8 * i) * 1024), 16, 0, 0); \
            __builtin_amdgcn_global_load_lds((const GAS unsigned*)(kvb + tk_ + offV[i]), (LAS unsigned*)(lds + AT_V + (b) * AT_VB + (wid + 8 * i) * 1024), 16, 0, 0); } \
        __builtin_amdgcn_global_load_lds((const GAS unsigned*)(krb + (size_t)(j) * 64 * ROPE * 2 + offKr), (LAS unsigned*)(lds + AT_KR + (b) * AT_KRB + wid * 1024), 16, 0, 0); \
        if (wid == 0) __builtin_amdgcn_global_load_lds((const GAS unsigned*)(rsp + (size_t)(j) * 64 * MH), (LAS unsigned*)(lds + AT_RS + (b) * 256), 4, 0, 0); } while (0)
    const int vb0 = (int)(uintptr_t)(lds + AT_V) + v_rd_base(lane);
    AT_DMA(0, 0); asm volatile("s_waitcnt vmcnt(0)" ::: "memory"); __syncthreads();
    for (int j = 0; j < NT; ++j) {
        const int cur = j & 1;
        if (j + 1 < NT) AT_DMA(j + 1, cur ^ 1);
        if (active && j <= limit) {
            const LAS unsigned char* Kn = lds + AT_KN + cur * AT_KNB; const LAS unsigned char* Kr = lds + AT_KR + cur * AT_KRB; const LAS unsigned char* Rt = lds + AT_RS + cur * 256;
            const int vb = vb0 + cur * AT_VB;
#define PK4(P, BASE, OUT) do { unsigned a0 = cvtpk(P[BASE + 0], P[BASE + 1]), a1 = cvtpk(P[BASE + 2], P[BASE + 3]);   \
    unsigned b0_ = cvtpk(P[BASE + 4], P[BASE + 5]), b1_ = cvtpk(P[BASE + 6], P[BASE + 7]);                              \
    auto r0 = __builtin_amdgcn_permlane32_swap(a0, b0_, false, false); auto r1 = __builtin_amdgcn_permlane32_swap(a1, b1_, false, false); \
    v4u w_ = {r0[0], r1[0], r0[1], r1[1]}; OUT = __builtin_bit_cast(bf16x8, w_); } while (0)
#define AT_HALF(HF) do { f32x16 p0; _Pragma("unroll") for (int r = 0; r < 16; ++r) p0[r] = 0.f; \
            const int krow = 32 * HF + r32, ksw = (krow & 7) << 4; \
            _Pragma("unroll") for (int d0 = 0; d0 < 8; ++d0) { const int cb = (d0 * 16 + hi * 8) * 2; \
                const bf16x8 b0 = *(const LAS bf16x8*)(Kn + krow * 256 + (cb ^ ksw)); p0 = __builtin_amdgcn_mfma_f32_32x32x16_bf16(b0, qr[d0], p0, 0, 0, 0); \
                if (d0 == 3) __builtin_amdgcn_sched_barrier(0); } \
            __builtin_amdgcn_sched_barrier(0); \
            _Pragma("unroll") for (int d0 = 0; d0 < 4; ++d0) { const int cb = (d0 * 16 + hi * 8) * 2; \
                const bf16x8 b0 = *(const LAS bf16x8*)(Kr + krow * 128 + (cb ^ ksw)); p0 = __builtin_amdgcn_mfma_f32_32x32x16_bf16(b0, qr[8 + d0], p0, 0, 0, 0); } \
            _Pragma("unroll") for (int g = 0; g < 4; ++g) { const f32x4 rs4 = *(const LAS f32x4*)(Rt + (32 * HF + 8 * g + 4 * hi) * 4); \
                p0[4 * g + 0] *= rs4[0]; p0[4 * g + 1] *= rs4[1]; p0[4 * g + 2] *= rs4[2]; p0[4 * g + 3] *= rs4[3]; } \
            float pmax = p0[0]; _Pragma("unroll") for (int r = 1; r < 16; ++r) pmax = fmaxf(pmax, p0[r]); \
            { auto rr = __builtin_amdgcn_permlane32_swap(__float_as_uint(pmax), __float_as_uint(pmax), false, false); pmax = fmaxf(__uint_as_float(rr[0]), __uint_as_float(rr[1])); } \
            const float mn = fmaxf(m_reg, pmax), alpha = __builtin_amdgcn_exp2f(m_reg - mn); m_reg = mn; \
            float ps = 0.f; _Pragma("unroll") for (int r = 0; r < 16; ++r) { p0[r] = __builtin_amdgcn_exp2f(p0[r] - mn); ps += p0[r]; } \
            { auto rr = __builtin_amdgcn_permlane32_swap(__float_as_uint(ps), __float_as_uint(ps), false, false); ps = __uint_as_float(rr[0]) + __uint_as_float(rr[1]); } \
            l_reg = l_reg * alpha + ps; \
            if (__any(alpha < 1.f)) { if (hi == 0) al_l[r32] = alpha; asm volatile("s_waitcnt lgkmcnt(0)" ::: "memory"); \
                _Pragma("unroll") for (int r = 0; r < 16; ++r) { const float al = al_l[crow(r, hi)]; _Pragma("unroll") for (int d = 0; d < 4; ++d) o[d][r] *= al; } } \
            bf16x8 pa0, pa1; PK4(p0, 0, pa0); PK4(p0, 8, pa1); \
            pv_half<0, HF>(o[0], vb, pa0, pa1); pv_half<1, HF>(o[1], vb, pa0, pa1); pv_half<2, HF>(o[2], vb, pa0, pa1); pv_half<3, HF>(o[3], vb, pa0, pa1); } while (0)
            AT_HALF(0); __builtin_amdgcn_sched_barrier(0); AT_HALF(1);
#undef PK4
#undef AT_HALF
        }
        asm volatile("s_waitcnt vmcnt(0)" ::: "memory");
        __syncthreads();
    }
#undef AT_DMA
    if (active) {
        if (hi == 0) li_l[r32] = l_reg; asm volatile("s_waitcnt lgkmcnt(0)" ::: "memory");
        int r32b = r32; asm volatile("" : "+v"(r32b));
        GAS bf16* Ow = (GAS bf16*)Ob + (size_t)(qrow0 + wid * 32) * DM + h * VHD + r32b;
#pragma unroll
        for (int r = 0; r < 16; ++r) { const int orow = crow(r, hi); const float rl = __builtin_amdgcn_rcpf(li_l[orow]);
#pragma unroll
            for (int d0 = 0; d0 < 4; ++d0) Ow[(size_t)orow * DM + d0 * 32] = (bf16)(cvtpk(o[d0][r] * rl, 0.f) & 0xffffu); }
    }
    __syncthreads();
}
__device__ __forceinline__ void attn_phase(const Args& A, const Frame& F) {
    unsigned char* ws = A.ws;
    const bf16* Q = (const bf16*)(ws + WS_Q); const bf16* KV = (const bf16*)(ws + WS_BIG); const bf16* KR = (const bf16*)(ws + WS_KRALL); const float* RSs = (const float*)(ws + WS_RS);
    bf16* Ob = (bf16*)(ws + WS_O);
    for (int u = blockIdx.x; u < 1024 + 512; u += F.G) {
        int qrow0, kvrow0, NT, h, nact, lim0; bool prompt;
        if (u < 1024) { const int rd = u >> 8, c = u & 255, g = c >> 7, bh = c & 127, b = bh >> 4;
            const int qb = rd == 0 ? 7 - g : rd == 1 ? g : rd == 2 ? 5 - g : 2 + g;
            h = bh & 15; qrow0 = b * SEQ + qb * 256; kvrow0 = b * SEQ; NT = 4 * qb + 4; nact = 8; lim0 = 4 * qb; prompt = true;
        } else { const int v = u - 1024, b = v >> 4; h = v & 15; qrow0 = MP + b * DSEQ; kvrow0 = MP + b * KVT; NT = KVT / 64; nact = 2; lim0 = NT - 1; prompt = false; }
        attn_unit(F.lds, Q, KV, KR, RSs, Ob, qrow0, kvrow0, NT, h, nact, lim0, prompt, F.tid);
    }
}
__device__ __forceinline__ void scan_phase2(const Args& A, const Frame& F) {
    bf16* QKVG = (bf16*)(A.ws + WS_BIG);
    for (int u = blockIdx.x; u < 256 + 1024; u += F.G) {
        const bool pr = u < 256; const int v = pr ? u : u - 256, b = v >> 5, h = (v >> 2) & 7, jv = v & 3;
        const size_t so = (size_t)(b * RH + h) * RDK * RDV;
        scan_unit(F.lds, QKVG, pr ? (size_t)b * SEQ : (size_t)MP + (size_t)b * DSEQ, pr ? SEQ / 64 : 1, h, jv, pr ? nullptr : A.in[I_STATE] + so, A.out + (pr ? OUT_RETP : OUT_RETS) + so, F.tid);
    }
}

#define CAS __attribute__((address_space(4)))
__device__ __forceinline__ Args load_args(const CAS Args* p) { Args a;
#pragma unroll
    for (int i = 0; i < 25; ++i) a.in[i] = p->in[i];
    a.out = p->out; a.ws = p->ws; a.ph_lo = p->ph_lo; a.ph_hi = p->ph_hi; return a; }
__global__ void __launch_bounds__(NWAVES * 64, 2) yoco_fwd(Args args) {
    extern __shared__ __attribute__((aligned(16))) unsigned char lds[];
    Frame F0;
    F0.lds = (LAS unsigned char*)lds;
    const int wave0 = __builtin_amdgcn_readfirstlane((int)threadIdx.x >> 6);
    F0.G = gridDim.x; { const int bx = blockIdx.x; F0.vcu = (F0.G % 8 == 0) ? (bx % 8) * (F0.G / 8) + bx / 8 : bx; }
    unsigned char* ws0 = args.ws;
    for (int u = threadIdx.x; u < (LDS_BYTES - LDSCTL_OFF) / 4; u += NWAVES * 64) ((LAS unsigned*)(F0.lds + LDSCTL_OFF))[u] = 0u;
    __syncthreads();
    XcdBarrier bar; bar.bar = (unsigned*)(ws0 + WS_CTL) + CW_BAR; bar.x = 0; bar.st = nullptr;
#if MK_ONE_LAUNCH
    bar = xcd_barrier_post((unsigned*)(ws0 + WS_CTL) + CW_BAR, (volatile LAS unsigned*)(F0.lds + MISC_OFF) + 8);
#endif
    const int lo = args.ph_lo, hi = args.ph_hi;
    int pc = 0;
#define PH_BEGIN if (pc >= lo && pc < hi) { Frame F; { int t_ = wave0 * 64 + (int)__builtin_amdgcn_mbcnt_hi(~0u, __builtin_amdgcn_mbcnt_lo(~0u, 0u)); asm volatile("" : "+v"(t_)); F.lds = F0.lds; F.tid = t_; F.lane = t_ & 63; F.wave = __builtin_amdgcn_readfirstlane(t_ >> 6); F.G = F0.G; F.vcu = F0.vcu; } \
    const CAS Args* ap_ = (const CAS Args*)__builtin_amdgcn_kernarg_segment_ptr(); asm volatile("" : "+s"(ap_)); const Args args = load_args(ap_); \
    unsigned char* ws = args.ws; float* hres = args.out; \
    bf16* XN = (bf16*)(ws + WS_XN); bf16* HID = (bf16*)(ws + WS_BIG); bf16* QKVG = (bf16*)(ws + WS_BIG); (void)XN; (void)HID; (void)QKVG; (void)hres;
#if MK_ONE_LAUNCH
#define PH_END if (pc + 1 < hi) xcd_barrier(bar); } ++pc;
#else
#define PH_END } ++pc;
#endif
    typedef pg8::StaticOrder SO;

    PH_BEGIN
#ifndef DIS_PRO
 p0_prologue(args, F);
#endif
 PH_END

    for (int l = 0; l < 2; ++l) {
        for (int f = 0; f < 2; ++f) {
            if (l + f > 0) { PH_BEGIN norm_phase(F, hres, (f == 0 ? args.in[I_F1N] : args.in[I_F2N]) + l * DM, XN); PH_END }
            PH_BEGIN {
                const size_t wo = l == 0 ? (f == 0 ? WS_WIN00 : WS_WIN01) : (f == 0 ? WS_WIN10 : WS_WIN11);
                pg8::Gemm g{XN, (const bf16*)(ws + wo), MT, 2 * DFF, DM, DM}; SO S; S.init(MT, 2 * DFF, F.G, (int)blockIdx.x);
                EpiSwiGLU E{HID, DFF};
                pg8::gemm_phase<EpiSwiGLU, SO, true, true>(F.lds + RING_OFF, g, S, E, F.tid); } PH_END
            PH_BEGIN {
                const size_t wo = l == 0 ? (f == 0 ? WS_WOUT00 : WS_WOUT01) : (f == 0 ? WS_WOUT10 : WS_WOUT11);
                pg8::Gemm g{HID, (const bf16*)(ws + wo), MT, DM, DFF, DFF}; SO S; S.init(MT, DM, F.G, (int)blockIdx.x);
                EpiResid E{hres, DM, 0.5f};
                pg8::gemm_phase<EpiResid, SO, true, true>(F.lds + RING_OFF, g, S, E, F.tid); } PH_END
            if (f == 0) {
                PH_BEGIN norm_phase(F, hres, args.in[I_MIXN] + l * DM, XN); PH_END
                if (l == 0) {
                    PH_BEGIN {
                        pg8::Gemm g{XN, (const bf16*)(ws + WS_WRIN), MT, RIN, DM, DM}; SO S; S.init(MT, RIN, F.G, (int)blockIdx.x);
                        EpiRet E{QKVG, RIN, (const float*)(ws + WS_COSR), (const float*)(ws + WS_SINR)};
                        pg8::gemm_phase<EpiRet, SO, true, true>(F.lds + RING_OFF, g, S, E, F.tid); } PH_END
                    PH_BEGIN
#ifndef DIS_SCAN
 scan_phase2(args, F);
#endif
 PH_END
                    PH_BEGIN gn_gate_phase(args, F); PH_END
                    PH_BEGIN {
                        pg8::Gemm g{QKVG + 4096, (const bf16*)(ws + WS_WROUT), MT, DM, RHV, RIN}; SO S; S.init(MT, DM, F.G, (int)blockIdx.x);
                        EpiResid E{hres, DM, 1.0f};
                        pg8::gemm_phase<EpiResid, SO, true, true>(F.lds + RING_OFF, g, S, E, F.tid); } PH_END
                } else {
                    PH_BEGIN {
                        pg8::Gemm g{XN, (const bf16*)(ws + WS_WDQ), MT, QLR, DM, DM}; SO S; S.init(MT, QLR, F.G, (int)blockIdx.x);
                        EpiF32 E{(float*)(ws + WS_SMALL), QLR};
                        pg8::gemm_phase<EpiF32, SO, true, true>(F.lds + RING_OFF, g, S, E, F.tid); } PH_END
                    PH_BEGIN qlat_norm_phase(args, F); PH_END
                    PH_BEGIN {
                        { pg8::Gemm g{(const bf16*)(ws + WS_QLN), (const bf16*)(ws + WS_WUQ), MT, QW, QLR, QLR}; SO S; S.init(MT, QW, F.G, (int)blockIdx.x);
                          EpiBf16 E{(bf16*)(ws + WS_Q), QW};
                          pg8::gemm_phase<EpiBf16, SO, true, true>(F.lds + RING_OFF, g, S, E, F.tid); }
                        { pg8::Gemm g{(const bf16*)(ws + WS_CALL), (const bf16*)(ws + WS_WUKV), KVROWS, KVW, KVL, KVL}; SO S; S.init(KVROWS, KVW, F.G, (int)blockIdx.x);
                          EpiKV E{(bf16*)(ws + WS_BIG), KVW, (float*)(ws + WS_SSQP)};
                          pg8::gemm_phase<EpiKV, SO, true, true>(F.lds + RING_OFF, g, S, E, F.tid); } } PH_END
                    PH_BEGIN
#ifndef DIS_QFIN
 qfin_phase(args, F);
#endif
 PH_END
                    PH_BEGIN
#ifndef DIS_ATTN
 attn_phase(args, F);
#endif
 PH_END
                    PH_BEGIN {
                        pg8::Gemm g{(const bf16*)(ws + WS_O), (const bf16*)(ws + WS_WO), MT, DM, DM, DM}; SO S; S.init(MT, DM, F.G, (int)blockIdx.x);
                        EpiResid E{hres, DM, 1.0f};
                        pg8::gemm_phase<EpiResid, SO, true, true>(F.lds + RING_OFF, g, S, E, F.tid); } PH_END
                }
            }
        }
        if (l == 0) {
            PH_BEGIN norm_phase(F, hres, args.in[I_KVN], XN); PH_END
            PH_BEGIN {
                pg8::Gemm g{XN, (const bf16*)(ws + WS_WDKV), MT, DKVP, DM, DM}; SO S; S.init(MT, DKVP, F.G, (int)blockIdx.x);
                EpiF32 E{(float*)(ws + WS_SMALL), DKVP};
                pg8::gemm_phase<EpiF32, SO, true, true>(F.lds + RING_OFF, g, S, E, F.tid); } PH_END
            PH_BEGIN latent_phase(args, F); PH_END
        }
    }
#undef PH_BEGIN
#undef PH_END
}
constexpr int N_PHASES = 1 + (2 + 1 + 4 + 3 + 3) + (3 + 1 + 6 + 3);

#if defined(MK_DEBUG)
constexpr size_t WS_DBG = 985 * MiB;
constexpr size_t WS_DBG_VS = WS_DBG, WS_DBG_VP = WS_DBG + 16 * MiB, WS_DBG_EY = WS_DBG + 20 * MiB, WS_DBG_H = WS_DBG + 21 * MiB, WS_DBG_Q = WS_DBG + 22 * MiB;
constexpr int DBG_ACC = 8192;
__device__ __forceinline__ float dbf(const bf16* p, size_t i) { return __uint_as_float((unsigned)p[i] << 16); }
__device__ __forceinline__ void dacc(unsigned char* ws, int k, float got, float exp) { float* a = (float*)(ws + WS_CTL) + DBG_ACC; atomicAdd(&a[2 * k], (got - exp) * (got - exp)); atomicAdd(&a[2 * k + 1], exp * exp); }
__device__ __forceinline__ unsigned dhash(unsigned x) { x ^= x >> 16; x *= 0x7feb352dU; x ^= x >> 15; x *= 0x846ca68bU; x ^= x >> 16; return x; }
__device__ __forceinline__ float dsilu(float a) { return a / (1.0f + __builtin_amdgcn_exp2f(-1.4426950408889634f * a)); }
__device__ __forceinline__ void dsincos(int pos, int j, int half, float& sn, float& cs) { const float inv = __builtin_amdgcn_exp2f(-(float)j / (float)half * 13.287712379549449f); sincos_d((double)pos * (double)inv, sn, cs); }
__device__ __forceinline__ int dpos(int tok) { return tok < MP ? (tok & (SEQ - 1)) : PAST + (tok & 63); }
__device__ __forceinline__ float dgamma_lg2(int h) { return lg2gamma(h); }

__global__ void dbg_k0(Args A) { const int s = blockIdx.x * blockDim.x + threadIdx.x; unsigned char* ws = A.ws;
    const int row = dhash(s) % MT, j = dhash(s + 77777) % DFF; const bf16* XN = (const bf16*)(ws + WS_XN); const float* W = A.in[I_F1IN];
    float a = 0.f, b = 0.f; for (int k = 0; k < DM; ++k) { const float x = dbf(XN, (size_t)row * DM + k); a += x * W[(size_t)k * 2 * DFF + j]; b += x * W[(size_t)k * 2 * DFF + DFF + j]; }
    dacc(ws, 12, dbf((const bf16*)(ws + WS_BIG), (size_t)row * DFF + j), dsilu(a) * b); }
__global__ void dbg_k1(Args A) { const int s = blockIdx.x * blockDim.x + threadIdx.x; unsigned char* ws = A.ws;
    const int row = dhash(s) % MT, c = dhash(s + 1234567) % DM; const bf16* HID = (const bf16*)(ws + WS_BIG); const float* W = A.in[I_F1OUT];
    float a = 0.f; for (int k = 0; k < DFF; ++k) a += dbf(HID, (size_t)row * DFF + k) * W[(size_t)k * DM + c];
    const float x = row < MP ? A.in[I_XP][(size_t)row * DM + c] : A.in[I_XS][(size_t)(row - MP) * DM + c];
    dacc(ws, 13, A.out[(size_t)row * DM + c] - x, 0.5f * a); }
__global__ void dbg_k2(Args A) { const int s = blockIdx.x * blockDim.x + threadIdx.x; unsigned char* ws = A.ws;
    const bf16* XN = (const bf16*)(ws + WS_XN); const bf16* QK = (const bf16*)(ws + WS_BIG); const float* W = A.in[I_RIN];
    const int row = dhash(s) % MT, col = dhash(s + 424242) % RIN; float exp;
    if (col < 4096) { const int h = (col >> 8) & 7, d = col & 255, j = d & 127, c1 = (col & ~255) + j, c2 = c1 + 128; float x1 = 0.f, x2 = 0.f;
        for (int k = 0; k < DM; ++k) { const float x = dbf(XN, (size_t)row * DM + k); x1 += x * W[(size_t)k * RIN + c1]; x2 += x * W[(size_t)k * RIN + c2]; }
        float sn, cs; dsincos(dpos(row), j, 128, sn, cs);
        const float r = d < 128 ? x1 * cs - x2 * sn : x1 * sn + x2 * cs; const float e = (float)((row & 63) + 1) * dgamma_lg2(h);
        exp = col < 2048 ? r * __builtin_amdgcn_exp2f(e) * 0.0625f : r * __builtin_amdgcn_exp2f(-e);
    } else { float a = 0.f; for (int k = 0; k < DM; ++k) a += dbf(XN, (size_t)row * DM + k) * W[(size_t)k * RIN + col]; exp = col < 8192 ? a : dsilu(a); }
    dacc(ws, 14, dbf(QK, (size_t)row * RIN + col), exp); }
__global__ void dbg_snapv(Args A) { unsigned char* ws = A.ws; const bf16* QK = (const bf16*)(ws + WS_BIG);
    for (size_t i = (size_t)blockIdx.x * blockDim.x + threadIdx.x; i < (size_t)MS * 4096; i += (size_t)gridDim.x * blockDim.x) { const size_t r = i >> 12, c = i & 4095; ((bf16*)(ws + WS_DBG_VS))[i] = QK[(MP + r) * RIN + 4096 + c]; }
    for (size_t i = (size_t)blockIdx.x * blockDim.x + threadIdx.x; i < (size_t)NBP * 64 * 4096; i += (size_t)gridDim.x * blockDim.x) { const size_t r = i >> 12, c = i & 4095, b = r >> 6, t = r & 63; ((bf16*)(ws + WS_DBG_VP))[i] = QK[(b * SEQ + t) * RIN + 4096 + c]; } }
__global__ void dbg_k3(Args A) { const int s = blockIdx.x * blockDim.x + threadIdx.x; unsigned char* ws = A.ws; const bf16* QK = (const bf16*)(ws + WS_BIG);
    const bool smp = (s & 1) != 0; const int h = dhash(s) & 7, dv = dhash(s + 999) & 511, t = dhash(s + 5555) & 63;
    const int b = smp ? (dhash(s + 31337) & 31) : (dhash(s + 31337) & 7); const size_t tok0 = smp ? (size_t)MP + b * 64 : (size_t)b * SEQ;
    const bf16* V = smp ? (const bf16*)(ws + WS_DBG_VS) + (size_t)b * 64 * 4096 : (const bf16*)(ws + WS_DBG_VP) + (size_t)b * 64 * 4096;
    float o = 0.f;
    for (int sidx = 0; sidx <= t; ++sidx) { float qk = 0.f; for (int d = 0; d < 256; ++d) qk += dbf(QK, (tok0 + t) * RIN + h * 256 + d) * dbf(QK, (tok0 + sidx) * RIN + 2048 + h * 256 + d);
        o += qk * dbf(V, (size_t)sidx * 4096 + h * 512 + dv); }
    if (smp) { const float* S = A.in[I_STATE] + (size_t)(b * RH + h) * RDK * RDV; for (int d = 0; d < 256; ++d) o += dbf(QK, (tok0 + t) * RIN + h * 256 + d) * S[(size_t)d * RDV + dv]; }
    dacc(ws, smp ? 0 : 3, dbf(QK, (tok0 + t) * RIN + 4096 + h * 512 + dv), o);
    if (smp) { const int dk = dhash(s + 2222) & 255; const float* S = A.in[I_STATE] + (size_t)(b * RH + h) * RDK * RDV; float u = S[(size_t)dk * RDV + dv];
        for (int sidx = 0; sidx < 64; ++sidx) u += dbf(QK, (tok0 + sidx) * RIN + 2048 + h * 256 + dk) * dbf(V, (size_t)sidx * 4096 + h * 512 + dv);
        u *= __builtin_amdgcn_exp2f(64.0f * dgamma_lg2(h)); dacc(ws, 1, A.out[OUT_RETS + (size_t)(b * RH + h) * RDK * RDV + (size_t)dk * RDV + dv], u); }
    { const int pidx = smp ? 64 + b * 8 + h : b * 8 + h; const int s2 = dhash(s + 4444) & 63; float qk = 0.f;
      for (int d = 0; d < 256; ++d) qk += dbf(QK, (tok0 + t) * RIN + h * 256 + d) * dbf(QK, (tok0 + s2) * RIN + 2048 + h * 256 + d);
      dacc(ws, 2, dbf((const bf16*)(ws + WS_DBG + 24 * MiB), (size_t)pidx * 4096 + t * 64 + s2), s2 <= t ? qk : 0.f); }
    { float mu = 0.f; for (int d = 0; d < 512; ++d) mu += dbf(QK, (tok0 + t) * RIN + 4096 + h * 512 + d); mu *= (1.0f / 512); float var = 0.f;
      for (int d = 0; d < 512; ++d) { const float x = dbf(QK, (tok0 + t) * RIN + 4096 + h * 512 + d) - mu; var += x * x; } var *= (1.0f / 512);
      const float y = dbf(QK, (tok0 + t) * RIN + 8192 + h * 512 + dv) * ((dbf(QK, (tok0 + t) * RIN + 4096 + h * 512 + dv) - mu) * __builtin_amdgcn_rsqf(var + EPS) * A.in[I_RGN][h * 512 + dv]);
      ((float*)(ws + WS_DBG_EY))[s] = y; } }
__global__ void dbg_k4(Args A) { const int s = blockIdx.x * blockDim.x + threadIdx.x; unsigned char* ws = A.ws; const bf16* QK = (const bf16*)(ws + WS_BIG);
    const bool smp = (s & 1) != 0; const int h = dhash(s) & 7, dv = dhash(s + 999) & 511, t = dhash(s + 5555) & 63;
    const int b = smp ? (dhash(s + 31337) & 31) : (dhash(s + 31337) & 7); const size_t tok0 = smp ? (size_t)MP + b * 64 : (size_t)b * SEQ;
    dacc(ws, 4, dbf(QK, (tok0 + t) * RIN + 4096 + h * 512 + dv), ((const float*)(ws + WS_DBG_EY))[s]);
    const int row = dhash(s + 10101) % MT, c = dhash(s + 20202) % DM; ((float*)(ws + WS_DBG_H))[s] = A.out[(size_t)row * DM + c]; }
__global__ void dbg_k5(Args A) { const int s = blockIdx.x * blockDim.x + threadIdx.x; unsigned char* ws = A.ws; const bf16* QK = (const bf16*)(ws + WS_BIG);
    const int row = dhash(s + 10101) % MT, c = dhash(s + 20202) % DM; const float* W = A.in[I_ROUT]; float a = 0.f;
    for (int k = 0; k < RHV; ++k) a += dbf(QK, (size_t)row * RIN + 4096 + k) * W[(size_t)k * DM + c];
    dacc(ws, 5, A.out[(size_t)row * DM + c] - ((const float*)(ws + WS_DBG_H))[s], a); }
__global__ void dbg_k6(Args A) { const int s = blockIdx.x * blockDim.x + threadIdx.x; unsigned char* ws = A.ws; const bf16* XN = (const bf16*)(ws + WS_XN);
    const float* CKR = (const float*)(ws + WS_SMALL); const int row = dhash(s) % MT, c = dhash(s + 4321) % (KVL + ROPE); const float* W = A.in[I_WDKV];
    float a = 0.f; for (int k = 0; k < DM; ++k) a += dbf(XN, (size_t)row * DM + k) * W[(size_t)k * (KVL + ROPE) + c];
    dacc(ws, 6, CKR[(size_t)row * DKVP + c], a);
    const float* r = CKR + (size_t)row * DKVP; float got, exp;
    if (c < KVL) { float ss = 0.f; for (int k = 0; k < KVL; ++k) ss += r[k] * r[k]; exp = r[c] * __builtin_amdgcn_rsqf(ss / KVL + EPS) * A.in[I_KVLN][c];
        got = row < MP ? A.out[OUT_CKVP + (size_t)row * KVL + c] : A.out[OUT_CKVS + (size_t)(row - MP) * KVL + c];
        const int kvrow = row < MP ? row : MP + ((row - MP) >> 6) * KVT + PAST + (row & 63); dacc(ws, 6, dbf((const bf16*)(ws + WS_CALL), (size_t)kvrow * KVL + c), exp);
    } else { const int j = (c - KVL) & 31; const float x1 = r[KVL + j], x2 = r[KVL + 32 + j]; float sn, cs; dsincos(dpos(row), j, 32, sn, cs);
        exp = (c - KVL) < 32 ? x1 * cs - x2 * sn : x1 * sn + x2 * cs; got = row < MP ? A.out[OUT_KRP + (size_t)row * ROPE + (c - KVL)] : A.out[OUT_KRS + (size_t)(row - MP) * ROPE + (c - KVL)]; }
    dacc(ws, 6, got, exp); }
__global__ void dbg_k7(Args A) { const int s = blockIdx.x * blockDim.x + threadIdx.x; unsigned char* ws = A.ws;
    { const bf16* QLN = (const bf16*)(ws + WS_QLN); const int row = dhash(s) % MT, c = dhash(s + 8888) % QW; const float* W = A.in[I_WUQ]; float a = 0.f;
      for (int k = 0; k < QLR; ++k) a += dbf(QLN, (size_t)row * QLR + k) * W[(size_t)k * QW + c];
      dacc(ws, 7, dbf((const bf16*)(ws + WS_Q), (size_t)row * QW + c), a); }
    { const bf16* CA = (const bf16*)(ws + WS_CALL); const int row = dhash(s + 99) % KVROWS, c = dhash(s + 7777) % KVW; const float* W = A.in[I_WUKV]; float a = 0.f;
      for (int k = 0; k < KVL; ++k) a += dbf(CA, (size_t)row * KVL + k) * W[(size_t)k * KVW + c];
      dacc(ws, 7, dbf((const bf16*)(ws + WS_BIG), (size_t)row * KVW + c), a); }
    { const int row = dhash(s + 606) % MT, hd = dhash(s + 707) & 15; for (int d = 0; d < QKH; ++d) ((bf16*)(ws + WS_DBG_Q))[(size_t)s * QKH + d] = ((const bf16*)(ws + WS_Q))[(size_t)row * QW + hd * QKH + d]; } }
__global__ void dbg_k8(Args A) { const int s = blockIdx.x * blockDim.x + threadIdx.x; unsigned char* ws = A.ws;
    { const int row = dhash(s + 606) % MT, hd = dhash(s + 707) & 15; const bf16* q = (const bf16*)(ws + WS_DBG_Q) + (size_t)s * QKH;
      float ss = 0.f; for (int d = 0; d < QKH; ++d) { float x;
          if (d < NOPE) x = dbf(q, d); else { const int j = (d - NOPE) & 31; const float x1 = dbf(q, NOPE + j), x2 = dbf(q, NOPE + 32 + j); float sn, cs; dsincos(dpos(row), j, 32, sn, cs);
              x = (d - NOPE) < 32 ? x1 * cs - x2 * sn : x1 * sn + x2 * cs; }
          ss += x * x; }
      const float rs = __builtin_amdgcn_rsqf(ss / QKH + EPS); const int d = dhash(s + 808) % QKH; float x;
      if (d < NOPE) x = dbf(q, d); else { const int j = (d - NOPE) & 31; const float x1 = dbf(q, NOPE + j), x2 = dbf(q, NOPE + 32 + j); float sn, cs; dsincos(dpos(row), j, 32, sn, cs);
          x = (d - NOPE) < 32 ? x1 * cs - x2 * sn : x1 * sn + x2 * cs; }
      dacc(ws, 8, dbf((const bf16*)(ws + WS_Q), (size_t)row * QW + hd * QKH + d), x * rs * A.in[I_QN][d] * A.in[I_KN][d] * 0.07216878364870322f * 1.4426950408889634f); }
    { const int row = dhash(s + 99) % KVROWS, hd = dhash(s + 555) & 15; const bf16* KVb = (const bf16*)(ws + WS_BIG); const bf16* KRb = (const bf16*)(ws + WS_KRALL); float ss = 0.f;
      for (int d = 0; d < NOPE; ++d) { const float x = dbf(KVb, (size_t)row * KVW + hd * 256 + d); ss += x * x; } for (int d = 0; d < ROPE; ++d) { const float x = dbf(KRb, (size_t)row * ROPE + d); ss += x * x; }
      dacc(ws, 8, ((const float*)(ws + WS_RS))[(size_t)row * MH + hd], __builtin_amdgcn_rsqf(ss / QKH + EPS)); } }
__global__ void dbg_k9(Args A) { const int s = blockIdx.x * blockDim.x + threadIdx.x; unsigned char* ws = A.ws;
    const bf16* Q = (const bf16*)(ws + WS_Q); const bf16* KVb = (const bf16*)(ws + WS_BIG); const bf16* KRb = (const bf16*)(ws + WS_KRALL); const float* RSs = (const float*)(ws + WS_RS);
    const int row = (s & 1) ? MP + (int)(dhash(s) % MS) : (int)(dhash(s) % MP); const int hd = dhash(s + 1111) & 15, d = dhash(s + 3333) & 127;
    int kv0, nk; if (row < MP) { const int b = row >> 11, t = row & 2047; kv0 = b * SEQ; nk = ((t >> 6) + 1) * 64; } else { const int b = (row - MP) >> 6; kv0 = MP + b * KVT; nk = KVT; }
    float m = -1e30f, l = 0.f, o = 0.f;
    for (int k = 0; k < nk; ++k) { float sc = 0.f; for (int e = 0; e < NOPE; ++e) sc += dbf(Q, (size_t)row * QW + hd * QKH + e) * dbf(KVb, (size_t)(kv0 + k) * KVW + hd * 256 + e);
        for (int e = 0; e < ROPE; ++e) sc += dbf(Q, (size_t)row * QW + hd * QKH + NOPE + e) * dbf(KRb, (size_t)(kv0 + k) * ROPE + e);
        sc *= RSs[(size_t)(kv0 + k) * MH + hd]; const float mn = fmaxf(m, sc), al = __builtin_amdgcn_exp2f(m - mn), p = __builtin_amdgcn_exp2f(sc - mn); l = l * al + p; o = o * al + p * dbf(KVb, (size_t)(kv0 + k) * KVW + hd * 256 + NOPE + d); m = mn; }
    dacc(ws, 9, dbf((const bf16*)(ws + WS_O), (size_t)row * DM + hd * VHD + d), o / l); }
__global__ void dbg_final(Args A) { if (threadIdx.x == 0 && blockIdx.x == 0) { const float* a = (const float*)(A.ws + WS_CTL) + DBG_ACC; unsigned bits = 0;
        for (int k = 0; k < 10; ++k) { const float e = a[2 * k], r = a[2 * k + 1]; if (!(e <= 2e-3f * r) || !(r > 0.f)) bits |= 1u << k; }
        float v = (float)(10 + (bits & 63)); for (unsigned i = 0; i < 2 + (bits >> 6); ++i) v *= 10.f; A.out[0] = v; } }
#endif

extern "C" void kernel_launch(void* const* d_in, const int* in_sizes, int n_in, void* d_out, int out_size, void* d_ws, size_t ws_size, hipStream_t stream) {
    static int grid = 0;
    if (grid == 0) {
        if (n_in != 25 || out_size != (int)OUT_END || ws_size < WS_END) { fprintf(stderr, "kernel_launch: shape mismatch: n_in %d out %d ws %zu (need %zu)\n", n_in, out_size, ws_size, (size_t)WS_END); grid = -1; return; }
        int dev = 0, cus = 0, per_cu = 0;
        if (hipGetDevice(&dev) != hipSuccess || hipDeviceGetAttribute(&cus, hipDeviceAttributeMultiprocessorCount, dev) != hipSuccess) { grid = -1; return; }
        if (hipFuncSetAttribute((const void*)yoco_fwd, hipFuncAttributeMaxDynamicSharedMemorySize, LDS_BYTES) != hipSuccess) { fprintf(stderr, "kernel_launch: hipFuncSetAttribute failed\n"); grid = -1; return; }
        if (hipOccupancyMaxActiveBlocksPerMultiprocessor(&per_cu, (const void*)yoco_fwd, NWAVES * 64, LDS_BYTES) != hipSuccess || per_cu < 1) { fprintf(stderr, "kernel_launch: occupancy query says %d blocks per CU\n", per_cu); (void)hipGetLastError(); grid = -1; return; }
        grid = cus;
    }
    if (grid < 0) return;
    (void)hipMemsetAsync((char*)d_ws + WS_CTL, 0, CTL_ZERO_BYTES, stream);
    Args a{};
    for (int i = 0; i < 25; ++i) a.in[i] = (const float*)d_in[i];
    a.out = (float*)d_out; a.ws = (unsigned char*)d_ws;
    const int last = N_PHASES < MK_LAST_PHASE ? N_PHASES : MK_LAST_PHASE;
#if MK_ONE_LAUNCH
    a.ph_lo = 0; a.ph_hi = last;
    hipLaunchKernelGGL(yoco_fwd, dim3(grid), dim3(NWAVES * 64), LDS_BYTES, stream, a);
#else
    for (int p = 0; p < last; ++p) { a.ph_lo = p; a.ph_hi = p + 1; hipLaunchKernelGGL(yoco_fwd, dim3(grid), dim3(NWAVES * 64), LDS_BYTES, stream, a);
#if defined(MK_DEBUG)
        constexpr int NSB = 16;
        if (p == 1) hipLaunchKernelGGL(dbg_k0, dim3(NSB), dim3(256), 0, stream, a);
        if (p == 2) hipLaunchKernelGGL(dbg_k1, dim3(NSB), dim3(256), 0, stream, a);
        if (p == 4) { hipLaunchKernelGGL(dbg_k2, dim3(NSB), dim3(256), 0, stream, a); hipLaunchKernelGGL(dbg_snapv, dim3(1024), dim3(256), 0, stream, a); }
        if (p == 5) hipLaunchKernelGGL(dbg_k3, dim3(NSB), dim3(256), 0, stream, a);
        if (p == 6) hipLaunchKernelGGL(dbg_k4, dim3(NSB), dim3(256), 0, stream, a);
        if (p == 7) hipLaunchKernelGGL(dbg_k5, dim3(NSB), dim3(256), 0, stream, a);
        if (p == 13) hipLaunchKernelGGL(dbg_k6, dim3(NSB), dim3(256), 0, stream, a);
        if (p == 20) hipLaunchKernelGGL(dbg_k7, dim3(NSB), dim3(256), 0, stream, a);
        if (p == 21) hipLaunchKernelGGL(dbg_k8, dim3(NSB), dim3(256), 0, stream, a);
        if (p == 22) hipLaunchKernelGGL(dbg_k9, dim3(NSB), dim3(256), 0, stream, a);
        if (p == last - 1) hipLaunchKernelGGL(dbg_final, dim3(1), dim3(64), 0, stream, a);
#endif
    }
#endif
    const hipError_t le = hipPeekAtLastError();
    if (le != hipSuccess) fprintf(stderr, "kernel_launch: launch failed: %s\n", hipGetErrorName(le));
}
```

```cpp
#include <hip/hip_runtime.h>
#include <cstdio>
#include <cstdint>

#define MK_BLK 0
#ifndef MK_ONE_LAUNCH
#define MK_ONE_LAUNCH 1
#endif
#ifndef MK_REP
#define MK_REP (-1)
#endif
#ifndef MK_DBLBAR
#define MK_DBLBAR 0
#endif
#ifndef MK_ALIGN_SWIGLU
#define MK_ALIGN_SWIGLU true
#endif
#ifndef MK_WARMMFMA
#define MK_WARMMFMA 0
#endif
#ifndef MK_BLK
#define MK_BLK 1
#endif
#ifndef MK_STAGGER
#define MK_STAGGER 0
#endif
#ifndef MK_ATTN_LAZY
#define MK_ATTN_LAZY 1
#endif
#ifndef MK_ATTN_DELAY
#define MK_ATTN_DELAY 0
#endif
#ifndef MK_SCAN_PF
#define MK_SCAN_PF 0
#endif
#ifndef MK_SCAN_IL
#define MK_SCAN_IL 0
#endif
#ifndef MK_STAGKV
#define MK_STAGKV 0
#endif
#ifndef MK_NFOLD
#define MK_NFOLD 2
#endif
#ifndef MK_CONVUNROLL
#define MK_CONVUNROLL 16
#endif
#ifndef MK_DEFSPLIT0
#define MK_DEFSPLIT0 1000
#define MK_DEFSPLIT1 1000
#define MK_DEFSPLIT2 1000
#define MK_DEFSPLIT3 1000
#define MK_DEFSPLIT4 1000
#endif
#ifndef MK_DEFNT
#define MK_DEFNT 1
#endif
#ifndef MK_DEFUNROLL
#define MK_DEFUNROLL 64
#endif
#ifndef MK_DEFER
#define MK_DEFER 2
#endif
#ifndef MK_TQ
#define MK_TQ 2
#endif
#ifndef MK_HBF
#define MK_HBF 1
#endif
#ifndef MK_SPINEND
#define MK_SPINEND 0
#endif
#ifndef MK_SPINCLK
#define MK_SPINCLK 0
#endif
#ifndef MK_QLFUSE
#define MK_QLFUSE 1
#endif
#ifndef MK_HALFTAIL
#define MK_HALFTAIL 0
#endif
#ifndef MK_QFUSE
#define MK_QFUSE 1
#endif
#ifndef MK_BARWAIT
#define MK_BARWAIT 0
#endif
#ifndef MK_BARMASK
#define MK_BARMASK 0xffffffffu
#endif
#ifndef MK_BARWAIT_BLK
#define MK_BARWAIT_BLK 0
#endif
#ifndef MK_ATTN_PRIO
#define MK_ATTN_PRIO 0
#endif
#ifndef MK_ATTN_DRYMODE
#define MK_ATTN_DRYMODE 0
#endif
#ifndef MK_ATTN_IL
#define MK_ATTN_IL 0
#endif
#ifndef MK_SCRAMBLE
#define MK_SCRAMBLE 0
#endif
#ifndef MK_PRETOUCH
#define MK_PRETOUCH 0
#endif
#ifndef MK_SP2
#define MK_SP2 true
#endif
#ifndef MK_CLKPH
#define MK_CLKPH (-1)
#endif
#ifndef MK_CLKMODE
#define MK_CLKMODE 0
#endif
#ifndef MK_SPINMUL
#define MK_SPINMUL 1
#endif
#ifndef MK_NORM2
#define MK_NORM2 1
#endif
#ifndef MK_SPINMASK
#define MK_SPINMASK 0u
#endif
#ifndef MK_REPMASK
#define MK_REPMASK 0u
#endif
#ifndef MK_REPN
#define MK_REPN 2
#endif
#ifndef MK_LAST_PHASE
#define MK_LAST_PHASE 1000
#endif

namespace pg8 {
#define PG8_LAS __attribute__((address_space(3)))
typedef unsigned short bf16_t;
typedef short bf16x8 __attribute__((ext_vector_type(8)));
typedef float f32x4 __attribute__((ext_vector_type(4)));
typedef unsigned u32x4 __attribute__((ext_vector_type(4)));
constexpr int BM = 256, BK = 64, HALF = 128, HTB = HALF * BK * 2  , STAGE_BYTES = 8 * HTB, NXCD = 8, WGM = 8;

__host__ __device__ __forceinline__ int lds_byte(int r, int c) { const int st = (r >> 4) * 2 + (c >> 5), rr = r & 15, cc = c & 31, ob = rr * 64 + cc * 2; return st * 1024 + (ob ^ (((ob >> 9) & 1) << 5)); }
__host__ __device__ __forceinline__ void stage_rc(int b, int& R, int& C) { const int st = b / 1024, sb = b % 1024, swz = sb ^ (((sb >> 9) & 1) << 5); R = (st >> 1) * 16 + swz / 64; C = (st & 1) * 32 + (swz % 64) / 2; }
__host__ __device__ __forceinline__ int perm32(int rho) { const int n = rho >> 4, i = rho & 15; return 8 * (i >> 2) + 4 * n + (i & 3); }

struct Unit { int pm, pn, k0, nkt, part, half, par; };
struct Gemm { const bf16_t* A; const bf16_t* Bt; int M, N, K, lda, blkA, blkB; };

struct StaticOrder {
    static constexpr bool HAS_HALF = false;
    int nM, nN, nwg, G, c;
    __host__ __device__ void init(int M, int N, int G_, int c_) { nM = M / BM; nN = N / BM; nwg = nM * nN; G = G_; c = c_; }
    __host__ __device__ bool next(int i, Unit& u) const {
        const long L = (long)i * G + c; if (L >= nwg) return false;
        int wgid = (int)L; { const int q = nwg / NXCD, r = nwg % NXCD, xcd = wgid % NXCD, off = wgid / NXCD; wgid = (xcd < r ? xcd * (q + 1) : r * (q + 1) + (xcd - r) * q) + off; }
        const int nig = WGM * nN, gid = wgid / nig, fm = gid * WGM, gsz = (nM - fm) < WGM ? (nM - fm) : WGM;
        u.pm = fm + ((wgid % nig) % gsz); u.pn = (wgid % nig) / gsz; u.k0 = 0; u.nkt = 0; u.part = 0; u.half = 0; return true;
    }
    __device__ __forceinline__ void a_ready(const Unit&) const {}
    __device__ __forceinline__ void done(const Unit&) const {}
};
struct TqOrder {
    static constexpr bool HAS_HALF = false;
    StaticOrder so;
    __host__ __device__ void init(int M, int N, int G_, int c_) { so.nM = M / 192; so.nN = N / BM; so.nwg = so.nM * so.nN; so.G = G_; so.c = c_; }
    __host__ __device__ bool next(int i, Unit& u) const { return so.next(i, u); }
    __device__ __forceinline__ void a_ready(const Unit&) const {}
    __device__ __forceinline__ void done(const Unit&) const {}
};
struct SplitTailOrder {
    static constexpr bool HAS_HALF = false;
    StaticOrder so; int nt; bool split;
    __host__ __device__ void init(int K, int G_, int c_) { nt = K / BK; split = (G_ == 256); so.init(split ? 64 * BM : 72 * BM, 8 * BM, G_, c_); }
    __host__ __device__ bool next(int i, Unit& u) const {
        if (!split) return so.next(i, u);
        if (i < 2) return so.next(i, u);
        if (i > 2) return false;
        const int t = so.c >> 2, kq = so.c & 3; u.pm = 64 + (t >> 3); u.pn = t & 7; u.nkt = nt >> 2; u.k0 = kq * u.nkt; u.part = kq + 1; u.half = 0; return true;
    }
    __device__ __forceinline__ void a_ready(const Unit&) const {}
    __device__ __forceinline__ void done(const Unit&) const {}
};

struct HalfTailOrder {
    static constexpr bool HAS_HALF = true;
    StaticOrder so; int R, r; bool cut;
    __host__ __device__ void init(int M, int N, int G_, int c_) { so.init(M, N, G_, c_); R = so.nwg / G_; r = so.nwg - R * G_; cut = (r > 0 && 2 * r <= G_); }
    __host__ __device__ bool next(int i, Unit& u) const {
        if (!cut || i < R) return so.next(i, u);
        if (i > R || so.c >= 2 * r) return false;
        StaticOrder t = so; t.c = so.c >> 1; if (!t.next(R, u)) return false;
        u.half = 1 + (so.c & 1); return true;
    }
    __device__ __forceinline__ void a_ready(const Unit&) const {}
    __device__ __forceinline__ void done(const Unit&) const {}
};


template <class Epi, class Sched, bool ALIGN_EPI = false, bool SP2 = false, int TQ = 0>
__device__ __forceinline__ void gemm_phase(PG8_LAS unsigned char* lds, const Gemm g, const Sched& S, const Epi& E, int tid_) {
    const int tid = tid_, wid = __builtin_amdgcn_readfirstlane(tid >> 6), lane = tid & 63, wr = wid >> 2, wc = wid & 3, fr = lane & 15, fq = lane >> 4;
    const int K = g.K, nt = K / BK, lda = g.lda;
    unsigned voffA[2], voffB[2];
#pragma unroll
    for (int i = 0; i < 2; ++i) { int R, C; stage_rc(tid * 16 + i * 8192, R, C); const int Rb = Epi::PERM ? ((R & ~31) + perm32(R & 31)) : R;
        voffA[i] = (unsigned)(R * (g.blkA ? BK : lda) + C) * 2u; voffB[i] = (unsigned)(Rb * (g.blkB ? BK : K) + C) * 2u; }
    const size_t kstepA = g.blkA ? (size_t)BM * BK * 2 : (size_t)(BK * 2), kstepB = g.blkB ? (size_t)BM * BK * 2 : (size_t)(BK * 2);
    const size_t hstepA = (size_t)(TQ == 2 ? 64 : HALF) * (g.blkA ? BK : lda) * 2, hstepB = (size_t)HALF * (g.blkB ? BK : K) * 2;
    static_assert(!TQ || SP2, "TQ units need the SP2 loop");
    const size_t tstepA = TQ ? (size_t)192 * lda * 2 : g.blkA ? (size_t)nt * BM * BK * 2 : (size_t)BM * lda * 2, tstepB = g.blkB ? (size_t)nt * BM * BK * 2 : 2 * hstepB;
    const unsigned ldsw = (unsigned)wid * 1024u;
    const int aoff = lds_byte(TQ == 2 ? wr * 48 + fr : wr * 64 + fr, fq * 8), boff = lds_byte(wc * 32 + fr, fq * 8);
    const int aoff1 = TQ == 2 ? lds_byte(32 + wr * 48 + fr, fq * 8) : TQ == 1 ? lds_byte(wr * 32 + fr, fq * 8) : aoff;
#define PG8_SA(b, h) (((b) * 2 + (h)) * HTB)
#define PG8_SB(b, h) ((4 + (b) * 2 + (h)) * HTB)
#define PG8_STAGE(bufoff, gbase, voff) do { _Pragma("unroll") for (int _i = 0; _i < 2; ++_i) \
        __builtin_amdgcn_global_load_lds((const unsigned*)((const char*)(gbase) + (voff)[_i]), (PG8_LAS unsigned*)(lds + (bufoff) + ldsw + _i * 8192), 16, 0, 0); } while (0)
#define PG8_LDA(dst, b, h) do { _Pragma("unroll") for (int m = 0; m < (TQ == 2 ? 3 : 4); ++m) _Pragma("unroll") for (int k = 0; k < 2; ++k) dst[m][k] = *(const PG8_LAS bf16x8*)(lds + PG8_SA(b, h) + aoff + m * 2048 + k * 1024); } while (0)
#define PG8_LDB(dst, b, h) do { _Pragma("unroll") for (int n = 0; n < 2; ++n) _Pragma("unroll") for (int k = 0; k < 2; ++k) dst[n][k] = *(const PG8_LAS bf16x8*)(lds + PG8_SB(b, h) + boff + n * 2048 + k * 1024); } while (0)
#define PG8_MMA(ai, bj, At, Bt) do { __builtin_amdgcn_s_setprio(1); _Pragma("unroll") for (int m = 0; m < (TQ == 2 ? 3 : 4); ++m) _Pragma("unroll") for (int n = 0; n < 2; ++n) _Pragma("unroll") for (int k = 0; k < 2; ++k) \
        acc[ai][bj][m][n] = __builtin_amdgcn_mfma_f32_16x16x32_bf16(Bt[n][k], At[m][k], acc[ai][bj][m][n], 0, 0, 0); __builtin_amdgcn_s_setprio(0); } while (0)
#define PG8_STAGE_A1(bufoff, gbase) do { if constexpr (TQ == 1) { _Pragma("unroll") for (int _i = 0; _i < 2; ++_i)   \
        __builtin_amdgcn_global_load_lds((const unsigned*)((const char*)(gbase) + voffA[0]), (PG8_LAS unsigned*)(lds + (bufoff) + ldsw + _i * 8192), 16, 0, 0); } else PG8_STAGE(bufoff, gbase, voffA); } while (0)
#define PG8_LDA1(dst, b) do { _Pragma("unroll") for (int m = 0; m < (TQ == 2 ? 3 : TQ == 1 ? 2 : 4); ++m) _Pragma("unroll") for (int k = 0; k < 2; ++k) dst[m][k] = *(const PG8_LAS bf16x8*)(lds + PG8_SA(b, 1) + aoff1 + m * 2048 + k * 1024); } while (0)
#define PG8_MMA1(bj, At, Bt) do { __builtin_amdgcn_s_setprio(1); _Pragma("unroll") for (int m = 0; m < (TQ == 2 ? 3 : TQ == 1 ? 2 : 4); ++m) _Pragma("unroll") for (int n = 0; n < 2; ++n) _Pragma("unroll") for (int k = 0; k < 2; ++k) \
        acc[1][bj][m][n] = __builtin_amdgcn_mfma_f32_16x16x32_bf16(Bt[n][k], At[m][k], acc[1][bj][m][n], 0, 0, 0); __builtin_amdgcn_s_setprio(0); } while (0)
#define PG8_WAIT_V(n) asm volatile("s_waitcnt vmcnt(" #n ")" ::: "memory")
#define PG8_WAIT_L(n) asm volatile("s_waitcnt lgkmcnt(" #n ")" ::: "memory")
#define PG8_BAR __builtin_amdgcn_s_barrier()
#define PG8_SCHED __builtin_amdgcn_sched_barrier(0)
    Unit cur, nxt; int ui = 0;
    if (!S.next(0, cur)) return;
    f32x4 acc[2][2][4][2];
#pragma unroll
    for (int a = 0; a < 2; ++a)
#pragma unroll
        for (int b = 0; b < 2; ++b)
#pragma unroll
            for (int m = 0; m < 4; ++m)
#pragma unroll
                for (int n = 0; n < 2; ++n) acc[a][b][m][n] = (f32x4){0.f, 0.f, 0.f, 0.f};
    bf16x8 At[4][2], B0[2][2], B1[2][2];
    const char* cA = (const char*)g.A + (size_t)cur.pm * tstepA + (size_t)cur.k0 * kstepA; const char* cB = (const char*)g.Bt + (size_t)cur.pn * tstepB + (size_t)cur.k0 * kstepB;
    S.a_ready(cur);
    if constexpr (SP2) {
        PG8_STAGE(PG8_SB(0, 0), cB, voffB); PG8_STAGE(PG8_SB(0, 1), cB + hstepB, voffB); PG8_STAGE(PG8_SA(0, 0), cA, voffA); PG8_STAGE_A1(PG8_SA(0, 1), cA + hstepA);
        if (wr == 1) PG8_BAR;
        PG8_WAIT_V(2); PG8_BAR;
        PG8_STAGE(PG8_SB(1, 0), cB + kstepB, voffB); PG8_STAGE(PG8_SA(1, 0), cA + kstepA, voffA); PG8_STAGE(PG8_SB(1, 1), cB + hstepB + kstepB, voffB);
        PG8_WAIT_V(6); PG8_BAR;
    } else {
        PG8_STAGE(PG8_SB(0, 0), cB, voffB); PG8_STAGE(PG8_SA(0, 0), cA, voffA); PG8_STAGE(PG8_SB(0, 1), cB + hstepB, voffB); PG8_STAGE(PG8_SA(0, 1), cA + hstepA, voffA);
        if (wr == 1) PG8_BAR;
        PG8_WAIT_V(4); PG8_BAR;
        PG8_STAGE(PG8_SB(1, 0), cB + kstepB, voffB); PG8_STAGE(PG8_SA(1, 0), cA + kstepA, voffA); PG8_STAGE(PG8_SB(1, 1), cB + hstepB + kstepB, voffB);
        PG8_WAIT_V(6); PG8_BAR;
    }
    for (;;) {
        const bool has_next = S.next(ui + 1, nxt);
        const char* nA = has_next ? (const char*)g.A + (size_t)nxt.pm * tstepA + (size_t)nxt.k0 * kstepA : cA; const char* nB = has_next ? (const char*)g.Bt + (size_t)nxt.pn * tstepB + (size_t)nxt.k0 * kstepB : cB;
        const int ntc = cur.nkt ? cur.nkt : nt;
        cur.par = ui & 1;
        if constexpr (Epi::PRE) E.prefetch(lds, cur, tid);
#define PG8_SP2_BODY(DO0, DO1) do { \
            PG8_LDB(B0, 0, 0); PG8_LDB(B1, 0, 1); PG8_SCHED; if (DO0) PG8_LDA(At, 0, 0); PG8_STAGE_A1(PG8_SA(1, 1), a1 + hstepA); \
            PG8_WAIT_V(8); PG8_WAIT_L(0); PG8_BAR; if (DO0) { PG8_MMA(0, 0, At, B0); PG8_MMA(0, 1, At, B1); } PG8_BAR; PG8_SCHED; \
            if (DO1) PG8_LDA1(At, 0); PG8_STAGE(PG8_SB(0, 0), b2, voffB); PG8_STAGE(PG8_SB(0, 1), b2 + hstepB, voffB); PG8_STAGE(PG8_SA(0, 0), a2, voffA); \
            PG8_WAIT_V(8); PG8_WAIT_L(0); PG8_BAR; if (DO1) { PG8_MMA1(0, At, B0); PG8_MMA1(1, At, B1); } PG8_BAR; PG8_SCHED; \
            PG8_LDB(B0, 1, 0); PG8_LDB(B1, 1, 1); PG8_SCHED; if (DO0) PG8_LDA(At, 1, 0); PG8_STAGE_A1(PG8_SA(0, 1), a2 + hstepA); \
            PG8_WAIT_V(8); PG8_WAIT_L(0); PG8_BAR; if (DO0) { PG8_MMA(0, 0, At, B0); PG8_MMA(0, 1, At, B1); } PG8_BAR; PG8_SCHED; \
            if (DO1) PG8_LDA1(At, 1); PG8_STAGE(PG8_SB(1, 0), b3, voffB); PG8_STAGE(PG8_SB(1, 1), b3 + hstepB, voffB); PG8_STAGE(PG8_SA(1, 0), a3, voffA); \
            PG8_WAIT_V(8); PG8_WAIT_L(0); PG8_BAR; if (DO1) { PG8_MMA1(0, At, B0); PG8_MMA1(1, At, B1); } PG8_BAR; PG8_SCHED; } while (0)
#define PG8_TLOOP(DO0, DO1) do { for (int t = 0; t < ntc; t += 2) { \
            const bool last = (t == ntc - 2); \
            const char* a1 = cA + (size_t)(t + 1) * kstepA; \
            const char* a2 = last ? nA : cA + (size_t)(t + 2) * kstepA; const char* b2 = last ? nB : cB + (size_t)(t + 2) * kstepB; \
            const char* a3 = a2 + kstepA; const char* b3 = b2 + kstepB; \
            if (last && has_next) S.a_ready(nxt); \
            PG8_SP2_BODY(DO0, DO1); } } while (0)
        if constexpr (SP2) {
            if constexpr (Sched::HAS_HALF) { if (cur.half == 0) PG8_TLOOP(true, true); else if (cur.half == 1) PG8_TLOOP(true, false); else PG8_TLOOP(false, true); }
            else PG8_TLOOP(true, true);
        } else {
        static_assert(SP2 || !Sched::HAS_HALF, "half units need the SP2 loop");
        for (int t = 0; t < ntc; t += 2) {
            const bool last = (t == ntc - 2);
            const char* a1 = cA + (size_t)(t + 1) * kstepA;
            const char* a2 = last ? nA : cA + (size_t)(t + 2) * kstepA; const char* b2 = last ? nB : cB + (size_t)(t + 2) * kstepB;
            const char* a3 = a2 + kstepA; const char* b3 = b2 + kstepB;
            if (last && has_next) S.a_ready(nxt);
            PG8_LDB(B0, 0, 0); PG8_SCHED; PG8_LDA(At, 0, 0); PG8_STAGE(PG8_SA(1, 1), a1 + hstepA, voffA);
            PG8_WAIT_L(8); PG8_BAR; PG8_WAIT_L(0); PG8_MMA(0, 0, At, B0); PG8_BAR; PG8_SCHED;
            PG8_LDB(B1, 0, 1); PG8_STAGE(PG8_SB(0, 0), b2, voffB);
            PG8_BAR; PG8_WAIT_L(0); PG8_MMA(0, 1, At, B1); PG8_BAR;
            PG8_LDA(At, 0, 1); PG8_STAGE(PG8_SA(0, 0), a2, voffA);
            PG8_BAR; PG8_WAIT_L(0); PG8_MMA(1, 0, At, B0); PG8_BAR; PG8_SCHED;
            PG8_STAGE(PG8_SB(0, 1), b2 + hstepB, voffB);
            PG8_WAIT_V(6); PG8_BAR; PG8_MMA(1, 1, At, B1); PG8_BAR;
            PG8_LDB(B0, 1, 0); PG8_SCHED; PG8_LDA(At, 1, 0); PG8_STAGE(PG8_SA(0, 1), a2 + hstepA, voffA);
            PG8_WAIT_L(8); PG8_BAR; PG8_WAIT_L(0); PG8_MMA(0, 0, At, B0); PG8_BAR; PG8_SCHED;
            PG8_LDB(B1, 1, 1); PG8_STAGE(PG8_SB(1, 0), b3, voffB);
            PG8_BAR; PG8_WAIT_L(0); PG8_MMA(0, 1, At, B1); PG8_BAR;
            PG8_LDA(At, 1, 1); PG8_STAGE(PG8_SA(1, 0), a3, voffA);
            PG8_BAR; PG8_WAIT_L(0); PG8_MMA(1, 0, At, B0); PG8_BAR; PG8_SCHED;
            PG8_STAGE(PG8_SB(1, 1), b3 + hstepB, voffB);
            PG8_WAIT_V(6); PG8_BAR; PG8_MMA(1, 1, At, B1); PG8_BAR;
        }
        }
#undef PG8_TLOOP
#undef PG8_SP2_BODY
        if constexpr (ALIGN_EPI) { if (wr == 0) PG8_BAR; }
        E(acc, cur, wr, wc, fr, fq);
        if (!has_next) break;
#pragma unroll
        for (int a = 0; a < 2; ++a)
#pragma unroll
            for (int b = 0; b < 2; ++b)
#pragma unroll
                for (int m = 0; m < 4; ++m)
#pragma unroll
                    for (int n = 0; n < 2; ++n) acc[a][b][m][n] = (f32x4){0.f, 0.f, 0.f, 0.f};
        cur = nxt; cA = nA; cB = nB; ++ui;
        if constexpr (ALIGN_EPI) { if (wr == 1) PG8_BAR; }
    }
    PG8_WAIT_V(0);
    if constexpr (!ALIGN_EPI) { if (wr == 0) PG8_BAR; }
    PG8_BAR;
#undef PG8_SA
#undef PG8_SB
#undef PG8_STAGE
#undef PG8_LDA
#undef PG8_LDB
#undef PG8_MMA
#undef PG8_STAGE_A1
#undef PG8_LDA1
#undef PG8_MMA1
#undef PG8_WAIT_V
#undef PG8_WAIT_L
#undef PG8_BAR
#undef PG8_SCHED
}
}
constexpr int DM = 2048, NBP = 8, SEQ = 2048, NBS = 32, DSEQ = 64, PAST = 1024, DFF = 5632;
constexpr int MP = NBP * SEQ, MS = NBS * DSEQ, MT = MP + MS;
constexpr int RH = 8, RDK = 256, RDV = 512, RIN = 2 * RH * RDK + 2 * RH * RDV, RHV = RH * RDV;
constexpr int MH = 16, NOPE = 128, ROPE = 64, QKH = 192, VHD = 128, KVL = 512, QLR = 512, QW = MH * QKH;
constexpr int KVT = PAST + DSEQ, KVROWS = MP + NBS * KVT;
constexpr int DKVP = 768, KVW = MH * (NOPE + VHD);
constexpr float EPS = 1e-6f;

constexpr size_t OUT_YP = 0, OUT_YS = (size_t)MP * DM, OUT_RETP = OUT_YS + (size_t)MS * DM, OUT_CKVP = OUT_RETP + (size_t)NBP * RH * RDK * RDV,
                 OUT_KRP = OUT_CKVP + (size_t)MP * KVL, OUT_RETS = OUT_KRP + (size_t)MP * ROPE, OUT_CKVS = OUT_RETS + (size_t)NBS * RH * RDK * RDV,
                 OUT_KRS = OUT_CKVS + (size_t)MS * KVL, OUT_END = OUT_KRS + (size_t)MS * ROPE;
static_assert(OUT_END == 90308608, "output size");

constexpr size_t MiB = 1u << 20;
constexpr size_t WS_CTL = 0, CTL_ZERO_BYTES = 1 * MiB;
constexpr size_t WS_COSR = 1 * MiB, WS_SINR = 2 * MiB;
constexpr size_t WS_COSM = 3 * MiB, WS_SINM = 3 * MiB + 256 * 1024;
constexpr size_t WS_SSQKR = 3 * MiB + 512 * 1024;
constexpr size_t WS_GQK = 3 * MiB + 768 * 1024;
constexpr size_t WS_RS = 4 * MiB;
constexpr size_t WS_KRALL = 21 * MiB;
constexpr size_t WS_CALL = 28 * MiB;
constexpr size_t WS_XN = 78 * MiB;
constexpr size_t WS_SMALL = 150 * MiB;
constexpr size_t WS_QLN = WS_SMALL + 36 * MiB;
constexpr size_t WS_QSSQ = WS_SMALL;
constexpr size_t WS_WL1 = 204 * MiB;
constexpr size_t SZ_WIN = (size_t)2 * DFF * DM * 2, SZ_WOUT = (size_t)DM * DFF * 2;
constexpr size_t WS_WIN10 = WS_WL1, WS_WOUT10 = WS_WIN10 + SZ_WIN, WS_WIN11 = WS_WOUT10 + SZ_WOUT, WS_WOUT11 = WS_WIN11 + SZ_WIN;
constexpr size_t WS_WDQ = WS_WOUT11 + SZ_WOUT, WS_WUQ = WS_WDQ + 2 * MiB, WS_WO = WS_WUQ + 3 * MiB, WS_WUKV = WS_WO + 8 * MiB;
constexpr size_t WS_WL0 = WS_WUKV + 4 * MiB;
static_assert(WS_WL0 == 353 * MiB, "ws map");
constexpr size_t WS_WIN00 = WS_WL0, WS_WOUT00 = WS_WIN00 + SZ_WIN, WS_WIN01 = WS_WOUT00 + SZ_WOUT, WS_WOUT01 = WS_WIN01 + SZ_WIN;
constexpr size_t WS_WRIN = WS_WOUT01 + SZ_WOUT, WS_WROUT = WS_WRIN + 48 * MiB, WS_WDKV = WS_WROUT + 16 * MiB;
constexpr size_t WS_Q = WS_WL0, WS_O = WS_WL0 + 108 * MiB;
constexpr size_t WS_BIG = WS_WDKV + 3 * MiB;
static_assert(WS_BIG == 552 * MiB && WS_O + (size_t)MT * DM * 2 <= WS_BIG, "ws map");
constexpr size_t WS_PART = WS_BIG + 200 * MiB;
constexpr size_t WS_END = WS_BIG + (size_t)MT * RIN * 2;
static_assert(WS_END == 984 * MiB, "ws map");
constexpr size_t WS_FIXCNT = 32 * 1024;
constexpr size_t WS_SSQH = 8 * MiB, SSQH_STRIDE = (size_t)MT * 32;
static_assert(WS_RS + (size_t)KVROWS * 16 * 4 <= WS_SSQH && WS_SSQH + 6 * SSQH_STRIDE <= WS_KRALL, "ws map");
constexpr int CW_BAR = 4096;

constexpr int RING_OFF = 0, RING_BYTES = 144 * 1024;
constexpr int LDSCTL_OFF = RING_BYTES, MISC_OFF = LDSCTL_OFF + 320;
constexpr int LDS_BYTES = 155648;
constexpr int NWAVES = 8;

#define GAS __attribute__((address_space(1)))
#define LAS __attribute__((address_space(3)))
typedef unsigned short bf16;
typedef unsigned v4u __attribute__((ext_vector_type(4)));
typedef unsigned v2u __attribute__((ext_vector_type(2)));
typedef float f32x4 __attribute__((ext_vector_type(4)));
typedef float f32x16 __attribute__((ext_vector_type(16)));
typedef short bf16x8 __attribute__((ext_vector_type(8)));
typedef short s16x4 __attribute__((ext_vector_type(4)));
typedef GAS unsigned gu32;
#define RLX_AGENT __ATOMIC_RELAXED, __HIP_MEMORY_SCOPE_AGENT
#define LDS_WAIT() asm volatile("s_waitcnt lgkmcnt(0)" ::: "memory")
#define VM_WAIT() asm volatile("s_waitcnt vmcnt(0)" ::: "memory")
typedef float f32x2_t __attribute__((ext_vector_type(2)));
typedef __bf16 bf16x2_t __attribute__((ext_vector_type(2)));
__device__ __forceinline__ unsigned cvtpk(float lo, float hi) { const f32x2_t v = {lo, hi}; const bf16x2_t b = __builtin_convertvector(v, bf16x2_t); return __builtin_bit_cast(unsigned, b); }
__device__ __forceinline__ float bflo(unsigned w) { return __uint_as_float(w << 16); }
__device__ __forceinline__ float bfhi(unsigned w) { return __uint_as_float(w & 0xffff0000u); }
__device__ __forceinline__ int lane_id_asm() { int l; asm volatile("v_mbcnt_lo_u32_b32 %0, -1, 0\n\tv_mbcnt_hi_u32_b32 %0, -1, %0" : "=v"(l)); return l; }
__device__ __forceinline__ float shfl_xor_l(float v, int o, int lane) { return __int_as_float(__builtin_amdgcn_ds_bpermute((lane ^ o) << 2, __float_as_int(v))); }
__device__ __forceinline__ float wave_sum(float v, int lane) {
#pragma unroll
    for (int o = 1; o < 64; o <<= 1) v += shfl_xor_l(v, o, lane);
    return v;
}
__device__ __forceinline__ float silu_f(float a) { return a * __builtin_amdgcn_rcpf(1.0f + __builtin_amdgcn_exp2f(-1.4426950408889634f * a)); }
__device__ __forceinline__ float lg2gamma(int h) {
    return h == 0 ? -0.04580368961312479f : h == 1 ? -0.02272007650008353f : h == 2 ? -0.011315313227834146f : h == 3 ? -0.005646563141142063f :
           h == 4 ? -0.0028205190623786626f : h == 5 ? -0.0014095702546713536f : h == 6 ? -0.0007046129765893727f : -0.0003522634716290214f;
}

#define XB_TMO      128
#define XB_XCNT(j)  (256  + 64 * (j))
#define XB_XSUB(j)  (1280 + 64 * (j))
#define XB_XGEN(j)  (2304 + 64 * (j))
#define XB_TOP      3328
#define XB_TOPGEN   3392
#define XCD_BAR_WORDS 3456
#define XB_SPIN_CAP (1u << 18)

__device__ __forceinline__ unsigned xb_ld(unsigned* p)              { return __hip_atomic_load(p, __ATOMIC_RELAXED, __HIP_MEMORY_SCOPE_AGENT); }
__device__ __forceinline__ unsigned xb_add(unsigned* p, unsigned v) { return __hip_atomic_fetch_add(p, v, __ATOMIC_RELAXED, __HIP_MEMORY_SCOPE_AGENT); }
__device__ __forceinline__ unsigned xb_xcc_id() { return (unsigned)__builtin_amdgcn_s_getreg((3 << 11) | 20) & 0xFu; }
#define XB_SPIN(cond, bar) do { unsigned _sp = 0; while (cond) { __builtin_amdgcn_s_sleep(1); \
    if ((++_sp & 255u) == 0u) { if (xb_ld(&(bar)[XB_TMO])) break; if (_sp > XB_SPIN_CAP) { atomicAdd(&(bar)[XB_TMO], 1u); break; } } } } while (0)

struct XcdBarrier {
    unsigned* bar; unsigned x;
    volatile LAS unsigned* st;
};
__device__ __forceinline__ XcdBarrier xcd_barrier_post(unsigned* bar, volatile LAS unsigned* st) {
    XcdBarrier b; b.bar = bar; b.x = xb_xcc_id(); b.st = st;
    if (threadIdx.x == 0) (void)xb_add(&bar[XB_XCNT(b.x)], 1u);
    return b;
}
__device__ __forceinline__ void xcd_barrier_complete(unsigned* bar, unsigned x, unsigned& nloc, unsigned& nx) {
    const unsigned G = gridDim.x * gridDim.y * gridDim.z;
    unsigned sum, cnt, mine, sp = 0u;
    for (;;) {
        sum = 0u; cnt = 0u; mine = 0u;
#pragma unroll
        for (unsigned j = 0; j < 16; ++j) { const unsigned c = xb_ld(&bar[XB_XCNT(j)]); sum += c; cnt += (c > 0u) ? 1u : 0u; mine = (j == x) ? c : mine; }
        if (sum == G) break;
        __builtin_amdgcn_s_sleep(1);
        if ((++sp & 255u) == 0u) { if (xb_ld(&bar[XB_TMO])) break; if (sp > XB_SPIN_CAP) { atomicAdd(&bar[XB_TMO], 1u); break; } }
    }
    nloc = mine > 0u ? mine : 1u; nx = cnt > 0u ? cnt : 1u;
}
__device__ __forceinline__ void xcd_barrier(const XcdBarrier& b, int wave_id) {
    asm volatile("s_waitcnt vmcnt(0)" ::: "memory");
    __syncthreads();
    if (wave_id == 0 && lane_id_asm() == 0) {
        unsigned* bar = b.bar;
        __builtin_amdgcn_s_waitcnt(0);
        unsigned nloc = b.st[0], nx = b.st[1];
        if (nloc == 0u) { xcd_barrier_complete(bar, b.x, nloc, nx); b.st[0] = nloc; b.st[1] = nx; }
        const unsigned old = xb_add(&bar[XB_XSUB(b.x)], 1u);
        const unsigned gen = old / nloc;
        if (old + 1u == (gen + 1u) * nloc) {
            __builtin_amdgcn_fence(__ATOMIC_RELEASE, "agent");
            asm volatile("s_waitcnt vmcnt(0)" ::: "memory");
            const unsigned og = xb_add(&bar[XB_TOP], 1u);
            const unsigned tg = og / nx;
            if (og + 1u == (tg + 1u) * nx) xb_add(&bar[XB_TOPGEN], 1u);
            else XB_SPIN(xb_ld(&bar[XB_TOPGEN]) == tg, bar);
            __builtin_amdgcn_fence(__ATOMIC_ACQUIRE, "agent");
            xb_add(&bar[XB_XGEN(b.x)], 1u);
            asm volatile("s_waitcnt vmcnt(0)" ::: "memory");
        } else {
            XB_SPIN(xb_ld(&bar[XB_XGEN(b.x)]) == gen, bar);
            __builtin_amdgcn_fence(__ATOMIC_ACQUIRE, "agent");
            asm volatile("s_waitcnt vmcnt(0)" ::: "memory");
        }
    }
    __syncthreads();
}

using pg8::Unit; using pg8::HALF; using pg8::BM;
constexpr int RSBUF_OFF = 128 * 1024;
__device__ __forceinline__ float rs_of8(const f32x4 a, const f32x4 b) { return 1.0f / sqrtf((((a[0] + a[1]) + (a[2] + a[3])) + ((b[0] + b[1]) + (b[2] + b[3]))) * (1.0f / (float)DM) + EPS); }
__device__ __forceinline__ void ssq_row_store(float* p, float tot) { float z = 0.f; asm volatile("" : "+v"(z)); *(GAS f32x4*)p = (f32x4){tot, z, z, z}; *(GAS f32x4*)(p + 4) = (f32x4){z, z, z, z}; }
__device__ __forceinline__ void rs_prefetch(LAS unsigned char* ring, const float* ssq, const Unit& u, int tid) {
    const int wid = __builtin_amdgcn_readfirstlane(tid >> 6);
    __builtin_amdgcn_global_load_lds((const unsigned*)(ssq + (size_t)u.pm * (BM * 8) + tid * 4), (LAS unsigned*)(ring + RSBUF_OFF + u.par * 8192 + wid * 1024), 16, 0, 0);
}
__device__ __forceinline__ void rs_load8(LAS unsigned char* ring, const Unit& u, int wr, int fr, float (&rs)[2][4]) {
#pragma unroll
    for (int ai = 0; ai < 2; ++ai)
#pragma unroll
        for (int m = 0; m < 4; ++m) { const LAS f32x4* p = (const LAS f32x4*)(ring + RSBUF_OFF + u.par * 8192 + (wr * 64 + fr + ai * HALF + m * 16) * 32); rs[ai][m] = rs_of8(p[0], p[1]); }
}
struct EpiSwiGLU {
    static constexpr bool PRE = (MK_NFOLD != 0); static constexpr bool PERM = true;
    bf16* O; int ldc; const float* ssq; LAS unsigned char* ring;
    __device__ __forceinline__ void prefetch(LAS unsigned char* lds, const Unit& u, int tid) const { if (ssq) rs_prefetch(lds, ssq, u, tid); }
    __device__ __forceinline__ void operator()(const f32x4 (&acc)[2][2][4][2], const Unit& u, int wr, int wc, int fr, int fq) const {
        const int row0 = u.pm * BM + wr * 64 + fr, col0 = u.pn * HALF + wc * 32 + 8 * fq;
        float rs[2][4];
        if (ssq) rs_load8(ring, u, wr, fr, rs); else {
#pragma unroll
            for (int i = 0; i < 8; ++i) rs[i >> 2][i & 3] = 1.0f; }
#pragma unroll
        for (int ai = 0; ai < 2; ++ai) { if (u.half && ai != u.half - 1) continue;
#pragma unroll
            for (int m = 0; m < 4; ++m) {
                const int row = row0 + ai * HALF + m * 16;
                bf16* rowp = MK_BLK ? O + ((size_t)(row >> 8) * (DFF / 64) + (col0 >> 6)) * (256 * 64) + (row & 255) * 64 + (col0 & 63) : O + (size_t)row * ldc + col0;
                const f32x4 a0 = acc[ai][0][m][0] * rs[ai][m], a1 = acc[ai][0][m][1] * rs[ai][m], b0 = acc[ai][1][m][0] * rs[ai][m], b1 = acc[ai][1][m][1] * rs[ai][m];
                v4u w;
                w.x = cvtpk(silu_f(a0[0]) * b0[0], silu_f(a0[1]) * b0[1]); w.y = cvtpk(silu_f(a0[2]) * b0[2], silu_f(a0[3]) * b0[3]);
                w.z = cvtpk(silu_f(a1[0]) * b1[0], silu_f(a1[1]) * b1[1]); w.w = cvtpk(silu_f(a1[2]) * b1[2], silu_f(a1[3]) * b1[3]);
                *(GAS v4u*)rowp = w; } }
    }
};
struct EpiResid {
    static constexpr bool PRE = false; static constexpr bool PERM = false;
    float* H; int ldc; float scale; float* P; int pstride; const float* Hin; const float* Hin2;
    __device__ __forceinline__ void operator()(const f32x4 (&acc)[2][2][4][2], const Unit& u, int wr, int wc, int fr, int fq) const {
        const int row0 = u.pm * BM + wr * 64 + fr, col0 = u.pn * BM + wc * 32 + 4 * fq;
        if (u.part) {
#pragma unroll
            for (int ai = 0; ai < 2; ++ai)
#pragma unroll
                for (int m = 0; m < 4; ++m) { float* rowp = P + (size_t)((u.part - 1) * MS + (row0 + ai * HALF + m * 16 - MP)) * pstride + col0;
#pragma unroll
                    for (int bj = 0; bj < 2; ++bj)
#pragma unroll
                        for (int n = 0; n < 2; ++n) *(GAS f32x4*)(rowp + bj * HALF + n * 16) = scale * acc[ai][bj][m][n]; }
            return;
        }
#pragma unroll
        for (int ai = 0; ai < 2; ++ai) {
            f32x4 h[4][2][2];
#pragma unroll
            for (int m = 0; m < 4; ++m) { const int row = row0 + ai * HALF + m * 16; const float* rowp = (row < MP ? Hin + (size_t)row * ldc : Hin2 + (size_t)(row - MP) * ldc) + col0;
#pragma unroll
                for (int bj = 0; bj < 2; ++bj)
#pragma unroll
                    for (int n = 0; n < 2; ++n) h[m][bj][n] = *(const GAS f32x4*)(rowp + bj * HALF + n * 16); }
#pragma unroll
            for (int m = 0; m < 4; ++m) { float* rowp = H + (size_t)(row0 + ai * HALF + m * 16) * ldc + col0;
#pragma unroll
                for (int bj = 0; bj < 2; ++bj)
#pragma unroll
                    for (int n = 0; n < 2; ++n) *(GAS f32x4*)(rowp + bj * HALF + n * 16) = h[m][bj][n] + scale * acc[ai][bj][m][n]; }
            asm volatile("" ::: "memory"); }
    }
};
struct EpiResid2 {
    static constexpr bool PRE = false; static constexpr bool PERM = false;
    float* H; int ldc; float scale; float* P; int pstride; const float* Hin; const float* Hin2;
    bf16* HB; float* ssq; unsigned* cnt; LAS float* part;
    __device__ __forceinline__ void operator()(const f32x4 (&acc_)[2][2][4][2], const Unit& u, int wr, int wc, int fr_, int fq_) const {
        f32x4 (&acc)[2][2][4][2] = const_cast<f32x4 (&)[2][2][4][2]>(acc_);
        int fr = fr_, fq = fq_; asm volatile("" : "+v"(fr), "+v"(fq));
        const int row0 = u.pm * BM + wr * 64 + fr, col0 = u.pn * BM + wc * 32 + 4 * fq;
        const bool lead = (wr == 0 && wc == 0 && (fq * 16 + fr) == 0);
        if (u.part) {
#pragma unroll
            for (int ai = 0; ai < 2; ++ai)
#pragma unroll
                for (int m = 0; m < 4; ++m) { float* rowp = P + ((size_t)(u.part - 1) * MS + (row0 + ai * HALF + m * 16 - MP)) * pstride + col0;
#pragma unroll
                    for (int bj = 0; bj < 2; ++bj)
#pragma unroll
                        for (int n = 0; n < 2; ++n) *(GAS f32x4*)(rowp + bj * HALF + n * 16) = scale * acc[ai][bj][m][n]; }
            return;
        }
#pragma unroll
        for (int ai = 0; ai < 2; ++ai) {
            f32x4 h[4][2][2];
#pragma unroll
            for (int m = 0; m < 4; ++m) { const int row = row0 + ai * HALF + m * 16; const float* rowp = (row < MP ? Hin + (size_t)row * ldc : Hin2 + (size_t)(row - MP) * ldc) + col0;
#pragma unroll
                for (int bj = 0; bj < 2; ++bj)
#pragma unroll
                    for (int n = 0; n < 2; ++n) h[m][bj][n] = *(const GAS f32x4*)(rowp + bj * HALF + n * 16); }
#pragma unroll
            for (int m = 0; m < 4; ++m) { const int row = row0 + ai * HALF + m * 16; float* rowp = H + (size_t)row * ldc + col0; float s = 0.f;
#pragma unroll
                for (int bj = 0; bj < 2; ++bj) { const f32x4 v0 = h[m][bj][0] + scale * acc[ai][bj][m][0], v1 = h[m][bj][1] + scale * acc[ai][bj][m][1];
                    *(GAS f32x4*)(rowp + bj * HALF) = v0; *(GAS f32x4*)(rowp + bj * HALF + 16) = v1;
                    if (HB) { bf16* hb = HB + (size_t)row * ldc + col0 + bj * HALF; v2u w; w.x = cvtpk(v0[0], v0[1]); w.y = cvtpk(v0[2], v0[3]); *(GAS v2u*)hb = w; w.x = cvtpk(v1[0], v1[1]); w.y = cvtpk(v1[2], v1[3]); *(GAS v2u*)(hb + 16) = w; }
                    s += (v0[0] * v0[0] + v0[1] * v0[1]) + (v0[2] * v0[2] + v0[3] * v0[3]) + (v1[0] * v1[0] + v1[1] * v1[1]) + (v1[2] * v1[2] + v1[3] * v1[3]); }
                if (ssq) { const int ln_ = fq * 16 + fr; s += shfl_xor_l(s, 16, ln_); s += shfl_xor_l(s, 32, ln_);
                    if (fq == 0) part[(ai * HALF + wr * 64 + m * 16 + fr) * 4 + wc] = s; } }
            asm volatile("" ::: "memory"); }
        if (ssq) {
            asm volatile("s_waitcnt lgkmcnt(0)" ::: "memory"); __builtin_amdgcn_s_barrier(); asm volatile("" ::: "memory");
            const int t = (wr * 4 + wc) * 64 + fq * 16 + fr;
            if (t < 256) { const f32x4 p = *(const LAS f32x4*)(part + t * 4);
                ((GAS float*)ssq)[((size_t)u.pm * BM + t) * 8 + u.pn] = (p[0] + p[1]) + (p[2] + p[3]); }
        }
    }
};
struct EpiResid3 {
    static constexpr bool PRE = false; static constexpr bool PERM = true;
    float* Y; int ldc; float scale; float* P; int pstride; const float* Xin; const float* Xin2;
    bf16* HB; float* ssq; LAS float* part;
    __device__ __forceinline__ void operator()(const f32x4 (&acc)[2][2][4][2], const Unit& u, int wr, int wc, int fr_, int fq_) const {
        int fr = fr_, fq = fq_; asm volatile("" : "+v"(fr), "+v"(fq));
        constexpr bool TQE = (MK_TQ != 0);
        const int rbase = u.pm * (TQE ? 192 : BM), row0 = rbase + wr * 64 + fr, col0 = u.pn * BM + wc * 32 + 8 * fq;
#define ER3_MM(ai) (MK_TQ == 2 ? 3 : (TQE && (ai)) ? 2 : 4)
#define ER3_RT(ai, m) (MK_TQ == 2 ? (ai) * 96 + wr * 48 + (m) * 16 + fr : (ai) == 0 ? wr * 64 + (m) * 16 + fr : HALF + (TQE ? wr * 32 : wr * 64) + (m) * 16 + fr)
        if (u.part) {
#pragma unroll
            for (int ai = 0; ai < 2; ++ai)
#pragma unroll
                for (int m = 0; m < 4; ++m) { float* rowp = P + ((size_t)(u.part - 1) * MS + (row0 + ai * HALF + m * 16 - MP)) * pstride + col0;
#pragma unroll
                    for (int bj = 0; bj < 2; ++bj)
#pragma unroll
                        for (int n = 0; n < 2; ++n) *(GAS f32x4*)(rowp + bj * HALF + n * 4) = scale * acc[ai][bj][m][n]; }
            return;
        }
#pragma unroll
        for (int ai = 0; ai < 2; ++ai) {
            f32x4 r[4][2][2];
            if (Xin) {
#pragma unroll
                for (int m = 0; m < ER3_MM(ai); ++m) { const int row = rbase + ER3_RT(ai, m); const float* rowp = (row < MP ? Xin + (size_t)row * ldc : Xin2 + (size_t)(row - MP) * ldc) + col0;
#pragma unroll
                    for (int bj = 0; bj < 2; ++bj)
#pragma unroll
                        for (int n = 0; n < 2; ++n) r[m][bj][n] = *(const GAS f32x4*)(rowp + bj * HALF + n * 4); }
            } else { v4u hb[4][2];
#pragma unroll
                for (int m = 0; m < ER3_MM(ai); ++m)
#pragma unroll
                    for (int bj = 0; bj < 2; ++bj) hb[m][bj] = *(const GAS v4u*)(HB + (size_t)(rbase + ER3_RT(ai, m)) * ldc + col0 + bj * HALF);
#pragma unroll
                for (int m = 0; m < ER3_MM(ai); ++m)
#pragma unroll
                    for (int bj = 0; bj < 2; ++bj) { r[m][bj][0] = (f32x4){bflo(hb[m][bj].x), bfhi(hb[m][bj].x), bflo(hb[m][bj].y), bfhi(hb[m][bj].y)}; r[m][bj][1] = (f32x4){bflo(hb[m][bj].z), bfhi(hb[m][bj].z), bflo(hb[m][bj].w), bfhi(hb[m][bj].w)}; }
            }
#pragma unroll
            for (int m = 0; m < ER3_MM(ai); ++m) { const int row = rbase + ER3_RT(ai, m); float s = 0.f;
#pragma unroll
                for (int bj = 0; bj < 2; ++bj) { const f32x4 v0 = r[m][bj][0] + scale * acc[ai][bj][m][0], v1 = r[m][bj][1] + scale * acc[ai][bj][m][1];
                    if (Y) { float* yp = Y + (size_t)row * ldc + col0 + bj * HALF; *(GAS f32x4*)yp = v0; *(GAS f32x4*)(yp + 4) = v1; }
                    else { v4u w; w.x = cvtpk(v0[0], v0[1]); w.y = cvtpk(v0[2], v0[3]); w.z = cvtpk(v1[0], v1[1]); w.w = cvtpk(v1[2], v1[3]);
                        *(GAS v4u*)(HB + (size_t)row * ldc + col0 + bj * HALF) = w; }
                    s += (v0[0] * v0[0] + v0[1] * v0[1]) + (v0[2] * v0[2] + v0[3] * v0[3]) + (v1[0] * v1[0] + v1[1] * v1[1]) + (v1[2] * v1[2] + v1[3] * v1[3]); }
                if (ssq) { const int ln_ = fq * 16 + fr; s += shfl_xor_l(s, 16, ln_); s += shfl_xor_l(s, 32, ln_);
                    if (fq == 0) part[ER3_RT(ai, m) * 4 + wc] = s; } }
            asm volatile("" ::: "memory"); }
        if (ssq) {
            asm volatile("s_waitcnt lgkmcnt(0)" ::: "memory"); __builtin_amdgcn_s_barrier(); asm volatile("" ::: "memory");
            const int t = (wr * 4 + wc) * 64 + fq * 16 + fr;
            if (t < (TQE ? 192 : 256)) { const f32x4 p = *(const LAS f32x4*)(part + t * 4);
                ((GAS float*)ssq)[((size_t)rbase + t) * 8 + u.pn] = (p[0] + p[1]) + (p[2] + p[3]); }
        }
#undef ER3_MM
#undef ER3_RT
    }
};
struct EpiF32 {
    static constexpr bool PRE = false; static constexpr bool PERM = false;
    float* C; int ldc;
    __device__ __forceinline__ void operator()(const f32x4 (&acc)[2][2][4][2], const Unit& u, int wr, int wc, int fr, int fq) const {
        const int row0 = u.pm * BM + wr * 64 + fr, col0 = u.pn * BM + wc * 32 + 4 * fq;
#pragma unroll
        for (int ai = 0; ai < 2; ++ai)
#pragma unroll
            for (int m = 0; m < 4; ++m) { float* rowp = C + (size_t)(row0 + ai * HALF + m * 16) * ldc + col0;
#pragma unroll
                for (int bj = 0; bj < 2; ++bj)
#pragma unroll
                    for (int n = 0; n < 2; ++n) *(GAS f32x4*)(rowp + bj * HALF + n * 16) = acc[ai][bj][m][n]; }
    }
};
struct EpiBf16 {
    static constexpr bool PRE = false; static constexpr bool PERM = true;
    bf16* O; int ldc;
    __device__ __forceinline__ void operator()(const f32x4 (&acc)[2][2][4][2], const Unit& u, int wr, int wc, int fr, int fq) const {
        const int row0 = u.pm * BM + wr * 64 + fr, col0 = u.pn * BM + wc * 32 + 8 * fq;
#pragma unroll
        for (int ai = 0; ai < 2; ++ai)
#pragma unroll
            for (int m = 0; m < 4; ++m) { bf16* rowp = O + (size_t)(row0 + ai * HALF + m * 16) * ldc + col0;
#pragma unroll
                for (int bj = 0; bj < 2; ++bj) { const f32x4 v0 = acc[ai][bj][m][0], v1 = acc[ai][bj][m][1];
                    v4u w; w.x = cvtpk(v0[0], v0[1]); w.y = cvtpk(v0[2], v0[3]); w.z = cvtpk(v1[0], v1[1]); w.w = cvtpk(v1[2], v1[3]);
                    *(GAS v4u*)(rowp + bj * HALF) = w; } }
    }
};
struct EpiQlat {
    static constexpr bool PRE = (MK_NFOLD != 0); static constexpr bool PERM = true;
    bf16* O; int ldc; float* ssq; LAS float* part;
    const float* hssq; LAS unsigned char* ring;
    __device__ __forceinline__ void prefetch(LAS unsigned char* lds, const Unit& u, int tid) const { if (hssq) rs_prefetch(lds, hssq, u, tid); }
    __device__ __forceinline__ void operator()(const f32x4 (&acc)[2][2][4][2], const Unit& u, int wr, int wc, int fr, int fq) const {
        const int row0 = u.pm * BM + wr * 64 + fr, col0 = u.pn * BM + wc * 32 + 8 * fq;
        float rs[2][4];
        if (hssq) rs_load8(ring, u, wr, fr, rs); else {
#pragma unroll
            for (int i = 0; i < 8; ++i) rs[i >> 2][i & 3] = 1.0f; }
#pragma unroll
        for (int ai = 0; ai < 2; ++ai)
#pragma unroll
            for (int m = 0; m < 4; ++m) { const int row = row0 + ai * HALF + m * 16; bf16* rowp = O + (size_t)row * ldc + col0; float s = 0.f;
#pragma unroll
                for (int bj = 0; bj < 2; ++bj) { const f32x4 v0 = acc[ai][bj][m][0] * rs[ai][m], v1 = acc[ai][bj][m][1] * rs[ai][m];
                    v4u w; w.x = cvtpk(v0[0], v0[1]); w.y = cvtpk(v0[2], v0[3]); w.z = cvtpk(v1[0], v1[1]); w.w = cvtpk(v1[2], v1[3]);
                    *(GAS v4u*)(rowp + bj * HALF) = w;
                    s += (v0[0] * v0[0] + v0[1] * v0[1]) + (v0[2] * v0[2] + v0[3] * v0[3]) + (v1[0] * v1[0] + v1[1] * v1[1]) + (v1[2] * v1[2] + v1[3] * v1[3]); }
                { const int ln_ = fq * 16 + fr; s += shfl_xor_l(s, 16, ln_); s += shfl_xor_l(s, 32, ln_); }
                if (fq == 0) part[(ai * HALF + wr * 64 + m * 16 + fr) * 4 + wc] = s; }
        asm volatile("s_waitcnt lgkmcnt(0)" ::: "memory"); __builtin_amdgcn_s_barrier(); asm volatile("" ::: "memory");
        const int t = (wr * 4 + wc) * 64 + fq * 16 + fr;
        if (t < 256) { const f32x4 p = *(const LAS f32x4*)(part + t * 4); ssq[(size_t)(u.pm * BM + t) * 2 + u.pn] = (p[0] + p[1]) + (p[2] + p[3]); }
    }
};
struct EpiQraw {
    static constexpr bool PRE = false; static constexpr bool PERM = true;
    bf16* O; int ldc; const float* ssq;
    __device__ __forceinline__ void operator()(const f32x4 (&acc)[2][2][4][2], const Unit& u, int wr, int wc, int fr, int fq) const {
        const int row0 = u.pm * BM + wr * 64 + fr, col0 = u.pn * BM + wc * 32 + 8 * fq;
#pragma unroll
        for (int ai = 0; ai < 2; ++ai) { float rs[4];
#pragma unroll
            for (int m = 0; m < 4; ++m) { const int row = row0 + ai * HALF + m * 16; const GAS float* sp = (const GAS float*)ssq + (size_t)row * 2; rs[m] = 1.0f / sqrtf((sp[0] + sp[1]) * (1.0f / QLR) + EPS); }
#pragma unroll
            for (int m = 0; m < 4; ++m) { bf16* rowp = O + (size_t)(row0 + ai * HALF + m * 16) * ldc + col0;
#pragma unroll
                for (int bj = 0; bj < 2; ++bj) { const f32x4 v0 = acc[ai][bj][m][0] * rs[m], v1 = acc[ai][bj][m][1] * rs[m];
                    v4u w; w.x = cvtpk(v0[0], v0[1]); w.y = cvtpk(v0[2], v0[3]); w.z = cvtpk(v1[0], v1[1]); w.w = cvtpk(v1[2], v1[3]);
                    *(GAS v4u*)(rowp + bj * HALF) = w; } } }
    }
};
struct EpiKV {
    static constexpr bool PRE = false; static constexpr bool PERM = true;
    bf16* O; int ldc; float* rs; const float* ssqkr; LAS float* part;
    __device__ __forceinline__ void operator()(const f32x4 (&acc)[2][2][4][2], const Unit& u, int wr, int wc, int fr, int fq) const {
        const int row0 = u.pm * BM + wr * 64 + fr, col0 = u.pn * BM + wc * 32 + 8 * fq;
#pragma unroll
        for (int ai = 0; ai < 2; ++ai)
#pragma unroll
            for (int m = 0; m < 4; ++m) { const int row = row0 + ai * HALF + m * 16; bf16* rowp = O + (size_t)row * ldc + col0;
#pragma unroll
                for (int bj = 0; bj < 2; ++bj) { const f32x4 v0 = acc[ai][bj][m][0], v1 = acc[ai][bj][m][1];
                    v4u w; w.x = cvtpk(v0[0], v0[1]); w.y = cvtpk(v0[2], v0[3]); w.z = cvtpk(v1[0], v1[1]); w.w = cvtpk(v1[2], v1[3]);
                    *(GAS v4u*)(rowp + bj * HALF) = w; }
                const f32x4 k0 = acc[ai][0][m][0], k1 = acc[ai][0][m][1];
                float s = (k0[0] * k0[0] + k0[1] * k0[1]) + (k0[2] * k0[2] + k0[3] * k0[3]) + (k1[0] * k1[0] + k1[1] * k1[1]) + (k1[2] * k1[2] + k1[3] * k1[3]);
                { const int ln_ = fq * 16 + fr; s += shfl_xor_l(s, 16, ln_); s += shfl_xor_l(s, 32, ln_); }
                if (fq == 0) part[(ai * HALF + wr * 64 + m * 16 + fr) * 4 + wc] = s; }
        asm volatile("s_waitcnt lgkmcnt(0)" ::: "memory"); __builtin_amdgcn_s_barrier(); asm volatile("" ::: "memory");
        const int t = (wr * 4 + wc) * 64 + fq * 16 + fr;
        if (t < 256) { const f32x4 p = *(const LAS f32x4*)(part + t * 4); const int row = u.pm * BM + t;
            rs[(size_t)row * 16 + u.pn] = 1.0f / sqrtf(((p[0] + p[1]) + (p[2] + p[3]) + ((const GAS float*)ssqkr)[row]) * (1.0f / QKH) + EPS); }
    }
};
struct EpiRet {
    static constexpr bool PRE = (MK_NFOLD != 0); static constexpr bool PERM = true;
    bf16* O; int ldc; const float* cosT; const float* sinT;
    const float* ssq; LAS unsigned char* ring;
    __device__ __forceinline__ void prefetch(LAS unsigned char* lds, const Unit& u, int tid) const { if (ssq) rs_prefetch(lds, ssq, u, tid); }
    __device__ __forceinline__ void operator()(const f32x4 (&acc)[2][2][4][2], const Unit& u, int wr, int wc, int fr_, int fq_) const {
        int fr = fr_, fq = fq_; asm volatile("" : "+v"(fr), "+v"(fq));
        const int row0 = u.pm * BM + wr * 64 + fr, col0 = u.pn * BM + wc * 32 + 8 * fq, j0 = wc * 32 + 8 * fq;
        float rs[2][4];
        if (ssq) rs_load8(ring, u, wr, fr, rs); else {
#pragma unroll
            for (int i = 0; i < 8; ++i) rs[i >> 2][i & 3] = 1.0f; }
        if (u.pn < 16) {
            const int h = u.pn & 7; const bool isq = u.pn < 8; const float lg = lg2gamma(h);
#pragma unroll
            for (int ai = 0; ai < 2; ++ai) { if (u.half && ai != u.half - 1) continue;
                f32x4 c0[4], c1[4], s0[4], s1[4];
#pragma unroll
                for (int m = 0; m < 4; ++m) { const int row = row0 + ai * HALF + m * 16; const int pos = row < MP ? (row & (SEQ - 1)) : PAST + (row & (DSEQ - 1));
                    c0[m] = *(const GAS f32x4*)(cosT + pos * 128 + j0); c1[m] = *(const GAS f32x4*)(cosT + pos * 128 + j0 + 4);
                    s0[m] = *(const GAS f32x4*)(sinT + pos * 128 + j0); s1[m] = *(const GAS f32x4*)(sinT + pos * 128 + j0 + 4); }
#pragma unroll
                for (int m = 0; m < 4; ++m) { const int row = row0 + ai * HALF + m * 16; bf16* rowp = O + (size_t)row * ldc + col0;
                    const float e = (float)((row & 63) + 1) * lg;
                    const float fac = (isq ? __builtin_amdgcn_exp2f(e) * 0.0625f : __builtin_amdgcn_exp2f(-e)) * rs[ai][m];
                    const f32x4 x10 = acc[ai][0][m][0], x11 = acc[ai][0][m][1], x20 = acc[ai][1][m][0], x21 = acc[ai][1][m][1];
                    const f32x4 a0 = (x10 * c0[m] - x20 * s0[m]) * fac, a1 = (x11 * c1[m] - x21 * s1[m]) * fac, b0 = (x10 * s0[m] + x20 * c0[m]) * fac, b1 = (x11 * s1[m] + x21 * c1[m]) * fac;
                    v4u w; w.x = cvtpk(a0[0], a0[1]); w.y = cvtpk(a0[2], a0[3]); w.z = cvtpk(a1[0], a1[1]); w.w = cvtpk(a1[2], a1[3]);
                    *(GAS v4u*)rowp = w;
                    w.x = cvtpk(b0[0], b0[1]); w.y = cvtpk(b0[2], b0[3]); w.z = cvtpk(b1[0], b1[1]); w.w = cvtpk(b1[2], b1[3]);
                    *(GAS v4u*)(rowp + HALF) = w; }
                asm volatile("" ::: "memory"); }
        } else {
            const bool isg = u.pn >= 32;
#pragma unroll
            for (int ai = 0; ai < 2; ++ai) { if (u.half && ai != u.half - 1) continue;
#pragma unroll
                for (int m = 0; m < 4; ++m) { bf16* rowp = O + (size_t)(row0 + ai * HALF + m * 16) * ldc + col0;
#pragma unroll
                    for (int bj = 0; bj < 2; ++bj) { f32x4 v0 = acc[ai][bj][m][0] * rs[ai][m], v1 = acc[ai][bj][m][1] * rs[ai][m];
                        if (isg) {
#pragma unroll
                            for (int i = 0; i < 4; ++i) { v0[i] = silu_f(v0[i]); v1[i] = silu_f(v1[i]); } }
                        v4u w; w.x = cvtpk(v0[0], v0[1]); w.y = cvtpk(v0[2], v0[3]); w.z = cvtpk(v1[0], v1[1]); w.w = cvtpk(v1[2], v1[3]);
                        *(GAS v4u*)(rowp + bj * HALF) = w; } } }
        }
    }
};
struct Args { const float* in[25]; float* out; unsigned char* ws; int ph_lo, ph_hi, dry, pad; };
enum { I_XP = 0, I_XS, I_STATE, I_CCKV, I_CKR, I_F1N, I_F1IN, I_F1OUT, I_MIXN, I_F2N, I_F2IN, I_F2OUT, I_RIN, I_RGN, I_ROUT, I_KVN, I_WDKV, I_KVLN, I_WUKV, I_KN,
       I_WDQ, I_QLN, I_WUQ, I_QN, I_WO };
struct Frame { LAS unsigned char* lds; int tid, lane, wave, vcu, G; };

__device__ __forceinline__ int dst_row_map(int mode, int n) {
    if (mode == 1) { const int hf = n >= DFF ? 1 : 0; const int nn = n - hf * DFF; return (nn >> 7) * 256 + hf * 128 + (nn & 127); }
    return n;
}
template <int UNR = MK_CONVUNROLL>
__device__ __forceinline__ void conv_item(const float* W, int K, int N, bf16* WT, int mode, LAS float* scr, int item, int lane, int blocked = 0, const float* kgain = nullptr) {
    const int nblk = N >> 6, kb = item / nblk, nb = item - kb * nblk, k0 = 64 * kb, n0 = 64 * nb;
    const GAS float* src = (const GAS float*)W + (size_t)k0 * N + n0 + lane;
    f32x4 kg0 = {1.f, 1.f, 1.f, 1.f}, kg1 = kg0;
    if (kgain) { const GAS f32x4* gp = (const GAS f32x4*)(kgain + k0 + 8 * (lane & 7)); kg0 = gp[0]; kg1 = gp[1]; }
    if constexpr (UNR >= 64) { float t_[64];
#pragma unroll
        for (int i = 0; i < 64; ++i) t_[i] = src[(size_t)i * N];
#pragma unroll
        for (int i = 0; i < 64; ++i) scr[i * 65 + lane] = t_[i]; }
    else {
#pragma unroll UNR
        for (int i = 0; i < 64; ++i) scr[i * 65 + lane] = src[(size_t)i * N]; }
    LDS_WAIT(); asm volatile("" ::: "memory");
#if MK_WARMMFMA
    { f32x4 d_ = {0.f, 0.f, 0.f, 0.f}; bf16x8 z_ = {1, 2, 3, 4, 5, 6, 7, 8};
#pragma unroll
      for (int i = 0; i < MK_WARMMFMA; ++i) d_ = __builtin_amdgcn_mfma_f32_16x16x32_bf16(z_, z_, d_, 0, 0, 0);
      asm volatile("" :: "v"(d_)); }
#endif
    const int c = lane & 7;
#pragma unroll
    for (int j = 0; j < 8; ++j) { const int n = (lane >> 3) + 8 * j; const LAS float* s = scr + (8 * c) * 65 + n;
        v4u o; o.x = cvtpk(s[0 * 65] * kg0.x, s[1 * 65] * kg0.y); o.y = cvtpk(s[2 * 65] * kg0.z, s[3 * 65] * kg0.w); o.z = cvtpk(s[4 * 65] * kg1.x, s[5 * 65] * kg1.y); o.w = cvtpk(s[6 * 65] * kg1.z, s[7 * 65] * kg1.w);
        const int dr = dst_row_map(mode, n0 + n);
        *(GAS v4u*)(blocked ? WT + ((size_t)(dr >> 8) * (K >> 6) + kb) * (256 * 64) + (dr & 255) * 64 + 8 * c : WT + (size_t)dr * K + k0 + 8 * c) = o; }
    LDS_WAIT(); asm volatile("" ::: "memory");
}
__device__ __forceinline__ void sincos_d(double a, float& s, float& c) {
    const double q = __builtin_rint(a * 0.63661977236758134308);
    double r = __builtin_fma(-q, 1.57079632679489655800e+00, a); r = __builtin_fma(-q, 6.12323399573676603587e-17, r);
    const double r2 = r * r;
    const double sp = r * (1.0 + r2 * (-1.0 / 6 + r2 * (1.0 / 120 + r2 * (-1.0 / 5040 + r2 * (1.0 / 362880 + r2 * (-1.0 / 39916800 + r2 * (1.0 / 6227020800.0)))))));
    const double cp = 1.0 + r2 * (-0.5 + r2 * (1.0 / 24 + r2 * (-1.0 / 720 + r2 * (1.0 / 40320 + r2 * (-1.0 / 3628800 + r2 * (1.0 / 479001600.0))))));
    const int qi = (int)q & 3;
    s = (float)(qi == 0 ? sp : qi == 1 ? cp : qi == 2 ? -sp : -cp);
    c = (float)(qi == 0 ? cp : qi == 1 ? -sp : qi == 2 ? -cp : sp);
}
__device__ __forceinline__ double powi_d(double r, int j) { double o = 1.0, b = r; for (int k = 0; k < 8; ++k) { if (j & (1 << k)) o *= b; b *= b; } return o; }

__device__ __forceinline__ void rms_row_2048(const float* xrow, const float* g, bf16* orow, float* hrow, int lane, const float* prow = nullptr, size_t pq = 0, float* ssqp = nullptr) {
    const GAS f32x4* xr = (const GAS f32x4*)xrow + lane;
    f32x4 v[8]; float s = 0.f;
#pragma unroll
    for (int j = 0; j < 8; ++j) v[j] = xr[64 * j];
    if (prow) {
#pragma unroll
        for (int q = 0; q < 4; ++q) { const GAS f32x4* pr = (const GAS f32x4*)(prow + q * pq) + lane;
#pragma unroll
            for (int j = 0; j < 8; ++j) v[j] += pr[64 * j]; }
    }
#pragma unroll
    for (int j = 0; j < 8; ++j) s += (v[j].x * v[j].x + v[j].y * v[j].y) + (v[j].z * v[j].z + v[j].w * v[j].w);
    if (ssqp) { const float tot = wave_sum(s, lane); GAS v2u* o8 = (GAS v2u*)orow + lane;
#pragma unroll
        for (int j = 0; j < 8; ++j) { v2u w; w.x = cvtpk(v[j].x, v[j].y); w.y = cvtpk(v[j].z, v[j].w); o8[64 * j] = w; }
        if (lane == 0) ssq_row_store(ssqp, tot); }
    else if (g) { const GAS f32x4* gr = (const GAS f32x4*)g + lane;
        const float rs = 1.0f / sqrtf(wave_sum(s, lane) * (1.0f / DM) + EPS);
        GAS v2u* o8 = (GAS v2u*)orow + lane;
#pragma unroll
        for (int j = 0; j < 8; ++j) { const f32x4 gg = gr[64 * j]; v2u w; w.x = cvtpk(v[j].x * rs * gg.x, v[j].y * rs * gg.y); w.y = cvtpk(v[j].z * rs * gg.z, v[j].w * rs * gg.w); o8[64 * j] = w; } }
    if (hrow) { GAS f32x4* hr = (GAS f32x4*)hrow + lane;
#pragma unroll
        for (int j = 0; j < 8; ++j) hr[64 * j] = v[j]; }
}
__device__ __forceinline__ void rms_row2_2048(const float* xa, const float* xb, const float* g, bf16* oa, bf16* ob, int lane, float* qa = nullptr, float* qb = nullptr) {
    const GAS f32x4* ra = (const GAS f32x4*)xa + lane; const GAS f32x4* rb = (const GAS f32x4*)xb + lane; const GAS f32x4* gr = (const GAS f32x4*)g + lane;
    f32x4 va[8], vb[8]; float sa = 0.f, sb = 0.f;
#pragma unroll
    for (int j = 0; j < 8; ++j) va[j] = ra[64 * j];
#pragma unroll
    for (int j = 0; j < 8; ++j) vb[j] = rb[64 * j];
#pragma unroll
    for (int j = 0; j < 8; ++j) { sa += (va[j].x * va[j].x + va[j].y * va[j].y) + (va[j].z * va[j].z + va[j].w * va[j].w); sb += (vb[j].x * vb[j].x + vb[j].y * vb[j].y) + (vb[j].z * vb[j].z + vb[j].w * vb[j].w); }
    GAS v2u* pa = (GAS v2u*)oa + lane; GAS v2u* pb = (GAS v2u*)ob + lane;
    if (qa) { const float ta = wave_sum(sa, lane), tb = wave_sum(sb, lane);
#pragma unroll
        for (int j = 0; j < 8; ++j) { v2u w; w.x = cvtpk(va[j].x, va[j].y); w.y = cvtpk(va[j].z, va[j].w); pa[64 * j] = w; w.x = cvtpk(vb[j].x, vb[j].y); w.y = cvtpk(vb[j].z, vb[j].w); pb[64 * j] = w; }
        if (lane == 0) { ssq_row_store(qa, ta); ssq_row_store(qb, tb); }
        return; }
    const float rsa = 1.0f / sqrtf(wave_sum(sa, lane) * (1.0f / DM) + EPS), rsb = 1.0f / sqrtf(wave_sum(sb, lane) * (1.0f / DM) + EPS);
#pragma unroll
    for (int j = 0; j < 8; ++j) { const f32x4 gg = gr[64 * j]; v2u w;
        w.x = cvtpk(va[j].x * rsa * gg.x, va[j].y * rsa * gg.y); w.y = cvtpk(va[j].z * rsa * gg.z, va[j].w * rsa * gg.w); pa[64 * j] = w;
        w.x = cvtpk(vb[j].x * rsb * gg.x, vb[j].y * rsb * gg.y); w.y = cvtpk(vb[j].z * rsb * gg.z, vb[j].w * rsb * gg.w); pb[64 * j] = w; }
}
__device__ __forceinline__ void norm_phase(const Frame& F, float* h, const float* g, bf16* xn, const float* P, int pstride, int dry, const float* hin_s = nullptr, float* ssq = nullptr) {
    const int gw = F.vcu * NWAVES + F.wave, NGW = F.G * NWAVES;
    int m0 = gw;
    if (MK_NORM2) for (; m0 + NGW < MP; m0 += 2 * NGW) rms_row2_2048(h + (size_t)m0 * DM, h + (size_t)(m0 + NGW) * DM, g, xn + (size_t)m0 * DM, xn + (size_t)(m0 + NGW) * DM, F.lane, ssq ? ssq + (size_t)m0 * 8 : nullptr, ssq ? ssq + (size_t)(m0 + NGW) * 8 : nullptr);
    for (int m = m0; m < MT; m += NGW) { const bool fix = P != nullptr && m >= MP && F.G == 256;
        rms_row_2048((fix && hin_s) ? hin_s + (size_t)(m - MP) * DM : h + (size_t)m * DM, g, xn + (size_t)m * DM, (fix && !dry) ? h + (size_t)m * DM : nullptr, F.lane, fix ? P + (size_t)(m - MP) * pstride : nullptr, (size_t)MS * pstride, ssq ? ssq + (size_t)m * 8 : nullptr); }
}
__device__ __forceinline__ void tail_fix_phase(const Frame& F, float* h, bf16* xn, const float* P, int pstride, const float* hin_s, float* ssq) {
    const int gw = F.vcu * NWAVES + F.wave, NGW = F.G * NWAVES;
    if (F.G != 256) return;
    for (int m = MP + gw; m < MT; m += NGW)
        rms_row_2048(hin_s ? hin_s + (size_t)(m - MP) * DM : h + (size_t)m * DM, nullptr, xn + (size_t)m * DM, h + (size_t)m * DM, F.lane, P + (size_t)(m - MP) * pstride, (size_t)MS * pstride, ssq + (size_t)m * 8);
}
__device__ __forceinline__ void tail_row_b(const float* xrow, bf16* hb, float* yrow, const float* prow, size_t pq, float* ssqp, int lane) {
    f32x4 v[8];
    if (xrow) { const GAS f32x4* xr = (const GAS f32x4*)xrow + lane;
#pragma unroll
        for (int j = 0; j < 8; ++j) v[j] = xr[64 * j]; }
    else { const GAS v2u* hr = (const GAS v2u*)hb + lane; v2u w[8];
#pragma unroll
        for (int j = 0; j < 8; ++j) w[j] = hr[64 * j];
#pragma unroll
        for (int j = 0; j < 8; ++j) v[j] = (f32x4){bflo(w[j].x), bfhi(w[j].x), bflo(w[j].y), bfhi(w[j].y)}; }
#pragma unroll
    for (int q = 0; q < 4; ++q) { const GAS f32x4* pr = (const GAS f32x4*)(prow + q * pq) + lane;
#pragma unroll
        for (int j = 0; j < 8; ++j) v[j] += pr[64 * j]; }
    if (yrow) { GAS f32x4* yr = (GAS f32x4*)yrow + lane;
#pragma unroll
        for (int j = 0; j < 8; ++j) yr[64 * j] = v[j];
        return; }
    float s = 0.f;
#pragma unroll
    for (int j = 0; j < 8; ++j) s += (v[j].x * v[j].x + v[j].y * v[j].y) + (v[j].z * v[j].z + v[j].w * v[j].w);
    const float tot = wave_sum(s, lane); GAS v2u* o8 = (GAS v2u*)hb + lane;
#pragma unroll
    for (int j = 0; j < 8; ++j) { v2u w; w.x = cvtpk(v[j].x, v[j].y); w.y = cvtpk(v[j].z, v[j].w); o8[64 * j] = w; }
    if (lane == 0) ssq_row_store(ssqp, tot);
}
__device__ __forceinline__ void tail_fix_phase_b(const Frame& F, bf16* xn, float* yout, const float* P, int pstride, const float* xin_s, float* ssq) {
    const int gw = F.vcu * NWAVES + F.wave, NGW = F.G * NWAVES;
    if (F.G != 256) return;
    for (int m = MP + gw; m < MT; m += NGW)
        tail_row_b(xin_s ? xin_s + (size_t)(m - MP) * DM : nullptr, xn + (size_t)m * DM, yout ? yout + (size_t)m * DM : nullptr, P + (size_t)(m - MP) * pstride, (size_t)MS * pstride, ssq ? ssq + (size_t)m * 8 : nullptr, F.lane);
}
__device__ __forceinline__ void fixup_phase(const Frame& F, float* h, const float* P, int pstride, int dry) {
    const int gw = F.vcu * NWAVES + F.wave, NGW = F.G * NWAVES;
    if (F.G != 256) return;
    for (int m = MP + gw; m < MT; m += NGW) rms_row_2048(h + (size_t)m * DM, nullptr, nullptr, dry ? nullptr : h + (size_t)m * DM, F.lane, P + (size_t)(m - MP) * pstride, (size_t)MS * pstride);
}
__device__ __forceinline__ int kv_row_of_token(int tok) { return tok < MP ? tok : MP + ((tok - MP) >> 6) * KVT + PAST + (tok & 63); }
__device__ __forceinline__ int pos_of_token(int tok) { return tok < MP ? (tok & (SEQ - 1)) : PAST + (tok & (DSEQ - 1)); }

__device__ __forceinline__ void p0_prologue(const Args& A, const Frame& F) {
    unsigned char* ws = A.ws;
    const int gw = F.vcu * NWAVES + F.wave, NGW = F.G * NWAVES;
    LAS float* scr = (LAS float*)(F.lds + RING_OFF + F.wave * 16640);
    int base = 0;
#if MK_PRETOUCH
    {
        const size_t gt_ = (size_t)(gw * 64 + F.lane), NGT_ = (size_t)NGW * 64; unsigned acc_ = 0;
#define TOUCH(ptr, bytes) do { const GAS unsigned char* p_ = (const GAS unsigned char*)(ptr); for (size_t o_ = gt_ * 4096; o_ < (size_t)(bytes); o_ += NGT_ * 4096) acc_ += *(const GAS unsigned*)(p_ + o_); } while (0)
        TOUCH(ws, WS_END); TOUCH(A.out, OUT_END * 4);
        TOUCH(A.in[I_XP], (size_t)MP * DM * 4); TOUCH(A.in[I_XS], (size_t)MS * DM * 4); TOUCH(A.in[I_STATE], (size_t)NBS * RH * RDK * RDV * 4); TOUCH(A.in[I_CCKV], (size_t)NBS * PAST * KVL * 4); TOUCH(A.in[I_CKR], (size_t)NBS * PAST * ROPE * 4);
        TOUCH(A.in[I_F1IN], (size_t)2 * DM * 2 * DFF * 4); TOUCH(A.in[I_F2IN], (size_t)2 * DM * 2 * DFF * 4); TOUCH(A.in[I_F1OUT], (size_t)2 * DFF * DM * 4); TOUCH(A.in[I_F2OUT], (size_t)2 * DFF * DM * 4);
        TOUCH(A.in[I_RIN], (size_t)DM * RIN * 4); TOUCH(A.in[I_ROUT], (size_t)RHV * DM * 4); TOUCH(A.in[I_WO], (size_t)DM * DM * 4); TOUCH(A.in[I_WUKV], (size_t)KVL * KVW * 4);
#undef TOUCH
        if (acc_ == 0x9e3779b9u && gt_ == 0x7ffffffful) ((GAS unsigned*)ws)[1] = acc_;
    }
#endif
#define CONV(Wp, Kk, Nn, dst, mode) CONVG(Wp, Kk, Nn, dst, mode, 0, nullptr)
#define CONVB(Wp, Kk, Nn, dst, mode, blk) CONVG(Wp, Kk, Nn, dst, mode, blk, nullptr)
#define CONVG(Wp, Kk, Nn, dst, mode, blk, kg) do { const int nitems = ((Kk) >> 6) * ((Nn) >> 6); \
        for (int it = ((gw - base) % NGW + NGW) % NGW; it < nitems; it += NGW) conv_item((Wp), (Kk), (Nn), (bf16*)(ws + (dst)), (mode), scr, it, F.lane, (blk), (kg)); base = (base + nitems) % NGW; } while (0)
    CONVG(A.in[I_F1IN], DM, 2 * DFF, WS_WIN00, 1, 0, MK_NFOLD ? A.in[I_F1N] : nullptr);
    const bool defer = MK_DEFER && F.G == 256, defer2 = MK_DEFER == 2 && F.G == 256;
    if (!defer) CONVG(A.in[I_F1IN] + (size_t)DM * 2 * DFF, DM, 2 * DFF, WS_WIN10, 1, 0, MK_NFOLD ? A.in[I_F1N] + DM : nullptr);
    if (!defer2) CONVG(A.in[I_F2IN], DM, 2 * DFF, WS_WIN01, 1, 0, MK_NFOLD ? A.in[I_F2N] : nullptr);
    if (!defer) CONVG(A.in[I_F2IN] + (size_t)DM * 2 * DFF, DM, 2 * DFF, WS_WIN11, 1, 0, MK_NFOLD ? A.in[I_F2N] + DM : nullptr);
    if (!defer2) CONVB(A.in[I_F1OUT], DFF, DM, WS_WOUT00, 0, MK_BLK);
    if (!defer) CONVB(A.in[I_F1OUT] + (size_t)DFF * DM, DFF, DM, WS_WOUT10, 0, MK_BLK);
    if (!defer2) CONVB(A.in[I_F2OUT], DFF, DM, WS_WOUT01, 0, MK_BLK);
    if (!defer) CONVB(A.in[I_F2OUT] + (size_t)DFF * DM, DFF, DM, WS_WOUT11, 0, MK_BLK);
    if (!defer2) CONVG(A.in[I_RIN], DM, RIN, WS_WRIN, 0, 0, MK_NFOLD ? A.in[I_MIXN] : nullptr);
    if (!defer2) CONV(A.in[I_ROUT], RHV, DM, WS_WROUT, 0);
    if (!defer2) CONVG(A.in[I_WDKV], DM, KVL + ROPE, WS_WDKV, 0, 0, MK_NFOLD ? A.in[I_KVN] : nullptr);
    if (!defer2) CONV(A.in[I_WUKV], KVL, KVW, WS_WUKV, 0);
    if (!defer2) CONVG(A.in[I_WDQ], DM, QLR, WS_WDQ, 0, 0, MK_NFOLD ? A.in[I_MIXN] + DM : nullptr);
    if (!defer2) CONVG(A.in[I_WUQ], QLR, QW, WS_WUQ, 0, 0, MK_QLFUSE ? A.in[I_QLN] : nullptr);
    if (!defer2) CONV(A.in[I_WO], DM, DM, WS_WO, 0);
#undef CONV
#undef CONVB
#undef CONVG
    const int gt = gw * 64 + F.lane, NGT = NGW * 64;
    for (int i = gt; i < (DKVP - KVL - ROPE) * DM / 8; i += NGT) *((GAS v4u*)(ws + WS_WDKV + (size_t)(KVL + ROPE) * DM * 2) + i) = (v4u){0u, 0u, 0u, 0u};
    for (int i = gt; i < 2048 * 128; i += NGT) { const int pos = i >> 7, j = i & 127; float s, c; sincos_d((double)pos * powi_d(0.930572040929699, j), s, c);
        ((GAS float*)(ws + WS_COSR))[i] = c; ((GAS float*)(ws + WS_SINR))[i] = s; }
    for (int i = gt; i < 2048 * 32; i += NGT) { const int pos = i >> 5, j = i & 31; float s, c; sincos_d((double)pos * powi_d(0.7498942093324559, j), s, c);
        ((GAS float*)(ws + WS_COSM))[i] = c; ((GAS float*)(ws + WS_SINM))[i] = s; }
    if (gt < QKH) ((GAS float*)(ws + WS_GQK))[gt] = A.in[I_QN][gt] * A.in[I_KN][gt] * 0.10411754627697264f;
    for (int r0 = gw; r0 < NBS * PAST; r0 += 2 * NGW) {
        f32x4 a[2], bb[2]; float kr[2]; int kvrow[2];
#pragma unroll
        for (int q = 0; q < 2; ++q) { const int r = (r0 + q * NGW < NBS * PAST) ? r0 + q * NGW : r0; const int b = r >> 10, s = r & (PAST - 1); kvrow[q] = MP + b * KVT + s;
            const GAS f32x4* src = (const GAS f32x4*)(A.in[I_CCKV] + (size_t)r * KVL) + 2 * F.lane; a[q] = src[0]; bb[q] = src[1];
            kr[q] = ((const GAS float*)A.in[I_CKR])[(size_t)r * ROPE + F.lane]; }
        float q2[2] = {kr[0] * kr[0], kr[1] * kr[1]};
#pragma unroll
        for (int o = 1; o < 64; o <<= 1) { q2[0] += shfl_xor_l(q2[0], o, F.lane); q2[1] += shfl_xor_l(q2[1], o, F.lane); }
#pragma unroll
        for (int q = 0; q < 2; ++q) { v4u w; w.x = cvtpk(a[q].x, a[q].y); w.y = cvtpk(a[q].z, a[q].w); w.z = cvtpk(bb[q].x, bb[q].y); w.w = cvtpk(bb[q].z, bb[q].w);
            *((GAS v4u*)(ws + WS_CALL + (size_t)kvrow[q] * KVL * 2) + F.lane) = w;
            ((GAS bf16*)(ws + WS_KRALL))[(size_t)kvrow[q] * ROPE + F.lane] = (bf16)(cvtpk(kr[q], 0.f) & 0xffffu);
            if (F.lane == 0) ((GAS float*)(ws + WS_SSQKR))[kvrow[q]] = q2[q]; } }
    { int m0 = gw;
      float* q0 = MK_NFOLD ? (float*)(ws + WS_SSQH) : nullptr;
      for (; m0 + NGW < MP; m0 += 2 * NGW) rms_row2_2048(A.in[I_XP] + (size_t)m0 * DM, A.in[I_XP] + (size_t)(m0 + NGW) * DM, A.in[I_F1N], (bf16*)(ws + WS_XN) + (size_t)m0 * DM, (bf16*)(ws + WS_XN) + (size_t)(m0 + NGW) * DM, F.lane, q0 ? q0 + (size_t)m0 * 8 : nullptr, q0 ? q0 + (size_t)(m0 + NGW) * 8 : nullptr);
      for (int m = m0; m < MT; m += NGW) { const float* xrow = m < MP ? A.in[I_XP] + (size_t)m * DM : A.in[I_XS] + (size_t)(m - MP) * DM;
        rms_row_2048(xrow, A.in[I_F1N], (bf16*)(ws + WS_XN) + (size_t)m * DM, nullptr, F.lane, nullptr, 0, q0 ? q0 + (size_t)m * 8 : nullptr); } }
}

struct DefD { const float* W; int K, N; bf16* WT; int mode, blocked; const float* kg; int item; };
__device__ __forceinline__ void conv_load64(const DefD& d, int lane, float (&t)[64], f32x4 (&kg)[2]) {
    const int nblk = d.N >> 6, kb = d.item / nblk, nb = d.item - kb * nblk, k0 = 64 * kb, n0 = 64 * nb;
    const GAS float* src = (const GAS float*)d.W + (size_t)k0 * d.N + n0 + lane;
#pragma unroll
    for (int i = 0; i < 64; ++i) t[i] = MK_DEFNT ? __builtin_nontemporal_load(src + (size_t)i * d.N) : src[(size_t)i * d.N];
    kg[0] = (f32x4){1.f, 1.f, 1.f, 1.f}; kg[1] = kg[0];
    if (d.kg) { const GAS f32x4* gp = (const GAS f32x4*)(d.kg + k0 + 8 * (lane & 7)); kg[0] = gp[0]; kg[1] = gp[1]; }
}
__device__ __forceinline__ void conv_finish64(const DefD& d, LAS float* scr, int lane, const float (&t)[64], const f32x4 (&kg)[2]) {
    const int nblk = d.N >> 6, kb = d.item / nblk, nb = d.item - kb * nblk, k0 = 64 * kb, n0 = 64 * nb;
#pragma unroll
    for (int i = 0; i < 64; ++i) scr[i * 65 + lane] = t[i];
    LDS_WAIT(); asm volatile("" ::: "memory");
    const int c = lane & 7;
#pragma unroll
    for (int j = 0; j < 8; ++j) { const int n = (lane >> 3) + 8 * j; const LAS float* s = scr + (8 * c) * 65 + n;
        v4u o; o.x = cvtpk(s[0 * 65] * kg[0].x, s[1 * 65] * kg[0].y); o.y = cvtpk(s[2 * 65] * kg[0].z, s[3 * 65] * kg[0].w); o.z = cvtpk(s[4 * 65] * kg[1].x, s[5 * 65] * kg[1].y); o.w = cvtpk(s[6 * 65] * kg[1].z, s[7 * 65] * kg[1].w);
        const int dr = dst_row_map(d.mode, n0 + n);
        GAS v4u* op = (GAS v4u*)(d.blocked ? d.WT + ((size_t)(dr >> 8) * (d.K >> 6) + kb) * (256 * 64) + (dr & 255) * 64 + 8 * c : d.WT + (size_t)dr * d.K + k0 + 8 * c);
        if (MK_DEFNT) __builtin_nontemporal_store(o, op); else *op = o; }
    LDS_WAIT(); asm volatile("" ::: "memory");
}
__device__ __forceinline__ void conv_deferred(const Args& A, const Frame& F, int slot) {
    if (!(MK_DEFER && F.G == 256)) return;
    unsigned char* ws = A.ws; LAS float* scr = (LAS float*)(F.lds + RING_OFF + F.wave * 16640);
#if MK_DEFER == 2
    if (slot > 5) return;
    const int first = slot == 1 ? 128 : slot == 4 ? 144 : 96;
    const int q0 = slot == 0 ? 0 : slot == 1 ? 8960 : slot == 2 ? 16640 : slot == 3 ? 25376 : slot == 4 ? 30368 : 36000, q1 = slot == 0 ? 8960 : slot == 1 ? 16640 : slot == 2 ? 25376 : slot == 3 ? 30368 : slot == 4 ? 36000 : 38816;
    const int qm = q0 + (int)((long)(q1 - q0) * (slot == 0 ? MK_DEFSPLIT0 : slot == 1 ? MK_DEFSPLIT1 : slot == 2 ? MK_DEFSPLIT2 : slot == 3 ? MK_DEFSPLIT3 : MK_DEFSPLIT4) / 1000);
    const bool idle = (int)blockIdx.x >= first;
    const int nidle = idle ? 256 - first : first, r = idle ? (int)blockIdx.x - first : (int)blockIdx.x, s0 = idle ? q0 : qm, s1 = idle ? qm : q1;
    auto desc = [&](int it) -> DefD {
        if (it < 2816) return DefD{A.in[I_F1OUT], DFF, DM, (bf16*)(ws + WS_WOUT00), 0, MK_BLK, nullptr, it};
        if (it < 8960) return DefD{A.in[I_RIN], DM, RIN, (bf16*)(ws + WS_WRIN), 0, 0, MK_NFOLD ? A.in[I_MIXN] : nullptr, it - 2816};
        if (it < 11008) return DefD{A.in[I_ROUT], RHV, DM, (bf16*)(ws + WS_WROUT), 0, 0, nullptr, it - 8960};
        if (it < 16640) return DefD{A.in[I_F2IN], DM, 2 * DFF, (bf16*)(ws + WS_WIN01), 1, 0, MK_NFOLD ? A.in[I_F2N] : nullptr, it - 11008};
        if (it < 19456) return DefD{A.in[I_F2OUT], DFF, DM, (bf16*)(ws + WS_WOUT01), 0, MK_BLK, nullptr, it - 16640};
        if (it < 19744) return DefD{A.in[I_WDKV], DM, KVL + ROPE, (bf16*)(ws + WS_WDKV), 0, 0, MK_NFOLD ? A.in[I_KVN] : nullptr, it - 19456};
        if (it < 25376) return DefD{A.in[I_F1IN] + (size_t)DM * 2 * DFF, DM, 2 * DFF, (bf16*)(ws + WS_WIN10), 1, 0, MK_NFOLD ? A.in[I_F1N] + DM : nullptr, it - 19744};
        if (it < 28192) return DefD{A.in[I_F1OUT] + (size_t)DFF * DM, DFF, DM, (bf16*)(ws + WS_WOUT10), 0, MK_BLK, nullptr, it - 25376};
        if (it < 28448) return DefD{A.in[I_WDQ], DM, QLR, (bf16*)(ws + WS_WDQ), 0, 0, MK_NFOLD ? A.in[I_MIXN] + DM : nullptr, it - 28192};
        if (it < 28832) return DefD{A.in[I_WUQ], QLR, QW, (bf16*)(ws + WS_WUQ), 0, 0, MK_QLFUSE ? A.in[I_QLN] : nullptr, it - 28448};
        if (it < 29344) return DefD{A.in[I_WUKV], KVL, KVW, (bf16*)(ws + WS_WUKV), 0, 0, nullptr, it - 28832};
        if (it < 30368) return DefD{A.in[I_WO], DM, DM, (bf16*)(ws + WS_WO), 0, 0, nullptr, it - 29344};
        if (it < 36000) return DefD{A.in[I_F2IN] + (size_t)DM * 2 * DFF, DM, 2 * DFF, (bf16*)(ws + WS_WIN11), 1, 0, MK_NFOLD ? A.in[I_F2N] + DM : nullptr, it - 30368};
        return DefD{A.in[I_F2OUT] + (size_t)DFF * DM, DFF, DM, (bf16*)(ws + WS_WOUT11), 0, MK_BLK, nullptr, it - 36000}; };
    int it = s0 + r * NWAVES + F.wave; const int st = nidle * NWAVES;
    if (it >= s1) return;
    float ta[64]; f32x4 ka[2]; DefD d = desc(it); conv_load64(d, F.lane, ta, ka);
    for (;;) { const int itn = it + st; const bool more = itn < s1; DefD dn = d; float tb[64]; f32x4 kb[2];
        if (more) { dn = desc(itn); conv_load64(dn, F.lane, tb, kb); }
        conv_finish64(d, scr, F.lane, ta, ka);
        if (!more) break;
#pragma unroll
        for (int i = 0; i < 64; ++i) ta[i] = tb[i];
        ka[0] = kb[0]; ka[1] = kb[1]; d = dn; it = itn; }
#else
    if (slot > 3) return;
    const int first = slot == 1 ? 128 : 96, nidle = 256 - first, r = (int)blockIdx.x - first;
    if (r < 0) return;
    const int s0 = slot == 0 ? 0 : slot == 1 ? 5120 : slot == 2 ? 9216 : 14336, s1 = slot == 0 ? 5120 : slot == 1 ? 9216 : slot == 2 ? 14336 : 16896;
    for (int it = s0 + r * NWAVES + F.wave; it < s1; it += nidle * NWAVES) {
        if (it < 5632) conv_item<MK_DEFUNROLL>(A.in[I_F1IN] + (size_t)DM * 2 * DFF, DM, 2 * DFF, (bf16*)(ws + WS_WIN10), 1, scr, it, F.lane, 0, MK_NFOLD ? A.in[I_F1N] + DM : nullptr);
        else if (it < 8448) conv_item<MK_DEFUNROLL>(A.in[I_F1OUT] + (size_t)DFF * DM, DFF, DM, (bf16*)(ws + WS_WOUT10), 0, scr, it - 5632, F.lane, MK_BLK, nullptr);
        else if (it < 14080) conv_item<MK_DEFUNROLL>(A.in[I_F2IN] + (size_t)DM * 2 * DFF, DM, 2 * DFF, (bf16*)(ws + WS_WIN11), 1, scr, it - 8448, F.lane, 0, MK_NFOLD ? A.in[I_F2N] + DM : nullptr);
        else conv_item<MK_DEFUNROLL>(A.in[I_F2OUT] + (size_t)DFF * DM, DFF, DM, (bf16*)(ws + WS_WOUT11), 0, scr, it - 14080, F.lane, MK_BLK, nullptr);
    }
#endif
}
static_assert((DM / 64) * (2 * DFF / 64) == 5632 && (DFF / 64) * (DM / 64) == 2816 && (DM / 64) * (RIN / 64) == 6144 && (RHV / 64) * (DM / 64) == 2048 && (DM / 64) * ((KVL + ROPE) / 64) == 288
              && (DM / 64) * (QLR / 64) == 256 && (QLR / 64) * (QW / 64) == 384 && (KVL / 64) * (KVW / 64) == 512 && (DM / 64) * (DM / 64) == 1024, "deferred item counts");

__device__ __forceinline__ void gn_gate_phase(const Args& A, const Frame& F) {
    const int gw = F.vcu * NWAVES + F.wave, NGW = F.G * NWAVES; bf16* QKVG = (bf16*)(A.ws + WS_BIG);
    for (int it = gw; it < MT * 2; it += NGW) { const int tok = it >> 1, h0 = (it & 1) * 4;
        bf16* op = QKVG + (size_t)tok * RIN + 4096 + h0 * RDV + 8 * F.lane;
        v4u ow[4], gv[4];
#pragma unroll
        for (int q = 0; q < 4; ++q) { ow[q] = *(const GAS v4u*)(op + q * RDV); gv[q] = *(const GAS v4u*)(op + q * RDV + 4096); }
        float x[4][8], s[4];
#pragma unroll
        for (int q = 0; q < 4; ++q) { x[q][0] = bflo(ow[q].x); x[q][1] = bfhi(ow[q].x); x[q][2] = bflo(ow[q].y); x[q][3] = bfhi(ow[q].y); x[q][4] = bflo(ow[q].z); x[q][5] = bfhi(ow[q].z); x[q][6] = bflo(ow[q].w); x[q][7] = bfhi(ow[q].w);
            s[q] = ((x[q][0] + x[q][1]) + (x[q][2] + x[q][3])) + ((x[q][4] + x[q][5]) + (x[q][6] + x[q][7])); }
#pragma unroll
        for (int o = 1; o < 64; o <<= 1) {
#pragma unroll
            for (int q = 0; q < 4; ++q) s[q] += shfl_xor_l(s[q], o, F.lane); }
        float v[4];
#pragma unroll
        for (int q = 0; q < 4; ++q) { const float mu = s[q] * (1.0f / RDV); v[q] = 0.f;
#pragma unroll
            for (int i = 0; i < 8; ++i) { x[q][i] -= mu; v[q] += x[q][i] * x[q][i]; } }
#pragma unroll
        for (int o = 1; o < 64; o <<= 1) {
#pragma unroll
            for (int q = 0; q < 4; ++q) v[q] += shfl_xor_l(v[q], o, F.lane); }
#pragma unroll
        for (int q = 0; q < 4; ++q) { const float rstd = 1.0f / sqrtf(v[q] * (1.0f / RDV) + EPS);
            const GAS f32x4* gp = (const GAS f32x4*)(A.in[I_RGN] + (h0 + q) * RDV + 8 * F.lane); const f32x4 g0 = gp[0], g1 = gp[1];
            const float gg[8] = {g0.x, g0.y, g0.z, g0.w, g1.x, g1.y, g1.z, g1.w};
            const float sg[8] = {bflo(gv[q].x), bfhi(gv[q].x), bflo(gv[q].y), bfhi(gv[q].y), bflo(gv[q].z), bfhi(gv[q].z), bflo(gv[q].w), bfhi(gv[q].w)};
            float y[8];
#pragma unroll
            for (int i = 0; i < 8; ++i) y[i] = sg[i] * (x[q][i] * rstd * gg[i]);
            v4u w; w.x = cvtpk(y[0], y[1]); w.y = cvtpk(y[2], y[3]); w.z = cvtpk(y[4], y[5]); w.w = cvtpk(y[6], y[7]);
            if (!A.dry) *(GAS v4u*)(op + q * RDV) = w; }
    }
}

__device__ __forceinline__ void latent_phase(const Args& A, const Frame& F) {
    const int gw = F.vcu * NWAVES + F.wave, NGW = F.G * NWAVES; unsigned char* ws = A.ws;
    for (int tok = gw; tok < MT; tok += NGW) {
        const GAS float* row = (const GAS float*)(ws + WS_SMALL) + (size_t)tok * DKVP;
        f32x4 a = ((const GAS f32x4*)row)[F.lane], b = ((const GAS f32x4*)row)[64 + F.lane];
        float rsh = 1.0f;
        if (MK_NFOLD) { const GAS f32x4* qp = (const GAS f32x4*)(ws + WS_SSQH + 3 * SSQH_STRIDE) + (size_t)tok * 2; rsh = rs_of8(qp[0], qp[1]); a *= rsh; b *= rsh; }
        const float ss = wave_sum((a.x * a.x + a.y * a.y) + (a.z * a.z + a.w * a.w) + (b.x * b.x + b.y * b.y) + (b.z * b.z + b.w * b.w), F.lane);
        const float rs = 1.0f / sqrtf(ss * (1.0f / KVL) + EPS);
        const f32x4 ga = ((const GAS f32x4*)A.in[I_KVLN])[F.lane], gb = ((const GAS f32x4*)A.in[I_KVLN])[64 + F.lane];
        const f32x4 ca = a * rs * ga, cb = b * rs * gb;
        float* cout = tok < MP ? A.out + OUT_CKVP + (size_t)tok * KVL : A.out + OUT_CKVS + (size_t)(tok - MP) * KVL;
        if (!A.dry) { ((GAS f32x4*)cout)[F.lane] = ca; ((GAS f32x4*)cout)[64 + F.lane] = cb; }
        const int kvrow = kv_row_of_token(tok), pos = pos_of_token(tok);
        GAS v2u* cb16 = (GAS v2u*)(ws + WS_CALL + (size_t)kvrow * KVL * 2);
        v2u w; w.x = cvtpk(ca.x, ca.y); w.y = cvtpk(ca.z, ca.w); cb16[F.lane] = w; w.x = cvtpk(cb.x, cb.y); w.y = cvtpk(cb.z, cb.w); cb16[64 + F.lane] = w;
        const int j = F.lane & 31;
        const float x1 = row[KVL + j] * rsh, x2 = row[KVL + 32 + j] * rsh;
        const float c = ((const GAS float*)(ws + WS_COSM))[pos * 32 + j], s = ((const GAS float*)(ws + WS_SINM))[pos * 32 + j];
        const float o1 = x1 * c - x2 * s, o2 = x1 * s + x2 * c;
        float* kout = tok < MP ? A.out + OUT_KRP + (size_t)tok * ROPE : A.out + OUT_KRS + (size_t)(tok - MP) * ROPE;
        GAS bf16* kb = (GAS bf16*)(ws + WS_KRALL) + (size_t)kvrow * ROPE;
        if (F.lane < 32 && !A.dry) { ((GAS float*)kout)[j] = o1; ((GAS float*)kout)[32 + j] = o2; kb[j] = (bf16)(cvtpk(o1, 0.f) & 0xffffu); kb[32 + j] = (bf16)(cvtpk(o2, 0.f) & 0xffffu); }
        const float q = wave_sum(F.lane < 32 ? (o1 * o1 + o2 * o2) : 0.f, F.lane);
        if (F.lane == 0) ((GAS float*)(ws + WS_SSQKR))[kvrow] = q;
        if (!MK_NFOLD) rms_row_2048(A.out + (size_t)tok * DM, A.in[I_F1N] + DM, (bf16*)(ws + WS_XN) + (size_t)tok * DM, nullptr, F.lane);
    }
}
__device__ __forceinline__ void qlat_norm_phase(const Args& A, const Frame& F) {
    const int gw = F.vcu * NWAVES + F.wave, NGW = F.G * NWAVES; unsigned char* ws = A.ws;
    for (int tok = gw; tok < MT; tok += NGW) {
        const GAS f32x4* row = (const GAS f32x4*)(ws + WS_SMALL) + (size_t)tok * (QLR / 4);
        const f32x4 a = row[F.lane], b = row[64 + F.lane];
        const float ss = wave_sum((a.x * a.x + a.y * a.y) + (a.z * a.z + a.w * a.w) + (b.x * b.x + b.y * b.y) + (b.z * b.z + b.w * b.w), F.lane);
        const float rs = 1.0f / sqrtf(ss * (1.0f / QLR) + EPS);
        const f32x4 ga = ((const GAS f32x4*)A.in[I_QLN])[F.lane], gb = ((const GAS f32x4*)A.in[I_QLN])[64 + F.lane];
        const f32x4 ca = a * rs * ga, cb = b * rs * gb;
        GAS v2u* o = (GAS v2u*)(ws + WS_QLN + (size_t)tok * QLR * 2);
        v2u w; w.x = cvtpk(ca.x, ca.y); w.y = cvtpk(ca.z, ca.w); o[F.lane] = w; w.x = cvtpk(cb.x, cb.y); w.y = cvtpk(cb.z, cb.w); o[64 + F.lane] = w;
    }
}
__device__ __forceinline__ void qfin_phase(const Args& A, const Frame& F) {
    const int gw = F.vcu * NWAVES + F.wave, NGW = F.G * NWAVES; unsigned char* ws = A.ws;
    const int head = F.lane >> 2, sub = F.lane & 3;
    const GAS float* gqk = (const GAS float*)(ws + WS_GQK);
    float gn[32], ga[8], gb[8];
#pragma unroll
    for (int i = 0; i < 32; ++i) gn[i] = gqk[32 * sub + i];
#pragma unroll
    for (int i = 0; i < 8; ++i) { ga[i] = gqk[NOPE + 8 * sub + i]; gb[i] = gqk[NOPE + 32 + 8 * sub + i]; }
    struct Row { v4u nw[4], r1, r2; f32x4 c0, c1, s0, s1; };
#define QF_LOAD(R, tok) do { const bf16* b_ = (const bf16*)(ws + WS_Q) + (size_t)(tok) * QW + head * QKH; \
        _Pragma("unroll") for (int i = 0; i < 4; ++i) R.nw[i] = *(const GAS v4u*)(b_ + 32 * sub + 8 * i); \
        R.r1 = *(const GAS v4u*)(b_ + NOPE + 8 * sub); R.r2 = *(const GAS v4u*)(b_ + NOPE + 32 + 8 * sub); const int pos_ = pos_of_token(tok); \
        const GAS f32x4* cp_ = (const GAS f32x4*)((const GAS float*)(ws + WS_COSM) + pos_ * 32 + 8 * sub); const GAS f32x4* sp_ = (const GAS f32x4*)((const GAS float*)(ws + WS_SINM) + pos_ * 32 + 8 * sub); \
        R.c0 = cp_[0]; R.c1 = cp_[1]; R.s0 = sp_[0]; R.s1 = sp_[1]; } while (0)
    Row cur, nxt;
    if (gw < MT) QF_LOAD(cur, gw);
    for (int tok = gw; tok < MT; tok += NGW) {
        const bool more = tok + NGW < MT;
        if (more) QF_LOAD(nxt, tok + NGW);
        bf16* base = (bf16*)(ws + WS_Q) + (size_t)tok * QW + head * QKH;
        const float cc[8] = {cur.c0.x, cur.c0.y, cur.c0.z, cur.c0.w, cur.c1.x, cur.c1.y, cur.c1.z, cur.c1.w}, sn[8] = {cur.s0.x, cur.s0.y, cur.s0.z, cur.s0.w, cur.s1.x, cur.s1.y, cur.s1.z, cur.s1.w};
        const float a[8] = {bflo(cur.r1.x), bfhi(cur.r1.x), bflo(cur.r1.y), bfhi(cur.r1.y), bflo(cur.r1.z), bfhi(cur.r1.z), bflo(cur.r1.w), bfhi(cur.r1.w)};
        const float b[8] = {bflo(cur.r2.x), bfhi(cur.r2.x), bflo(cur.r2.y), bfhi(cur.r2.y), bflo(cur.r2.z), bfhi(cur.r2.z), bflo(cur.r2.w), bfhi(cur.r2.w)};
        float ra[8], rb[8], ss = 0.f;
#pragma unroll
        for (int i = 0; i < 8; ++i) { ra[i] = a[i] * cc[i] - b[i] * sn[i]; rb[i] = a[i] * sn[i] + b[i] * cc[i]; ss += ra[i] * ra[i] + rb[i] * rb[i]; }
        float nf[32];
#pragma unroll
        for (int i = 0; i < 4; ++i) { nf[8 * i + 0] = bflo(cur.nw[i].x); nf[8 * i + 1] = bfhi(cur.nw[i].x); nf[8 * i + 2] = bflo(cur.nw[i].y); nf[8 * i + 3] = bfhi(cur.nw[i].y);
            nf[8 * i + 4] = bflo(cur.nw[i].z); nf[8 * i + 5] = bfhi(cur.nw[i].z); nf[8 * i + 6] = bflo(cur.nw[i].w); nf[8 * i + 7] = bfhi(cur.nw[i].w); }
#pragma unroll
        for (int i = 0; i < 32; ++i) ss += nf[i] * nf[i];
        ss += shfl_xor_l(ss, 1, F.lane); ss += shfl_xor_l(ss, 2, F.lane);
        const float rs = 1.0f / sqrtf(ss * (1.0f / QKH) + EPS);
#pragma unroll
        for (int i = 0; i < 4; ++i) { float o[8];
#pragma unroll
            for (int e = 0; e < 8; ++e) o[e] = nf[8 * i + e] * rs * gn[8 * i + e];
            v4u w; w.x = cvtpk(o[0], o[1]); w.y = cvtpk(o[2], o[3]); w.z = cvtpk(o[4], o[5]); w.w = cvtpk(o[6], o[7]);
            if (!A.dry) *(GAS v4u*)(base + 32 * sub + 8 * i) = w; }
        { float o[8], p[8];
#pragma unroll
            for (int e = 0; e < 8; ++e) { o[e] = ra[e] * rs * ga[e]; p[e] = rb[e] * rs * gb[e]; }
            v4u w; w.x = cvtpk(o[0], o[1]); w.y = cvtpk(o[2], o[3]); w.z = cvtpk(o[4], o[5]); w.w = cvtpk(o[6], o[7]);
            if (!A.dry) *(GAS v4u*)(base + NOPE + 8 * sub) = w;
            w.x = cvtpk(p[0], p[1]); w.y = cvtpk(p[2], p[3]); w.z = cvtpk(p[4], p[5]); w.w = cvtpk(p[6], p[7]);
            if (!A.dry) *(GAS v4u*)(base + NOPE + 32 + 8 * sub) = w; }
        if (more) cur = nxt;
    }
#undef QF_LOAD
}
constexpr int SC_QS = 264, SC_KS = 272, SC_VS = 144, SC_PS = 72;
constexpr int SC_Q = 0, SC_K = SC_Q + 64 * SC_QS * 2, SC_V = SC_K + 64 * SC_KS * 2, SC_P = SC_V + 64 * SC_VS * 2, SC_END = SC_P + 64 * SC_PS * 2;
static_assert(SC_END <= RING_BYTES, "scan LDS");
__device__ __forceinline__ s16x4 tr16(const LAS unsigned char* p) {
    typedef short v4i16_t __attribute__((ext_vector_type(4)));
    return __builtin_bit_cast(s16x4, __builtin_amdgcn_ds_read_tr16_b64_v4i16((LAS v4i16_t*)p)); }
__device__ __forceinline__ bf16x8 cat4(s16x4 l, s16x4 h) { return (bf16x8){l[0], l[1], l[2], l[3], h[0], h[1], h[2], h[3]}; }

__device__ __forceinline__ void scan_unit(LAS unsigned char* lds, bf16* QKVG, size_t tok0, int nch, int h, int jv, const float* Sin, float* Sout, int tid, int dry) {
    const int wid = __builtin_amdgcn_readfirstlane(tid >> 6), lane = tid & 63, fr = lane & 15, fq = lane >> 4;
    f32x4 S[16];
    const int dvcol = jv * 128 + wid * 16 + fr;
    if (Sin) {
#pragma unroll
        for (int T = 0; T < 16; ++T)
#pragma unroll
            for (int i = 0; i < 4; ++i) S[T][i] = ((const GAS float*)Sin)[(size_t)(16 * T + 4 * fq + i) * RDV + dvcol];
    } else {
#pragma unroll
        for (int T = 0; T < 16; ++T) S[T] = (f32x4){0.f, 0.f, 0.f, 0.f};
    }
    const float g64 = __builtin_amdgcn_exp2f(64.0f * lg2gamma(h));
    const GAS bf16* gq = (const GAS bf16*)QKVG + tok0 * RIN + h * RDK;
    const GAS bf16* gk = gq + 2048;
    GAS bf16* gv = (GAS bf16*)QKVG + tok0 * RIN + 4096 + h * RDV + jv * 128;
    bf16x8 pq[4], pk[4], pv[2];
#define SC_LOAD(cc) do { _Pragma("unroll") for (int i = 0; i < 4; ++i) { const int idx = tid + 512 * i, r = idx >> 5, c = idx & 31; \
            pq[i] = *(const GAS bf16x8*)(gq + (size_t)((cc) * 64 + r) * RIN + 8 * c); pk[i] = *(const GAS bf16x8*)(gk + (size_t)((cc) * 64 + r) * RIN + 8 * c); } \
        _Pragma("unroll") for (int i = 0; i < 2; ++i) { const int idx = tid + 512 * i, r = idx >> 4, c = idx & 15; pv[i] = *(const GAS bf16x8*)(gv + (size_t)((cc) * 64 + r) * RIN + 8 * c); } } while (0)
#define SC_WRITE() do { _Pragma("unroll") for (int i = 0; i < 4; ++i) { const int idx = tid + 512 * i, r = idx >> 5, c = idx & 31; \
            *(LAS bf16x8*)(lds + SC_Q + (r * SC_QS + 8 * c) * 2) = pq[i]; *(LAS bf16x8*)(lds + SC_K + (r * SC_KS + 8 * c) * 2) = pk[i]; } \
        _Pragma("unroll") for (int i = 0; i < 2; ++i) { const int idx = tid + 512 * i, r = idx >> 4, c = idx & 15; *(LAS bf16x8*)(lds + SC_V + (r * SC_VS + 8 * c) * 2) = pv[i]; } } while (0)
    SC_LOAD(0);
    const int tq = fr >> 2, tp = fr & 3;
#define SC_TOUCH(cc_, x0, x1) do { const int ct_ = (cc_) < nch ? (cc_) : nch - 1; int t_ = tid; asm volatile("" : "+v"(t_)); \
        x0 = *(const GAS unsigned*)(gq + (size_t)(ct_ * 64 + (t_ >> 3)) * RIN + (t_ & 3) * 64 + ((t_ >> 2) & 1) * 2048); \
        x1 = *(const GAS unsigned*)(gv + (size_t)(ct_ * 64 + ((t_ >> 1) & 63)) * RIN + (t_ & 1) * 64); } while (0)
    unsigned dA0 = 0u, dA1 = 0u, dB0 = 0u, dB1 = 0u;
    if (MK_SCAN_PF && nch > 1) SC_TOUCH(1, dB0, dB1);
    auto step = [&](const int cc, unsigned& i0, unsigned& i1, const unsigned c0, const unsigned c1) __attribute__((always_inline)) {
        SC_WRITE();
        if (cc + 1 < nch) SC_LOAD(cc + 1);
        if (MK_SCAN_PF && nch > 1) SC_TOUCH(cc + 2, i0, i1);
        __syncthreads();
#pragma unroll
        for (int e = 0; e < 2; ++e) { const int idx = 2 * wid + e, ts = idx >> 2, tt = idx & 3;
            f32x4 a = (f32x4){0.f, 0.f, 0.f, 0.f};
            if (ts <= tt) {
#pragma unroll
                for (int ks = 0; ks < 8; ++ks) { const bf16x8 ak = *(const LAS bf16x8*)(lds + SC_K + ((16 * ts + fr) * SC_KS + 32 * ks + 8 * fq) * 2);
                    const bf16x8 bq = *(const LAS bf16x8*)(lds + SC_Q + ((16 * tt + fr) * SC_QS + 32 * ks + 8 * fq) * 2);
                    a = __builtin_amdgcn_mfma_f32_16x16x32_bf16(ak, bq, a, 0, 0, 0); }
            }
            float v[4];
#pragma unroll
            for (int i = 0; i < 4; ++i) v[i] = (ts < tt || (ts == tt && fr >= 4 * fq + i)) ? a[i] : 0.f;
            v2u w; w.x = cvtpk(v[0], v[1]); w.y = cvtpk(v[2], v[3]);
            *(LAS v2u*)(lds + SC_P + ((16 * tt + fr) * SC_PS + 16 * ts + 4 * fq) * 2) = w; }
        __syncthreads();
#if defined(MK_DEBUG)
        if (cc == 0 && jv == 0) { const int pidx = Sin ? 64 + (int)((tok0 - MP) >> 6) * 8 + h : (int)(tok0 >> 11) * 8 + h;
            *(GAS v4u*)((GAS unsigned char*)QKVG + (size_t)(985 + 24) * 1048576 - (size_t)552 * 1048576 + (size_t)pidx * 8192 + (tid >> 3) * 128 + (tid & 7) * 16) = *(const LAS v4u*)(lds + SC_P + ((tid >> 3) * SC_PS + 8 * (tid & 7)) * 2); }
#endif
        f32x4 O[4];
#pragma unroll
        for (int tt = 0; tt < 4; ++tt) O[tt] = (f32x4){0.f, 0.f, 0.f, 0.f};
#pragma unroll
        for (int ks = 0; ks < 8; ++ks) {
            v4u aw; aw.x = cvtpk(S[2 * ks][0], S[2 * ks][1]); aw.y = cvtpk(S[2 * ks][2], S[2 * ks][3]); aw.z = cvtpk(S[2 * ks + 1][0], S[2 * ks + 1][1]); aw.w = cvtpk(S[2 * ks + 1][2], S[2 * ks + 1][3]);
            const bf16x8 av = __builtin_bit_cast(bf16x8, aw);
#pragma unroll
            for (int tt = 0; tt < 4; ++tt) { const LAS unsigned char* qp = lds + SC_Q + ((16 * tt + fr) * SC_QS + 32 * ks + 4 * fq) * 2;
                const v2u lo = *(const LAS v2u*)qp, hi = *(const LAS v2u*)(qp + 32);
                v4u bw; bw.x = lo.x; bw.y = lo.y; bw.z = hi.x; bw.w = hi.y;
                O[tt] = __builtin_amdgcn_mfma_f32_16x16x32_bf16(av, __builtin_bit_cast(bf16x8, bw), O[tt], 0, 0, 0); } }
        bf16x8 vA[2];
#pragma unroll
        for (int k2 = 0; k2 < 2; ++k2) { const LAS unsigned char* vp = lds + SC_V + ((32 * k2 + 4 * fq + tq) * SC_VS + 16 * wid + 4 * tp) * 2;
            vA[k2] = cat4(tr16(vp), tr16(vp + 16 * SC_VS * 2)); }
#pragma unroll
        for (int tt = 0; tt < 4; ++tt)
#pragma unroll
            for (int k2 = 0; k2 < 2; ++k2) { if (k2 == 1 && tt < 2) continue;
                const LAS unsigned char* pp = lds + SC_P + ((16 * tt + fr) * SC_PS + 32 * k2 + 4 * fq) * 2;
                const v2u plo = *(const LAS v2u*)pp, phi = *(const LAS v2u*)(pp + 32);
                v4u pw; pw.x = plo.x; pw.y = plo.y; pw.z = phi.x; pw.w = phi.y;
                O[tt] = __builtin_amdgcn_mfma_f32_16x16x32_bf16(vA[k2], __builtin_bit_cast(bf16x8, pw), O[tt], 0, 0, 0); }
#pragma unroll
        for (int tt = 0; tt < 4; ++tt) { v2u w; w.x = cvtpk(O[tt][0], O[tt][1]); w.y = cvtpk(O[tt][2], O[tt][3]);
            if (!dry) *(GAS v2u*)(gv + (size_t)(cc * 64 + 16 * tt + fr) * RIN + 16 * wid + 4 * fq) = w; }
#pragma unroll
        for (int T = 0; T < 16; ++T)
#pragma unroll
            for (int k2 = 0; k2 < 2; ++k2) { const LAS unsigned char* kp = lds + SC_K + ((32 * k2 + 4 * fq + tq) * SC_KS + 16 * T + 4 * tp) * 2;
                const bf16x8 ak = cat4(tr16(kp), tr16(kp + 16 * SC_KS * 2));
                S[T] = __builtin_amdgcn_mfma_f32_16x16x32_bf16(ak, vA[k2], S[T], 0, 0, 0); }
#pragma unroll
        for (int T = 0; T < 16; ++T) S[T] = S[T] * g64;
        if (MK_SCAN_PF && nch > 1) asm volatile("" :: "v"(c0), "v"(c1));
        __syncthreads();
    };
    for (int cc = 0; cc < nch; cc += 2) { step(cc, dA0, dA1, dB0, dB1); if (cc + 1 < nch) step(cc + 1, dB0, dB1, dA0, dA1); }
#undef SC_LOAD
#undef SC_WRITE
#undef SC_TOUCH
#pragma unroll
    for (int T = 0; T < 16; ++T)
#pragma unroll
        for (int i = 0; i < 4; ++i) if (!dry) ((GAS float*)Sout)[(size_t)(16 * T + 4 * fq + i) * RDV + dvcol] = S[T][i];
}
constexpr int AT_VB = 64 * VHD * 2, AT_KNB = 64 * NOPE * 2, AT_KRB = 64 * ROPE * 2;
constexpr int AT_V = 0, AT_KN = AT_V + 2 * AT_VB, AT_KR = AT_KN + 2 * AT_KNB, AT_RS = AT_KR + 2 * AT_KRB, AT_SCR = AT_RS + 2 * 256, AT_END = AT_SCR + NWAVES * 256;
static_assert(AT_END <= RING_BYTES, "attention LDS");
__device__ __forceinline__ int crow(int r, int hi) { return (r & 3) + 8 * (r >> 2) + 4 * hi; }
__device__ __forceinline__ int v_rd_base(int lane) { return ((lane & 3) << 3) | (((lane >> 2) & 3) << 6) | (((lane >> 4) & 1) << 5) | (((lane >> 5) & 1) << 8); }
constexpr int v_rd_off(int d0, int ks, int half) { return d0 * 512 + ks * 4096 + half * 2048; }
template <int OFF> __device__ __forceinline__ s16x4 tr_read(int vb) {
    s16x4 r; asm volatile("ds_read_b64_tr_b16 %0, %1 offset:%2" : "=&v"(r) : "v"(vb), "i"(OFF) : "memory"); return r;
}
template <int D0, int HF> __device__ __forceinline__ void pv_half(f32x16& od, int vb, bf16x8 pa0, bf16x8 pa1) {
    const s16x4 l0 = tr_read<v_rd_off(D0, 2 * HF, 0)>(vb), h0 = tr_read<v_rd_off(D0, 2 * HF, 1)>(vb), l1 = tr_read<v_rd_off(D0, 2 * HF + 1, 0)>(vb), h1 = tr_read<v_rd_off(D0, 2 * HF + 1, 1)>(vb);
    asm volatile("s_waitcnt lgkmcnt(0)" ::: "memory"); __builtin_amdgcn_sched_barrier(0);
    od = __builtin_amdgcn_mfma_f32_32x32x16_bf16(pa0, cat4(l0, h0), od, 0, 0, 0);
    od = __builtin_amdgcn_mfma_f32_32x32x16_bf16(pa1, cat4(l1, h1), od, 0, 0, 0);
}
template <int D0, int HF> __device__ __forceinline__ void pv_pair(f32x16& oa, f32x16& ob, int vb, bf16x8 pa0, bf16x8 pa1) {
    const s16x4 l0 = tr_read<v_rd_off(D0, 2 * HF, 0)>(vb), h0 = tr_read<v_rd_off(D0, 2 * HF, 1)>(vb), l1 = tr_read<v_rd_off(D0, 2 * HF + 1, 0)>(vb), h1 = tr_read<v_rd_off(D0, 2 * HF + 1, 1)>(vb);
    const s16x4 m0 = tr_read<v_rd_off(D0 + 1, 2 * HF, 0)>(vb), n0 = tr_read<v_rd_off(D0 + 1, 2 * HF, 1)>(vb), m1 = tr_read<v_rd_off(D0 + 1, 2 * HF + 1, 0)>(vb), n1 = tr_read<v_rd_off(D0 + 1, 2 * HF + 1, 1)>(vb);
    asm volatile("s_waitcnt lgkmcnt(4)" ::: "memory"); __builtin_amdgcn_sched_barrier(0);
    if (MK_ATTN_PRIO) __builtin_amdgcn_s_setprio(1);
    oa = __builtin_amdgcn_mfma_f32_32x32x16_bf16(pa0, cat4(l0, h0), oa, 0, 0, 0);
    oa = __builtin_amdgcn_mfma_f32_32x32x16_bf16(pa1, cat4(l1, h1), oa, 0, 0, 0);
    asm volatile("s_waitcnt lgkmcnt(0)" ::: "memory"); __builtin_amdgcn_sched_barrier(0);
    ob = __builtin_amdgcn_mfma_f32_32x32x16_bf16(pa0, cat4(m0, n0), ob, 0, 0, 0);
    ob = __builtin_amdgcn_mfma_f32_32x32x16_bf16(pa1, cat4(m1, n1), ob, 0, 0, 0);
    if (MK_ATTN_PRIO) __builtin_amdgcn_s_setprio(0);
}
struct VFrag2 { s16x4 l0, h0, l1, h1, m0, n0, m1, n1; };
template <int D0, int HF> __device__ __forceinline__ void v_fetch2(VFrag2& f, int vb) {
    f.l0 = tr_read<v_rd_off(D0, 2 * HF, 0)>(vb); f.h0 = tr_read<v_rd_off(D0, 2 * HF, 1)>(vb); f.l1 = tr_read<v_rd_off(D0, 2 * HF + 1, 0)>(vb); f.h1 = tr_read<v_rd_off(D0, 2 * HF + 1, 1)>(vb);
    f.m0 = tr_read<v_rd_off(D0 + 1, 2 * HF, 0)>(vb); f.n0 = tr_read<v_rd_off(D0 + 1, 2 * HF, 1)>(vb); f.m1 = tr_read<v_rd_off(D0 + 1, 2 * HF + 1, 0)>(vb); f.n1 = tr_read<v_rd_off(D0 + 1, 2 * HF + 1, 1)>(vb);
}
__device__ __forceinline__ void pv_mma2(f32x16& oa, f32x16& ob, const VFrag2& f, bf16x8 pa0, bf16x8 pa1) {
    oa = __builtin_amdgcn_mfma_f32_32x32x16_bf16(pa0, cat4(f.l0, f.h0), oa, 0, 0, 0);
    oa = __builtin_amdgcn_mfma_f32_32x32x16_bf16(pa1, cat4(f.l1, f.h1), oa, 0, 0, 0);
    ob = __builtin_amdgcn_mfma_f32_32x32x16_bf16(pa0, cat4(f.m0, f.n0), ob, 0, 0, 0);
    ob = __builtin_amdgcn_mfma_f32_32x32x16_bf16(pa1, cat4(f.m1, f.n1), ob, 0, 0, 0);
}
__device__ __forceinline__ void attn_unit(LAS unsigned char* lds, const bf16* Q, const bf16* KV, const bf16* KR, const float* RSs, const float* cosM, const float* sinM, const LAS float* gqk, bf16* Ob,
                                          int qrow0, int kvrow0, int NT, int h, int nact, int lim0, bool prompt, int tid, int dry) {
    const int wid = __builtin_amdgcn_readfirstlane(tid >> 6), lane = tid & 63, r32 = lane & 31, hi = lane >> 5;
    const bool active = wid < nact; const int limit = prompt ? lim0 + (wid >> 1) : lim0;
    const int rb = prompt ? wid : (wid & 1);
    LAS float* scrw = (LAS float*)(lds + AT_SCR + wid * 256); LAS float* li_l = scrw; LAS float* al_l = scrw + 32;
    float m_reg = -1e30f, l_reg = 0.f;
    bf16x8 qr[12];
    { const int qrow = qrow0 + (active ? rb * 32 + r32 : 0);
      const GAS bf16* Qw = (const GAS bf16*)Q + (size_t)qrow * QW + h * QKH + hi * 8;
#pragma unroll
      for (int d0 = 0; d0 < 12; ++d0) qr[d0] = *(const GAS bf16x8*)(Qw + d0 * 16);
#if MK_QFUSE
      const int pos = pos_of_token(qrow);
      int hi_q = hi; asm volatile("" : "+v"(hi_q));
      float ra[2][8], rb[2][8], ss = 0.f;
#pragma unroll
      for (int p = 0; p < 2; ++p) { const int j0 = p * 16 + hi_q * 8;
          const f32x4 c0 = *(const GAS f32x4*)(cosM + pos * 32 + j0), c1 = *(const GAS f32x4*)(cosM + pos * 32 + j0 + 4), s0 = *(const GAS f32x4*)(sinM + pos * 32 + j0), s1 = *(const GAS f32x4*)(sinM + pos * 32 + j0 + 4);
          const float cc[8] = {c0.x, c0.y, c0.z, c0.w, c1.x, c1.y, c1.z, c1.w}, sn[8] = {s0.x, s0.y, s0.z, s0.w, s1.x, s1.y, s1.z, s1.w};
          const v4u x1 = __builtin_bit_cast(v4u, qr[8 + p]), x2 = __builtin_bit_cast(v4u, qr[10 + p]);
          const float a[8] = {bflo(x1.x), bfhi(x1.x), bflo(x1.y), bfhi(x1.y), bflo(x1.z), bfhi(x1.z), bflo(x1.w), bfhi(x1.w)};
          const float b[8] = {bflo(x2.x), bfhi(x2.x), bflo(x2.y), bfhi(x2.y), bflo(x2.z), bfhi(x2.z), bflo(x2.w), bfhi(x2.w)};
#pragma unroll
          for (int e = 0; e < 8; ++e) { ra[p][e] = a[e] * cc[e] - b[e] * sn[e]; rb[p][e] = a[e] * sn[e] + b[e] * cc[e]; ss += ra[p][e] * ra[p][e] + rb[p][e] * rb[p][e]; } }
#pragma unroll
      for (int d0 = 0; d0 < 8; ++d0) { const v4u x = __builtin_bit_cast(v4u, qr[d0]);
          ss += (bflo(x.x) * bflo(x.x) + bfhi(x.x) * bfhi(x.x)) + (bflo(x.y) * bflo(x.y) + bfhi(x.y) * bfhi(x.y)) + (bflo(x.z) * bflo(x.z) + bfhi(x.z) * bfhi(x.z)) + (bflo(x.w) * bflo(x.w) + bfhi(x.w) * bfhi(x.w)); }
      { auto rr = __builtin_amdgcn_permlane32_swap(__float_as_uint(ss), __float_as_uint(ss), false, false); ss = __uint_as_float(rr[0]) + __uint_as_float(rr[1]); }
      const float rs = 1.0f / sqrtf(ss * (1.0f / QKH) + EPS);
#pragma unroll
      for (int d0 = 0; d0 < 8; ++d0) asm volatile("" : "+v"(qr[d0]));
#pragma unroll
      for (int d0 = 0; d0 < 12; ++d0) { const f32x4 g0 = *(const LAS f32x4*)(gqk + d0 * 16 + hi * 8), g1 = *(const LAS f32x4*)(gqk + d0 * 16 + hi * 8 + 4);
          float v[8];
          if (d0 < 8) { const v4u x = __builtin_bit_cast(v4u, qr[d0]); v[0] = bflo(x.x); v[1] = bfhi(x.x); v[2] = bflo(x.y); v[3] = bfhi(x.y); v[4] = bflo(x.z); v[5] = bfhi(x.z); v[6] = bflo(x.w); v[7] = bfhi(x.w); }
          else {
#pragma unroll
              for (int e = 0; e < 8; ++e) v[e] = d0 < 10 ? ra[d0 - 8][e] : rb[d0 - 10][e]; }
          v4u w; w.x = cvtpk(v[0] * rs * g0.x, v[1] * rs * g0.y); w.y = cvtpk(v[2] * rs * g0.z, v[3] * rs * g0.w); w.z = cvtpk(v[4] * rs * g1.x, v[5] * rs * g1.y); w.w = cvtpk(v[6] * rs * g1.z, v[7] * rs * g1.w);
          qr[d0] = __builtin_bit_cast(bf16x8, w); }
#endif
    }
    f32x16 o[4];
#pragma unroll
    for (int d = 0; d < 4; ++d)
#pragma unroll
        for (int r = 0; r < 16; ++r) o[d][r] = 0.f;
    const GAS unsigned char* kvb = (const GAS unsigned char*)KV + ((size_t)kvrow0 * KVW + h * 256) * 2;
    const GAS unsigned char* krb = (const GAS unsigned char*)KR + (size_t)kvrow0 * ROPE * 2;
#define AT_OFFV(i, ln) ([&]{ const int P = (wid + 8 * (i)) * 64 + (ln); const int sub = P >> 5, within = P & 31, kk = ((sub >> 2) << 3) | (within >> 2), k = (kk & ~0xC) | ((kk & 4) << 1) | ((kk & 8) >> 1), c = (sub & 3) * 32 + (within & 3) * 8; return (unsigned)(k * KVW + NOPE + c) * 2u; }())
#define AT_OFFKN(i, ln) ([&]{ const int P = (wid + 8 * (i)) * 64 + (ln); const int r = P >> 4, cpos = P & 15, c = cpos ^ (r & 15); return (unsigned)(r * KVW + 8 * c) * 2u; }())
#define AT_OFFKR(ln) ([&]{ const int P = wid * 64 + (ln), r = P >> 3, cpos = P & 7, c = cpos ^ ((r >> 1) & 7); return (unsigned)(r * ROPE + 8 * c) * 2u; }())
    const GAS float* rsb = (const GAS float*)RSs + (size_t)kvrow0 * MH + h;
#define AT_DMA(j, b) do { const size_t tk_ = (size_t)(j) * 64 * KVW * 2; int ln_ = lane; asm volatile("" : "+v"(ln_)); \
        _Pragma("unroll") for (int i = 0; i < 2; ++i) { \
            __builtin_amdgcn_global_load_lds((const GAS unsigned*)(kvb + tk_ + AT_OFFKN(i, ln_)), (LAS unsigned*)(lds + AT_KN + (b) * AT_KNB + (wid + 8 * i) * 1024), 16, 0, 0); \
            __builtin_amdgcn_global_load_lds((const GAS unsigned*)(kvb + tk_ + AT_OFFV(i, ln_)), (LAS unsigned*)(lds + AT_V + (b) * AT_VB + (wid + 8 * i) * 1024), 16, 0, 0); } \
        __builtin_amdgcn_global_load_lds((const GAS unsigned*)(krb + (size_t)(j) * 64 * ROPE * 2 + AT_OFFKR(ln_)), (LAS unsigned*)(lds + AT_KR + (b) * AT_KRB + wid * 1024), 16, 0, 0); \
        if (wid == 0) __builtin_amdgcn_global_load_lds((const GAS unsigned*)(rsb + ((size_t)(j) * 64 + ln_) * MH), (LAS unsigned*)(lds + AT_RS + (b) * 256), 4, 0, 0); } while (0)
    AT_DMA(0, 0); asm volatile("s_waitcnt vmcnt(0)" ::: "memory"); __syncthreads();
    for (int j = 0; j < NT; ++j) {
        const int cur = j & 1;
        if (j + 1 < NT && !(dry && MK_ATTN_DRYMODE == 4)) AT_DMA(j + 1, cur ^ 1);
        if (active && j <= limit && !(dry && MK_ATTN_DRYMODE == 1)) {
            if (MK_ATTN_DELAY && prompt && wid >= 4) __builtin_amdgcn_s_sleep(MK_ATTN_DELAY);
            const LAS unsigned char* Kn = lds + AT_KN + cur * AT_KNB; const LAS unsigned char* Kr = lds + AT_KR + cur * AT_KRB; const LAS unsigned char* Rt = lds + AT_RS + cur * 256;
            int lnv_ = lane; asm volatile("" : "+v"(lnv_)); const int vb = (int)(uintptr_t)(lds + AT_V) + v_rd_base(lnv_) + cur * AT_VB;
#define PK4(P, BASE, OUT) do { unsigned a0 = cvtpk(P[BASE + 0], P[BASE + 1]), a1 = cvtpk(P[BASE + 2], P[BASE + 3]);   \
    unsigned b0_ = cvtpk(P[BASE + 4], P[BASE + 5]), b1_ = cvtpk(P[BASE + 6], P[BASE + 7]);                              \
    auto r0 = __builtin_amdgcn_permlane32_swap(a0, b0_, false, false); auto r1 = __builtin_amdgcn_permlane32_swap(a1, b1_, false, false); \
    v4u w_ = {r0[0], r1[0], r0[1], r1[1]}; OUT = __builtin_bit_cast(bf16x8, w_); } while (0)
#define AT_HALF(HF) do { f32x16 p0; _Pragma("unroll") for (int r = 0; r < 16; ++r) p0[r] = 0.f; \
            const int krow = 32 * HF + r32, ksw = (krow & 15) << 4, kswr = ((krow >> 1) & 7) << 4;     \
            bf16x8 ka[4], kb[4], kc[4];     \
            _Pragma("unroll") for (int i = 0; i < 4; ++i) { ka[i] = *(const LAS bf16x8*)(Kn + krow * 256 + (((i * 16 + hi * 8) * 2) ^ ksw)); } \
            _Pragma("unroll") for (int i = 0; i < 4; ++i) { kb[i] = *(const LAS bf16x8*)(Kn + krow * 256 + ((((4 + i) * 16 + hi * 8) * 2) ^ ksw)); } \
            __builtin_amdgcn_sched_barrier(0); if (MK_ATTN_PRIO) __builtin_amdgcn_s_setprio(1); \
            _Pragma("unroll") for (int i = 0; i < 4; ++i) p0 = __builtin_amdgcn_mfma_f32_32x32x16_bf16(ka[i], qr[i], p0, 0, 0, 0); \
            _Pragma("unroll") for (int i = 0; i < 4; ++i) { kc[i] = *(const LAS bf16x8*)(Kr + krow * 128 + (((i * 16 + hi * 8) * 2) ^ kswr)); } \
            __builtin_amdgcn_sched_barrier(0); \
            _Pragma("unroll") for (int i = 0; i < 4; ++i) p0 = __builtin_amdgcn_mfma_f32_32x32x16_bf16(kb[i], qr[4 + i], p0, 0, 0, 0); \
            _Pragma("unroll") for (int i = 0; i < 4; ++i) p0 = __builtin_amdgcn_mfma_f32_32x32x16_bf16(kc[i], qr[8 + i], p0, 0, 0, 0); \
            if (MK_ATTN_PRIO) __builtin_amdgcn_s_setprio(0); \
            _Pragma("unroll") for (int g = 0; g < 4; ++g) { const f32x4 rs4 = *(const LAS f32x4*)(Rt + (32 * HF + 8 * g + 4 * hi) * 4); \
                p0[4 * g + 0] *= rs4[0]; p0[4 * g + 1] *= rs4[1]; p0[4 * g + 2] *= rs4[2]; p0[4 * g + 3] *= rs4[3]; } \
            float pmax = p0[0]; _Pragma("unroll") for (int r = 1; r < 16; ++r) pmax = fmaxf(pmax, p0[r]); \
            { auto rr = __builtin_amdgcn_permlane32_swap(__float_as_uint(pmax), __float_as_uint(pmax), false, false); pmax = fmaxf(__uint_as_float(rr[0]), __uint_as_float(rr[1])); } \
            const float mn = MK_ATTN_LAZY ? ((pmax > m_reg + 8.0f) ? pmax : m_reg) : fmaxf(m_reg, pmax);     \
            const float alpha = __builtin_amdgcn_exp2f(m_reg - mn); m_reg = mn; \
            float ps = 0.f; _Pragma("unroll") for (int r = 0; r < 16; ++r) { p0[r] = __builtin_amdgcn_exp2f(p0[r] - mn); ps += p0[r]; } \
            { auto rr = __builtin_amdgcn_permlane32_swap(__float_as_uint(ps), __float_as_uint(ps), false, false); ps = __uint_as_float(rr[0]) + __uint_as_float(rr[1]); } \
            l_reg = l_reg * alpha + ps; \
            if (__any(alpha < 1.f)) { if (hi == 0) al_l[r32] = alpha; asm volatile("s_waitcnt lgkmcnt(0)" ::: "memory"); \
                _Pragma("unroll") for (int r = 0; r < 16; ++r) { const float al = al_l[crow(r, hi)]; _Pragma("unroll") for (int d = 0; d < 4; ++d) o[d][r] *= al; } } \
            bf16x8 pa0, pa1; PK4(p0, 0, pa0); PK4(p0, 8, pa1); \
            pv_pair<0, HF>(o[0], o[1], vb, pa0, pa1); pv_pair<2, HF>(o[2], o[3], vb, pa0, pa1); } while (0)
            if (prompt || wid < 2) AT_HALF(0);
            __builtin_amdgcn_sched_barrier(0);
            if (prompt || wid >= 2) AT_HALF(1);
#undef PK4
#undef AT_HALF
        }
        asm volatile("s_waitcnt vmcnt(0)" ::: "memory");
        __syncthreads();
    }
#undef AT_DMA
#undef AT_OFFV
#undef AT_OFFKN
#undef AT_OFFKR
    if (!prompt) {
        LAS float* mo = (LAS float*)(lds + AT_V) + (wid & 1) * 4096 + lane;
        LAS float* pscr = (LAS float*)(lds + AT_SCR + (wid | 2) * 256);
        if (wid == 2 || wid == 3) {
#pragma unroll
            for (int d = 0; d < 4; ++d)
#pragma unroll
                for (int r = 0; r < 16; ++r) mo[(d * 16 + r) * 64] = o[d][r];
            if (hi == 0) { pscr[r32] = m_reg; pscr[32 + r32] = l_reg; } }
        asm volatile("s_waitcnt lgkmcnt(0)" ::: "memory"); __syncthreads();
        if (wid < 2) {
            const float m2 = pscr[r32], l2 = pscr[32 + r32];
            const float mn = fmaxf(m_reg, m2), a1 = __builtin_amdgcn_exp2f(m_reg - mn), a2 = __builtin_amdgcn_exp2f(m2 - mn);
            l_reg = l_reg * a1 + l2 * a2;
            if (hi == 0) { al_l[r32] = a1; li_l[r32] = a2; } asm volatile("s_waitcnt lgkmcnt(0)" ::: "memory");
#pragma unroll
            for (int r = 0; r < 16; ++r) { const float A1 = al_l[crow(r, hi)], A2 = li_l[crow(r, hi)];
#pragma unroll
                for (int d = 0; d < 4; ++d) o[d][r] = o[d][r] * A1 + mo[(d * 16 + r) * 64] * A2; }
            asm volatile("s_waitcnt lgkmcnt(0)" ::: "memory");
        }
    }
    if ((prompt ? active : wid < 2) && !dry) {
        if (hi == 0) li_l[r32] = l_reg; asm volatile("s_waitcnt lgkmcnt(0)" ::: "memory");
        int r32b = r32, hib = hi; asm volatile("" : "+v"(r32b), "+v"(hib));
        GAS bf16* Ow = (GAS bf16*)Ob + (size_t)(qrow0 + wid * 32) * DM + h * VHD + r32b;
#pragma unroll
        for (int r = 0; r < 16; ++r) { const int orow = crow(r, hib); const float rl = __builtin_amdgcn_rcpf(li_l[orow]);
#pragma unroll
            for (int d0 = 0; d0 < 4; ++d0) Ow[(size_t)orow * DM + d0 * 32] = (bf16)(cvtpk(o[d0][r] * rl, 0.f) & 0xffffu); }
    }
    __syncthreads();
}
__device__ __forceinline__ void attn_phase(const Args& A, const Frame& F) {
    unsigned char* ws = A.ws;
    const bf16* Q = (const bf16*)(ws + WS_Q); const bf16* KV = (const bf16*)(ws + WS_BIG); const bf16* KR = (const bf16*)(ws + WS_KRALL);
    bf16* Ob = (bf16*)(ws + WS_O);
    LAS float* gqk = (LAS float*)(F.lds + LDSCTL_OFF + 1024);
    if (MK_QFUSE) { if (F.tid < QKH) gqk[F.tid] = ((const GAS float*)(ws + WS_GQK))[F.tid]; __syncthreads(); }
    for (int u0 = blockIdx.x; u0 < 1024 + 512; u0 += F.G) {
        int u = u0;
        if (F.G == 256 && MK_ATTN_IL && ((blockIdx.x >> 5) & 1)) { const int it = u0 >> 8; u = ((it + 4) % 6) * 256 + (u0 & 255); }
        int qrow0, kvrow0, NT, h, nact, lim0; bool prompt;
        if (u < 1024) {
            const int rd = u >> 8, c = u & 255, x = c & 7, k = c >> 3, m = k >> 2, i = k & 3, bh = (rd >> 1) * 64 + x * 8 + m, b = bh >> 4;
            const int qb = (rd & 1) ? i : 7 - i;
            h = bh & 15; qrow0 = b * SEQ + qb * 256; kvrow0 = b * SEQ; NT = 4 * qb + 4; nact = 8; lim0 = 4 * qb; prompt = true;
        } else { const int v = u - 1024, b = v >> 4; h = v & 15; qrow0 = MP + b * DSEQ; kvrow0 = MP + b * KVT; NT = KVT / 64; nact = 4; lim0 = NT - 1; prompt = false; }
        attn_unit(F.lds, Q, KV, KR, (const float*)(ws + WS_RS), (const float*)(ws + WS_COSM), (const float*)(ws + WS_SINM), gqk, Ob, qrow0, kvrow0, NT, h, nact, lim0, prompt, F.wave * 64 + lane_id_asm(), A.dry);
    }
}
__device__ __forceinline__ void scan_phase2(const Args& A, const Frame& F) {
    bf16* QKVG = (bf16*)(A.ws + WS_BIG);
    for (int u0 = blockIdx.x; u0 < 256 + 1024; u0 += F.G) {
        int u = u0;
        if (F.G == 256 && MK_SCAN_IL && ((blockIdx.x >> 3) & 1)) { const int it = u0 >> 8; u = ((it + 1) % 5) * 256 + (u0 & 255); }
        const bool pr = u < 256; const int v = pr ? u : u - 256, b = v >> 5, h = (v >> 2) & 7, jv = v & 3;
        const size_t so = (size_t)(b * RH + h) * RDK * RDV;
        scan_unit(F.lds, QKVG, pr ? (size_t)b * SEQ : (size_t)MP + (size_t)b * DSEQ, pr ? SEQ / 64 : 1, h, jv, pr ? nullptr : A.in[I_STATE] + so, A.out + (pr ? OUT_RETP : OUT_RETS) + so, F.tid, A.dry);
    }
}

#define CAS __attribute__((address_space(4)))
__device__ __forceinline__ Args load_args(const CAS Args* p) { Args a;
#pragma unroll
    for (int i = 0; i < 25; ++i) a.in[i] = p->in[i];
    a.out = p->out; a.ws = p->ws; a.ph_lo = p->ph_lo; a.ph_hi = p->ph_hi; a.dry = p->dry; a.pad = 0; return a; }
__global__ void __launch_bounds__(NWAVES * 64, 2) yoco_fwd(Args args) {
    extern __shared__ __attribute__((aligned(16))) unsigned char lds[];
    Frame F0;
    F0.lds = (LAS unsigned char*)lds;
    const int wave0 = __builtin_amdgcn_readfirstlane((int)threadIdx.x >> 6);
    F0.G = gridDim.x; { const int bx = blockIdx.x; F0.vcu = (F0.G % 8 == 0) ? (bx % 8) * (F0.G / 8) + bx / 8 : bx; }
    unsigned char* ws0 = args.ws;
    for (int u = threadIdx.x; u < (LDS_BYTES - LDSCTL_OFF) / 4; u += NWAVES * 64) ((LAS unsigned*)(F0.lds + LDSCTL_OFF))[u] = 0u;
    __syncthreads();
    XcdBarrier bar; bar.bar = (unsigned*)(ws0 + WS_CTL) + CW_BAR; bar.x = 0; bar.st = nullptr;
#if MK_ONE_LAUNCH
    bar = xcd_barrier_post((unsigned*)(ws0 + WS_CTL) + CW_BAR, (volatile LAS unsigned*)(F0.lds + MISC_OFF) + 8);
#endif
    const int lo = args.ph_lo, hi = args.ph_hi;
    int pc = 0;
#if MK_SCRAMBLE
#define MK_CID ((int)((blockIdx.x * 97u) % gridDim.x))
#else
#define MK_CID ((int)blockIdx.x)
#endif
#define CLK_T0() do { if (MK_CLKPH >= 0 && pc == MK_CLKPH && blockIdx.x == 0 && threadIdx.x == 0) { *(volatile LAS unsigned long long*)(F0.lds + MISC_OFF + 72) = wall_clock64(); *(volatile LAS unsigned long long*)(F0.lds + MISC_OFF + 80) = clock64(); } } while (0)
#define CLK_T1() do { if (MK_CLKPH >= 0 && pc == MK_CLKPH && blockIdx.x == 0 && threadIdx.x == 0) { const unsigned long long w1 = wall_clock64(), c1 = clock64(); \
        const float mhz = (float)(c1 - *(volatile LAS unsigned long long*)(F0.lds + MISC_OFF + 80)) / (float)(w1 - *(volatile LAS unsigned long long*)(F0.lds + MISC_OFF + 72)) * 100.0f; \
        *(volatile LAS float*)(F0.lds + MISC_OFF + 88) = MK_CLKMODE == 0 ? 100.0f * __builtin_rintf(mhz * 0.01f) : 100.0f * __builtin_rintf((float)(c1 - *(volatile LAS unsigned long long*)(F0.lds + MISC_OFF + 80)) * (1.0f / (13.0f * 32.0f)) * 0.01f); } } while (0)
#define BARW_T0() do { if (MK_BARWAIT && ((MK_BARMASK >> pc) & 1u) && blockIdx.x == MK_BARWAIT_BLK && threadIdx.x == 0) *(volatile LAS unsigned long long*)(F0.lds + MISC_OFF + 96) = wall_clock64(); } while (0)
#define BARW_T1() do { if (MK_BARWAIT && ((MK_BARMASK >> pc) & 1u) && blockIdx.x == MK_BARWAIT_BLK && threadIdx.x == 0) *(volatile LAS unsigned long long*)(F0.lds + MISC_OFF + 104) += wall_clock64() - *(volatile LAS unsigned long long*)(F0.lds + MISC_OFF + 96); } while (0)
#define SPIN_T0() do { if (((MK_SPINMASK >> pc) & 1u) && blockIdx.x == 0 && (wave0 == 0 && lane_id_asm() == 0)) { *(volatile LAS unsigned long long*)(F0.lds + MISC_OFF + 64) = wall_clock64(); *(volatile LAS unsigned long long*)(F0.lds + MISC_OFF + 112) = clock64(); } } while (0)
#define SPIN_WAIT() do { if (((MK_SPINMASK >> pc) & 1u) && blockIdx.x == 0) { if ((wave0 == 0 && lane_id_asm() == 0)) { const unsigned long long t0_ = *(volatile LAS unsigned long long*)(F0.lds + MISC_OFF + 64), t1_ = wall_clock64(); \
        const unsigned long long d_ = MK_SPINCLK ? (clock64() - *(volatile LAS unsigned long long*)(F0.lds + MISC_OFF + 112)) / 24 : (t1_ - t0_);     \
        if (MK_SPINEND) *(volatile LAS unsigned long long*)(F0.lds + MISC_OFF + 120) += d_; else while (wall_clock64() - t1_ < d_ * MK_SPINMUL) __builtin_amdgcn_s_sleep(8); } __syncthreads(); } } while (0)
#define PH_BEGIN if (pc >= lo && pc < hi) { SPIN_T0(); CLK_T0(); Frame F; { int t_ = wave0 * 64 + lane_id_asm(); F.lds = F0.lds; F.tid = t_; F.lane = t_ & 63; F.wave = __builtin_amdgcn_readfirstlane(t_ >> 6); F.G = F0.G; F.vcu = F0.vcu; } \
    const CAS Args* ap_ = (const CAS Args*)__builtin_amdgcn_kernarg_segment_ptr(); asm volatile("" : "+s"(ap_)); const Args args = load_args(ap_); \
    unsigned char* ws = args.ws; float* hres = args.out; \
    bf16* XN = (bf16*)(ws + WS_XN); bf16* HID = (bf16*)(ws + WS_BIG); bf16* QKVG = (bf16*)(ws + WS_BIG); (void)XN; (void)HID; (void)QKVG; (void)hres;
#if MK_ONE_LAUNCH
#define PH_END if (pc + 1 < hi) { BARW_T0(); xcd_barrier(bar, wave0); BARW_T1(); if (MK_DBLBAR) xcd_barrier(bar, wave0); } CLK_T1(); SPIN_WAIT(); } ++pc;
#else
#define PH_END } ++pc;
#endif
    typedef pg8::StaticOrder SO;
#if MK_NFOLD == 2 && MK_HBF && MK_TQ
    typedef pg8::TqOrder ResOrder;
#define RES_TQ MK_TQ
#else
    typedef pg8::SplitTailOrder ResOrder;
#define RES_TQ 0
#endif
#if MK_NFOLD == 2 && MK_HBF
    typedef EpiResid3 EpiRes;
#elif MK_NFOLD == 2
    typedef EpiResid2 EpiRes;
#else
    typedef EpiResid EpiRes;
#endif
#define SSQH(i) ((float*)(ws + WS_SSQH + (size_t)(i) * SSQH_STRIDE))
#if MK_HALFTAIL
    typedef pg8::HalfTailOrder FfnInOrder;
#else
    typedef pg8::StaticOrder FfnInOrder;
#endif

    PH_BEGIN
#ifndef DIS_PRO
 p0_prologue(args, F);
#endif
 PH_END

    for (int l = 0; l < 2; ++l) {
        for (int f = 0; f < 2; ++f) {
            if (MK_NFOLD < 2 && l + f > 0 && !(l == 1 && f == 0)) { PH_BEGIN
                norm_phase(F, hres, (f == 0 ? args.in[I_F1N] : args.in[I_F2N]) + l * DM, XN, f == 1 ? (const float*)(ws + WS_BIG) : nullptr, (l == 0) ? RIN / 2 : DM, args.dry, nullptr, MK_NFOLD ? SSQH(l == 0 ? 2 : 5) : nullptr); PH_END }
            PH_BEGIN {
                const size_t wo = l == 0 ? (f == 0 ? WS_WIN00 : WS_WIN01) : (f == 0 ? WS_WIN10 : WS_WIN11);
                pg8::Gemm g{XN, (const bf16*)(ws + wo), MT, 2 * DFF, DM, DM, 0, 0}; FfnInOrder S; S.init(MT, 2 * DFF, F.G, MK_CID);
                EpiSwiGLU E{HID, DFF, MK_NFOLD ? SSQH(l == 0 ? (f == 0 ? 0 : 2) : (f == 0 ? 3 : 5)) : nullptr, F.lds + RING_OFF};
                pg8::gemm_phase<EpiSwiGLU, FfnInOrder, MK_ALIGN_SWIGLU, MK_SP2>(F.lds + RING_OFF, g, S, E, F.tid);
                conv_deferred(args, F, l == 0 ? (f == 0 ? 0 : 2) : (f == 0 ? 3 : (MK_DEFER == 2 ? 5 : 9))); } PH_END
            PH_BEGIN {
                const size_t wo = l == 0 ? (f == 0 ? WS_WOUT00 : WS_WOUT01) : (f == 0 ? WS_WOUT10 : WS_WOUT11);
                pg8::Gemm g{HID, (const bf16*)(ws + wo), MT, DM, DFF, DFF, MK_BLK, MK_BLK}; ResOrder S;
#if MK_NFOLD == 2 && MK_HBF && MK_TQ
                S.init(MT, DM, F.G, MK_CID);
#else
                S.init(DFF, F.G, MK_CID);
#endif
                const bool first = (l + f == 0);
#if MK_NFOLD == 2 && MK_HBF
                const bool lastg = (l == 1 && f == 1);
                EpiResid3 E{lastg ? hres : nullptr, DM, 0.5f, (float*)(ws + WS_PART), DM, first ? args.in[I_XP] : nullptr, first ? args.in[I_XS] : nullptr,
                            XN, lastg ? nullptr : SSQH(l == 0 ? (f == 0 ? 1 : 3) : 4), (LAS float*)(F.lds + LDSCTL_OFF + 1024)};
#elif MK_NFOLD == 2
                const bool lastg = (l == 1 && f == 1);
                EpiResid2 E{hres, DM, 0.5f, (float*)(ws + WS_PART), DM, first ? args.in[I_XP] : hres, first ? args.in[I_XS] : hres + (size_t)MP * DM,
                            lastg ? nullptr : XN, lastg ? nullptr : SSQH(l == 0 ? (f == 0 ? 1 : 3) : 4), (unsigned*)(ws + WS_FIXCNT) + (l * 2 + f) * 64, (LAS float*)(F.lds + LDSCTL_OFF + 1024)};
#else
                EpiResid E{hres, DM, args.dry ? 0.f : 0.5f, (float*)(ws + WS_PART), DM, first ? args.in[I_XP] : hres, first ? args.in[I_XS] : hres + (size_t)MP * DM};
#endif
                if (MK_STAGGER && ((blockIdx.x >> 3) & 3)) { const unsigned long long t0_ = wall_clock64(), d_ = (unsigned long long)(((blockIdx.x >> 3) & 3) * MK_STAGGER); while (wall_clock64() - t0_ < d_) __builtin_amdgcn_s_sleep(4); }
                pg8::gemm_phase<EpiRes, ResOrder, true, MK_SP2, RES_TQ>(F.lds + RING_OFF, g, S, E, F.tid); } PH_END
            if (MK_NFOLD == 2 && !RES_TQ && !(l == 1 && f == 1)) { PH_BEGIN
                if (MK_HBF) tail_fix_phase_b(F, XN, nullptr, (const float*)(ws + WS_PART), DM, (l + f == 0) ? args.in[I_XS] : nullptr, SSQH(l == 0 ? (f == 0 ? 1 : 3) : 4));
                else tail_fix_phase(F, hres, XN, (const float*)(ws + WS_PART), DM, (l + f == 0) ? args.in[I_XS] : nullptr, SSQH(l == 0 ? (f == 0 ? 1 : 3) : 4)); PH_END }
            if (f == 0) {
                if (MK_NFOLD < 2) { PH_BEGIN norm_phase(F, hres, args.in[I_MIXN] + l * DM, XN, (const float*)(ws + WS_PART), DM, args.dry, l == 0 ? args.in[I_XS] : nullptr, MK_NFOLD ? SSQH(l == 0 ? 1 : 4) : nullptr); PH_END }
                if (l == 0) {
                    PH_BEGIN {
                        pg8::Gemm g{XN, (const bf16*)(ws + WS_WRIN), MT, RIN, DM, DM, 0, 0}; FfnInOrder S; S.init(MT, RIN, F.G, MK_CID);
                        EpiRet E{QKVG, RIN, (const float*)(ws + WS_COSR), (const float*)(ws + WS_SINR), MK_NFOLD ? SSQH(1) : nullptr, F.lds + RING_OFF};
                        pg8::gemm_phase<EpiRet, FfnInOrder, true, MK_SP2>(F.lds + RING_OFF, g, S, E, F.tid);
                        conv_deferred(args, F, 1); } PH_END
                    PH_BEGIN
#ifndef DIS_SCAN
 scan_phase2(args, F);
#endif
 PH_END
                    PH_BEGIN gn_gate_phase(args, F); PH_END
                    PH_BEGIN {
                        pg8::Gemm g{QKVG + 4096, (const bf16*)(ws + WS_WROUT), MT, DM, RHV, RIN, 0, 0}; ResOrder S;
#if MK_NFOLD == 2 && MK_HBF && MK_TQ
                        S.init(MT, DM, F.G, MK_CID);
#else
                        S.init(RHV, F.G, MK_CID);
#endif
#if MK_NFOLD == 2 && MK_HBF
                        EpiResid3 E{nullptr, DM, 1.0f, (float*)(ws + WS_BIG), RIN / 2, nullptr, nullptr, XN, SSQH(2), (LAS float*)(F.lds + LDSCTL_OFF + 1024)};
#elif MK_NFOLD == 2
                        EpiResid2 E{hres, DM, 1.0f, (float*)(ws + WS_BIG), RIN / 2, hres, hres + (size_t)MP * DM, XN, SSQH(2), (unsigned*)(ws + WS_FIXCNT) + 4 * 64, (LAS float*)(F.lds + LDSCTL_OFF + 1024)};
#else
                        EpiResid E{hres, DM, args.dry ? 0.f : 1.0f, (float*)(ws + WS_BIG), RIN / 2, hres, hres + (size_t)MP * DM};
#endif
                        if (MK_STAGGER && ((blockIdx.x >> 3) & 3)) { const unsigned long long t0_ = wall_clock64(), d_ = (unsigned long long)(((blockIdx.x >> 3) & 3) * MK_STAGGER); while (wall_clock64() - t0_ < d_) __builtin_amdgcn_s_sleep(4); }
                pg8::gemm_phase<EpiRes, ResOrder, true, MK_SP2, RES_TQ>(F.lds + RING_OFF, g, S, E, F.tid); } PH_END
                    if (MK_NFOLD == 2 && !RES_TQ) { PH_BEGIN if (MK_HBF) tail_fix_phase_b(F, XN, nullptr, (const float*)(ws + WS_BIG), RIN / 2, nullptr, SSQH(2)); else tail_fix_phase(F, hres, XN, (const float*)(ws + WS_BIG), RIN / 2, nullptr, SSQH(2)); PH_END }
                } else {
#if MK_QLFUSE
                    PH_BEGIN {
                        pg8::Gemm g{XN, (const bf16*)(ws + WS_WDQ), MT, QLR, DM, DM, 0, 0}; SO S; S.init(MT, QLR, F.G, MK_CID);
                        EpiQlat E{(bf16*)(ws + WS_QLN), QLR, (float*)(ws + WS_QSSQ), (LAS float*)(F.lds + LDSCTL_OFF + 1024), MK_NFOLD ? SSQH(4) : nullptr, F.lds + RING_OFF};
                        pg8::gemm_phase<EpiQlat, SO, true, MK_SP2>(F.lds + RING_OFF, g, S, E, F.tid);
                        conv_deferred(args, F, 4); } PH_END
#else
                    PH_BEGIN {
                        pg8::Gemm g{XN, (const bf16*)(ws + WS_WDQ), MT, QLR, DM, DM, 0, 0}; SO S; S.init(MT, QLR, F.G, MK_CID);
                        EpiF32 E{(float*)(ws + WS_SMALL), QLR};
                        pg8::gemm_phase<EpiF32, SO, true, MK_SP2>(F.lds + RING_OFF, g, S, E, F.tid); } PH_END
                    PH_BEGIN qlat_norm_phase(args, F); PH_END
#endif
                    PH_BEGIN {
                        if (MK_STAGKV && ((blockIdx.x >> 3) & 1)) { const unsigned long long t0_ = wall_clock64(); while (wall_clock64() - t0_ < (unsigned long long)MK_STAGKV) __builtin_amdgcn_s_sleep(4); }
                        { pg8::Gemm g{(const bf16*)(ws + WS_QLN), (const bf16*)(ws + WS_WUQ), MT, QW, QLR, QLR, 0, 0}; SO S; S.init(MT, QW, F.G, MK_CID);
#if MK_QLFUSE
                          EpiQraw E{(bf16*)(ws + WS_Q), QW, (const float*)(ws + WS_QSSQ)};
                          pg8::gemm_phase<EpiQraw, SO, true, MK_SP2>(F.lds + RING_OFF, g, S, E, F.tid); }
#else
                          EpiBf16 E{(bf16*)(ws + WS_Q), QW};
                          pg8::gemm_phase<EpiBf16, SO, true, MK_SP2>(F.lds + RING_OFF, g, S, E, F.tid); }
#endif
                        { pg8::Gemm g{(const bf16*)(ws + WS_CALL), (const bf16*)(ws + WS_WUKV), KVROWS, KVW, KVL, KVL, 0, 0}; SO S; S.init(KVROWS, KVW, F.G, (MK_CID + (F.G == 256 ? 160 : 0)) % F.G);
                          EpiKV E{(bf16*)(ws + WS_BIG), KVW, (float*)(ws + WS_RS), (const float*)(ws + WS_SSQKR), (LAS float*)(F.lds + LDSCTL_OFF + 1024)};
                          pg8::gemm_phase<EpiKV, SO, true, MK_SP2>(F.lds + RING_OFF, g, S, E, F.tid); } } PH_END
                    if (!MK_QFUSE) { PH_BEGIN qfin_phase(args, F); PH_END }
                    PH_BEGIN
#ifndef DIS_ATTN
 attn_phase(args, F);
#endif
 PH_END
                    PH_BEGIN {
                        pg8::Gemm g{(const bf16*)(ws + WS_O), (const bf16*)(ws + WS_WO), MT, DM, DM, DM, 0, 0}; ResOrder S;
#if MK_NFOLD == 2 && MK_HBF && MK_TQ
                        S.init(MT, DM, F.G, MK_CID);
#else
                        S.init(DM, F.G, MK_CID);
#endif
#if MK_NFOLD == 2 && MK_HBF
                        EpiResid3 E{nullptr, DM, 1.0f, (float*)(ws + WS_BIG), DM, nullptr, nullptr, XN, SSQH(5), (LAS float*)(F.lds + LDSCTL_OFF + 1024)};
#elif MK_NFOLD == 2
                        EpiResid2 E{hres, DM, 1.0f, (float*)(ws + WS_BIG), DM, hres, hres + (size_t)MP * DM, XN, SSQH(5), (unsigned*)(ws + WS_FIXCNT) + 5 * 64, (LAS float*)(F.lds + LDSCTL_OFF + 1024)};
#else
                        EpiResid E{hres, DM, args.dry ? 0.f : 1.0f, (float*)(ws + WS_BIG), DM, hres, hres + (size_t)MP * DM};
#endif
                        if (MK_STAGGER && ((blockIdx.x >> 3) & 3)) { const unsigned long long t0_ = wall_clock64(), d_ = (unsigned long long)(((blockIdx.x >> 3) & 3) * MK_STAGGER); while (wall_clock64() - t0_ < d_) __builtin_amdgcn_s_sleep(4); }
                pg8::gemm_phase<EpiRes, ResOrder, true, MK_SP2, RES_TQ>(F.lds + RING_OFF, g, S, E, F.tid); } PH_END
                    if (MK_NFOLD == 2 && !RES_TQ) { PH_BEGIN if (MK_HBF) tail_fix_phase_b(F, XN, nullptr, (const float*)(ws + WS_BIG), DM, nullptr, SSQH(5)); else tail_fix_phase(F, hres, XN, (const float*)(ws + WS_BIG), DM, nullptr, SSQH(5)); PH_END }
                }
            }
        }
        if (l == 0) {
            if (MK_NFOLD < 2) { PH_BEGIN norm_phase(F, hres, args.in[I_KVN], XN, (const float*)(ws + WS_PART), DM, args.dry, nullptr, MK_NFOLD ? SSQH(3) : nullptr); PH_END }
            PH_BEGIN {
                pg8::Gemm g{XN, (const bf16*)(ws + WS_WDKV), MT, DKVP, DM, DM, 0, 0}; SO S; S.init(MT, DKVP, F.G, MK_CID);
                EpiF32 E{(float*)(ws + WS_SMALL), DKVP};
                pg8::gemm_phase<EpiF32, SO, true, MK_SP2>(F.lds + RING_OFF, g, S, E, F.tid); } PH_END
            PH_BEGIN latent_phase(args, F); PH_END
        }
    }
    if (!RES_TQ) { PH_BEGIN if (MK_NFOLD == 2 && MK_HBF) tail_fix_phase_b(F, XN, hres, (const float*)(ws + WS_PART), DM, nullptr, nullptr); else fixup_phase(F, hres, (const float*)(ws + WS_PART), DM, args.dry); PH_END }
#undef PH_BEGIN
#undef PH_END
    if (MK_SPINEND && MK_SPINMASK && blockIdx.x == 0) { if (wave0 == 0 && lane_id_asm() == 0) { const unsigned long long d_ = *(volatile LAS unsigned long long*)(F0.lds + MISC_OFF + 120) * MK_SPINMUL, t1_ = wall_clock64(); while (wall_clock64() - t1_ < d_) __builtin_amdgcn_s_sleep(8); } __syncthreads(); }
    if (MK_BARWAIT && blockIdx.x == MK_BARWAIT_BLK) { if (threadIdx.x == 0) { const unsigned long long d_ = *(volatile LAS unsigned long long*)(F0.lds + MISC_OFF + 104) * MK_SPINMUL, t1_ = wall_clock64(); while (wall_clock64() - t1_ < d_) __builtin_amdgcn_s_sleep(8); } __syncthreads(); }
    if (MK_CLKPH >= 0 && blockIdx.x == 0 && threadIdx.x == 0) args.out[0] = *(volatile LAS float*)(F0.lds + MISC_OFF + 88);
}
constexpr int N_PHASES = 1 + (2 + 1 + 4 + 3 + 3) + (2 + 1 + 6 + 3) + 1 - (MK_QFUSE ? 1 : 0) - (MK_QLFUSE ? 1 : 0)  - ((MK_NFOLD == 2 && MK_HBF && MK_TQ) ? 6 : 0);

#if defined(MK_DEBUG)
constexpr size_t WS_DBG = 985 * MiB;
constexpr size_t WS_DBG_VS = WS_DBG, WS_DBG_VP = WS_DBG + 16 * MiB, WS_DBG_EY = WS_DBG + 20 * MiB, WS_DBG_H = WS_DBG + 21 * MiB, WS_DBG_Q = WS_DBG + 22 * MiB;
constexpr int DBG_ACC = 8192;
__device__ __forceinline__ float dbf(const bf16* p, size_t i) { return __uint_as_float((unsigned)p[i] << 16); }
__device__ __forceinline__ void dacc(unsigned char* ws, int k, float got, float exp) { float* a = (float*)(ws + WS_CTL) + DBG_ACC; atomicAdd(&a[2 * k], (got - exp) * (got - exp)); atomicAdd(&a[2 * k + 1], exp * exp); }
__device__ __forceinline__ unsigned dhash(unsigned x) { x ^= x >> 16; x *= 0x7feb352dU; x ^= x >> 15; x *= 0x846ca68bU; x ^= x >> 16; return x; }
__device__ __forceinline__ float dsilu(float a) { return a / (1.0f + __builtin_amdgcn_exp2f(-1.4426950408889634f * a)); }
__device__ __forceinline__ void dsincos(int pos, int j, int half, float& sn, float& cs) { const float inv = __builtin_amdgcn_exp2f(-(float)j / (float)half * 13.287712379549449f); sincos_d((double)pos * (double)inv, sn, cs); }
__device__ __forceinline__ int dpos(int tok) { return tok < MP ? (tok & (SEQ - 1)) : PAST + (tok & 63); }
__device__ __forceinline__ float dgamma_lg2(int h) { return lg2gamma(h); }

__global__ void dbg_k0(Args A) { const int s = blockIdx.x * blockDim.x + threadIdx.x; unsigned char* ws = A.ws;
    const int row = dhash(s) % MT, j = dhash(s + 77777) % DFF; const bf16* XN = (const bf16*)(ws + WS_XN); const float* W = A.in[I_F1IN];
    float a = 0.f, b = 0.f; for (int k = 0; k < DM; ++k) { const float x = dbf(XN, (size_t)row * DM + k); a += x * W[(size_t)k * 2 * DFF + j]; b += x * W[(size_t)k * 2 * DFF + DFF + j]; }
    dacc(ws, 0, dbf((const bf16*)(ws + WS_BIG), (size_t)row * DFF + j), dsilu(a) * b); }
__global__ void dbg_k1(Args A) { const int s = blockIdx.x * blockDim.x + threadIdx.x; unsigned char* ws = A.ws;
    const int row = dhash(s) % MT, c = dhash(s + 1234567) % DM; const bf16* HID = (const bf16*)(ws + WS_BIG); const float* W = A.in[I_F1OUT];
    float a = 0.f; for (int k = 0; k < DFF; ++k) a += dbf(HID, (size_t)row * DFF + k) * W[(size_t)k * DM + c];
    const float x = row < MP ? A.in[I_XP][(size_t)row * DM + c] : A.in[I_XS][(size_t)(row - MP) * DM + c];
    dacc(ws, 1, A.out[(size_t)row * DM + c] - x, 0.5f * a); }
__global__ void dbg_k2(Args A) { const int s = blockIdx.x * blockDim.x + threadIdx.x; unsigned char* ws = A.ws;
    const bf16* XN = (const bf16*)(ws + WS_XN); const bf16* QK = (const bf16*)(ws + WS_BIG); const float* W = A.in[I_RIN];
    const int row = dhash(s) % MT, col = dhash(s + 424242) % RIN; float exp;
    if (col < 4096) { const int h = (col >> 8) & 7, d = col & 255, j = d & 127, c1 = (col & ~255) + j, c2 = c1 + 128; float x1 = 0.f, x2 = 0.f;
        for (int k = 0; k < DM; ++k) { const float x = dbf(XN, (size_t)row * DM + k); x1 += x * W[(size_t)k * RIN + c1]; x2 += x * W[(size_t)k * RIN + c2]; }
        float sn, cs; dsincos(dpos(row), j, 128, sn, cs);
        const float r = d < 128 ? x1 * cs - x2 * sn : x1 * sn + x2 * cs; const float e = (float)((row & 63) + 1) * dgamma_lg2(h);
        exp = col < 2048 ? r * __builtin_amdgcn_exp2f(e) * 0.0625f : r * __builtin_amdgcn_exp2f(-e);
    } else { float a = 0.f; for (int k = 0; k < DM; ++k) a += dbf(XN, (size_t)row * DM + k) * W[(size_t)k * RIN + col]; exp = col < 8192 ? a : dsilu(a); }
    dacc(ws, 2, dbf(QK, (size_t)row * RIN + col), exp); }
__global__ void dbg_snapv(Args A) { unsigned char* ws = A.ws; const bf16* QK = (const bf16*)(ws + WS_BIG);
    for (size_t i = (size_t)blockIdx.x * blockDim.x + threadIdx.x; i < (size_t)MS * 4096; i += (size_t)gridDim.x * blockDim.x) { const size_t r = i >> 12, c = i & 4095; ((bf16*)(ws + WS_DBG_VS))[i] = QK[(MP + r) * RIN + 4096 + c]; }
    for (size_t i = (size_t)blockIdx.x * blockDim.x + threadIdx.x; i < (size_t)NBP * 64 * 4096; i += (size_t)gridDim.x * blockDim.x) { const size_t r = i >> 12, c = i & 4095, b = r >> 6, t = r & 63; ((bf16*)(ws + WS_DBG_VP))[i] = QK[(b * SEQ + t) * RIN + 4096 + c]; } }
__global__ void dbg_k3(Args A) { const int s = blockIdx.x * blockDim.x + threadIdx.x; unsigned char* ws = A.ws; const bf16* QK = (const bf16*)(ws + WS_BIG);
    const bool smp = (s & 1) != 0; const int h = dhash(s) & 7, dv = dhash(s + 999) & 511, t = dhash(s + 5555) & 63;
    const int b = smp ? (dhash(s + 31337) & 31) : (dhash(s + 31337) & 7); const size_t tok0 = smp ? (size_t)MP + b * 64 : (size_t)b * SEQ;
    const bf16* V = smp ? (const bf16*)(ws + WS_DBG_VS) + (size_t)b * 64 * 4096 : (const bf16*)(ws + WS_DBG_VP) + (size_t)b * 64 * 4096;
    float o = 0.f;
    for (int sidx = 0; sidx <= t; ++sidx) { float qk = 0.f; for (int d = 0; d < 256; ++d) qk += dbf(QK, (tok0 + t) * RIN + h * 256 + d) * dbf(QK, (tok0 + sidx) * RIN + 2048 + h * 256 + d);
        o += qk * dbf(V, (size_t)sidx * 4096 + h * 512 + dv); }
    if (smp) { const float* S = A.in[I_STATE] + (size_t)(b * RH + h) * RDK * RDV; for (int d = 0; d < 256; ++d) o += dbf(QK, (tok0 + t) * RIN + h * 256 + d) * S[(size_t)d * RDV + dv]; }
    dacc(ws, 3, dbf(QK, (tok0 + t) * RIN + 4096 + h * 512 + dv), o);
    if (smp) { const int dk = dhash(s + 2222) & 255; const float* S = A.in[I_STATE] + (size_t)(b * RH + h) * RDK * RDV; float u = S[(size_t)dk * RDV + dv];
        for (int sidx = 0; sidx < 64; ++sidx) u += dbf(QK, (tok0 + sidx) * RIN + 2048 + h * 256 + dk) * dbf(V, (size_t)sidx * 4096 + h * 512 + dv);
        u *= __builtin_amdgcn_exp2f(64.0f * dgamma_lg2(h)); dacc(ws, 3, A.out[OUT_RETS + (size_t)(b * RH + h) * RDK * RDV + (size_t)dk * RDV + dv], u); }
    { const int pidx = smp ? 64 + b * 8 + h : b * 8 + h; const int s2 = dhash(s + 4444) & 63; float qk = 0.f;
      for (int d = 0; d < 256; ++d) qk += dbf(QK, (tok0 + t) * RIN + h * 256 + d) * dbf(QK, (tok0 + s2) * RIN + 2048 + h * 256 + d);
      dacc(ws, 3, dbf((const bf16*)(ws + WS_DBG + 24 * MiB), (size_t)pidx * 4096 + t * 64 + s2), s2 <= t ? qk : 0.f); }
    { float mu = 0.f; for (int d = 0; d < 512; ++d) mu += dbf(QK, (tok0 + t) * RIN + 4096 + h * 512 + d); mu *= (1.0f / 512); float var = 0.f;
      for (int d = 0; d < 512; ++d) { const float x = dbf(QK, (tok0 + t) * RIN + 4096 + h * 512 + d) - mu; var += x * x; } var *= (1.0f / 512);
      const float y = dbf(QK, (tok0 + t) * RIN + 8192 + h * 512 + dv) * ((dbf(QK, (tok0 + t) * RIN + 4096 + h * 512 + dv) - mu) * __builtin_amdgcn_rsqf(var + EPS) * A.in[I_RGN][h * 512 + dv]);
      ((float*)(ws + WS_DBG_EY))[s] = y; } }
__global__ void dbg_k4(Args A) { const int s = blockIdx.x * blockDim.x + threadIdx.x; unsigned char* ws = A.ws; const bf16* QK = (const bf16*)(ws + WS_BIG);
    const bool smp = (s & 1) != 0; const int h = dhash(s) & 7, dv = dhash(s + 999) & 511, t = dhash(s + 5555) & 63;
    const int b = smp ? (dhash(s + 31337) & 31) : (dhash(s + 31337) & 7); const size_t tok0 = smp ? (size_t)MP + b * 64 : (size_t)b * SEQ;
    dacc(ws, 4, dbf(QK, (tok0 + t) * RIN + 4096 + h * 512 + dv), ((const float*)(ws + WS_DBG_EY))[s]);
    const int row = dhash(s + 10101) % MT, c = dhash(s + 20202) % DM; ((float*)(ws + WS_DBG_H))[s] = A.out[(size_t)row * DM + c]; }
__global__ void dbg_k5(Args A) { const int s = blockIdx.x * blockDim.x + threadIdx.x; unsigned char* ws = A.ws; const bf16* QK = (const bf16*)(ws + WS_BIG);
    const int row = dhash(s + 10101) % MT, c = dhash(s + 20202) % DM; const float* W = A.in[I_ROUT]; float a = 0.f;
    for (int k = 0; k < RHV; ++k) a += dbf(QK, (size_t)row * RIN + 4096 + k) * W[(size_t)k * DM + c];
    dacc(ws, 5, A.out[(size_t)row * DM + c] - ((const float*)(ws + WS_DBG_H))[s], a); }
__global__ void dbg_k6a(Args A) { const int s = blockIdx.x * blockDim.x + threadIdx.x; unsigned char* ws = A.ws; const bf16* XN = (const bf16*)(ws + WS_XN);
    const float* CKR = (const float*)(ws + WS_SMALL); const int row = dhash(s) % MT, c = dhash(s + 4321) % (KVL + ROPE); const float* W = A.in[I_WDKV];
    float a = 0.f; for (int k = 0; k < DM; ++k) a += dbf(XN, (size_t)row * DM + k) * W[(size_t)k * (KVL + ROPE) + c];
    dacc(ws, 6, CKR[(size_t)row * DKVP + c], a); }
__global__ void dbg_k6(Args A) { const int s = blockIdx.x * blockDim.x + threadIdx.x; unsigned char* ws = A.ws;
    const float* CKR = (const float*)(ws + WS_SMALL); const int row = dhash(s) % MT, c = dhash(s + 4321) % (KVL + ROPE);
    const float* r = CKR + (size_t)row * DKVP; float got, exp;
    if (c < KVL) { float ss = 0.f; for (int k = 0; k < KVL; ++k) ss += r[k] * r[k]; exp = r[c] * __builtin_amdgcn_rsqf(ss / KVL + EPS) * A.in[I_KVLN][c];
        got = row < MP ? A.out[OUT_CKVP + (size_t)row * KVL + c] : A.out[OUT_CKVS + (size_t)(row - MP) * KVL + c];
        const int kvrow = row < MP ? row : MP + ((row - MP) >> 6) * KVT + PAST + (row & 63); dacc(ws, 6, dbf((const bf16*)(ws + WS_CALL), (size_t)kvrow * KVL + c), exp);
    } else { const int j = (c - KVL) & 31; const float x1 = r[KVL + j], x2 = r[KVL + 32 + j]; float sn, cs; dsincos(dpos(row), j, 32, sn, cs);
        exp = (c - KVL) < 32 ? x1 * cs - x2 * sn : x1 * sn + x2 * cs; got = row < MP ? A.out[OUT_KRP + (size_t)row * ROPE + (c - KVL)] : A.out[OUT_KRS + (size_t)(row - MP) * ROPE + (c - KVL)]; }
    dacc(ws, 6, got, exp); }
__global__ void dbg_k7(Args A) { const int s = blockIdx.x * blockDim.x + threadIdx.x; unsigned char* ws = A.ws;
    { const bf16* QLN = (const bf16*)(ws + WS_QLN); const int row = dhash(s) % MT, c = dhash(s + 8888) % QW; const float* W = A.in[I_WUQ]; float a = 0.f;
      for (int k = 0; k < QLR; ++k) a += dbf(QLN, (size_t)row * QLR + k) * W[(size_t)k * QW + c];
      dacc(ws, 7, dbf((const bf16*)(ws + WS_Q), (size_t)row * QW + c), a); }
    { const bf16* CA = (const bf16*)(ws + WS_CALL); const int row = dhash(s + 99) % KVROWS, c = dhash(s + 7777) % KVW; const float* W = A.in[I_WUKV]; float a = 0.f;
      for (int k = 0; k < KVL; ++k) a += dbf(CA, (size_t)row * KVL + k) * W[(size_t)k * KVW + c];
      dacc(ws, 7, dbf((const bf16*)(ws + WS_BIG), (size_t)row * KVW + c), a); }
    { const int row = dhash(s + 606) % MT, hd = dhash(s + 707) & 15; for (int d = 0; d < QKH; ++d) ((bf16*)(ws + WS_DBG_Q))[(size_t)s * QKH + d] = ((const bf16*)(ws + WS_Q))[(size_t)row * QW + hd * QKH + d]; } }
__global__ void dbg_k8(Args A) { const int s = blockIdx.x * blockDim.x + threadIdx.x; unsigned char* ws = A.ws;
    { const int row = dhash(s + 606) % MT, hd = dhash(s + 707) & 15; const bf16* q = (const bf16*)(ws + WS_DBG_Q) + (size_t)s * QKH;
      float ss = 0.f; for (int d = 0; d < QKH; ++d) { float x;
          if (d < NOPE) x = dbf(q, d); else { const int j = (d - NOPE) & 31; const float x1 = dbf(q, NOPE + j), x2 = dbf(q, NOPE + 32 + j); float sn, cs; dsincos(dpos(row), j, 32, sn, cs);
              x = (d - NOPE) < 32 ? x1 * cs - x2 * sn : x1 * sn + x2 * cs; }
          ss += x * x; }
      const float rs = __builtin_amdgcn_rsqf(ss / QKH + EPS); const int d = dhash(s + 808) % QKH; float x;
      if (d < NOPE) x = dbf(q, d); else { const int j = (d - NOPE) & 31; const float x1 = dbf(q, NOPE + j), x2 = dbf(q, NOPE + 32 + j); float sn, cs; dsincos(dpos(row), j, 32, sn, cs);
          x = (d - NOPE) < 32 ? x1 * cs - x2 * sn : x1 * sn + x2 * cs; }
      dacc(ws, 8, dbf((const bf16*)(ws + WS_Q), (size_t)row * QW + hd * QKH + d), x * rs * A.in[I_QN][d] * A.in[I_KN][d] * 0.07216878364870322f * 1.4426950408889634f); }
    { const int row = dhash(s + 99) % KVROWS, hd = dhash(s + 555) & 15; const bf16* KVb = (const bf16*)(ws + WS_BIG); const bf16* KRb = (const bf16*)(ws + WS_KRALL); float ss = 0.f;
      for (int d = 0; d < NOPE; ++d) { const float x = dbf(KVb, (size_t)row * KVW + hd * 256 + d); ss += x * x; } for (int d = 0; d < ROPE; ++d) { const float x = dbf(KRb, (size_t)row * ROPE + d); ss += x * x; }
      dacc(ws, 8, ((const float*)(ws + WS_RS))[(size_t)row * MH + hd], __builtin_amdgcn_rsqf(ss / QKH + EPS)); } }
__global__ void dbg_k9(Args A) { const int s = blockIdx.x * blockDim.x + threadIdx.x; unsigned char* ws = A.ws;
    const bf16* Q = (const bf16*)(ws + WS_Q); const bf16* KVb = (const bf16*)(ws + WS_BIG); const bf16* KRb = (const bf16*)(ws + WS_KRALL); const float* RSs = (const float*)(ws + WS_RS);
    const int row = (s & 1) ? MP + (int)(dhash(s) % MS) : (int)(dhash(s) % MP); const int hd = dhash(s + 1111) & 15, d = dhash(s + 3333) & 127;
    int kv0, nk; if (row < MP) { const int b = row >> 11, t = row & 2047; kv0 = b * SEQ; nk = ((t >> 6) + 1) * 64; } else { const int b = (row - MP) >> 6; kv0 = MP + b * KVT; nk = KVT; }
    float m = -1e30f, l = 0.f, o = 0.f;
    for (int k = 0; k < nk; ++k) { float sc = 0.f; for (int e = 0; e < NOPE; ++e) sc += dbf(Q, (size_t)row * QW + hd * QKH + e) * dbf(KVb, (size_t)(kv0 + k) * KVW + hd * 256 + e);
        for (int e = 0; e < ROPE; ++e) sc += dbf(Q, (size_t)row * QW + hd * QKH + NOPE + e) * dbf(KRb, (size_t)(kv0 + k) * ROPE + e);
        sc *= RSs[(size_t)(kv0 + k) * MH + hd]; const float mn = fmaxf(m, sc), al = __builtin_amdgcn_exp2f(m - mn), p = __builtin_amdgcn_exp2f(sc - mn); l = l * al + p; o = o * al + p * dbf(KVb, (size_t)(kv0 + k) * KVW + hd * 256 + NOPE + d); m = mn; }
    dacc(ws, 9, dbf((const bf16*)(ws + WS_O), (size_t)row * DM + hd * VHD + d), o / l); }
__global__ void dbg_final(Args A) { if (threadIdx.x == 0 && blockIdx.x == 0) { const float* a = (const float*)(A.ws + WS_CTL) + DBG_ACC; unsigned bits = 0;
        for (int k = 0; k < 10; ++k) { const float e = a[2 * k], r = a[2 * k + 1]; if (!(e <= 2e-3f * r) || !(r > 0.f)) bits |= 1u << k; }
        float v = (float)(10 + (bits & 63)); for (unsigned i = 0; i < 2 + (bits >> 6); ++i) v *= 10.f; A.out[0] = v; } }
__global__ void dbg_stamp(Args A, int which) { if (threadIdx.x == 0 && blockIdx.x == 0) { ((unsigned long long*)(A.ws + WS_CTL))[4200 + which] = wall_clock64(); ((unsigned long long*)(A.ws + WS_CTL))[4210 + which] = clock64(); } }
__global__ void dbg_final_time(Args A) { if (threadIdx.x == 0 && blockIdx.x == 0) { const unsigned long long* t = (const unsigned long long*)(A.ws + WS_CTL) + 4200; const unsigned long long* c = t + 10; const float mhz = (float)(c[1] - c[0]) / (float)(t[1] - t[0]) * 100.0f; A.out[0] = 1000.0f * __builtin_floorf(mhz * (1.0f / 300.0f)); } }
#endif

extern "C" void kernel_launch(void* const* d_in, const int* in_sizes, int n_in, void* d_out, int out_size, void* d_ws, size_t ws_size, hipStream_t stream) {
    static int grid = 0;
    if (grid == 0) {
        if (n_in != 25 || out_size != (int)OUT_END || ws_size < WS_END) { fprintf(stderr, "kernel_launch: shape mismatch: n_in %d out %d ws %zu (need %zu)\n", n_in, out_size, ws_size, (size_t)WS_END); grid = -1; return; }
        int dev = 0, cus = 0, per_cu = 0;
        if (hipGetDevice(&dev) != hipSuccess || hipDeviceGetAttribute(&cus, hipDeviceAttributeMultiprocessorCount, dev) != hipSuccess) { grid = -1; return; }
        if (hipFuncSetAttribute((const void*)yoco_fwd, hipFuncAttributeMaxDynamicSharedMemorySize, LDS_BYTES) != hipSuccess) { fprintf(stderr, "kernel_launch: hipFuncSetAttribute failed\n"); grid = -1; return; }
        if (hipOccupancyMaxActiveBlocksPerMultiprocessor(&per_cu, (const void*)yoco_fwd, NWAVES * 64, LDS_BYTES) != hipSuccess || per_cu < 1) { fprintf(stderr, "kernel_launch: occupancy query says %d blocks per CU\n", per_cu); (void)hipGetLastError(); grid = -1; return; }
        grid = cus;
    }
    if (grid < 0) return;
    (void)hipMemsetAsync((char*)d_ws + WS_CTL, 0, CTL_ZERO_BYTES, stream);
    Args a{};
    for (int i = 0; i < 25; ++i) a.in[i] = (const float*)d_in[i];
    a.out = (float*)d_out; a.ws = (unsigned char*)d_ws;
    const int last = N_PHASES < MK_LAST_PHASE ? N_PHASES : MK_LAST_PHASE;
#if MK_ONE_LAUNCH
    a.ph_lo = 0; a.ph_hi = last;
    hipLaunchKernelGGL(yoco_fwd, dim3(grid), dim3(NWAVES * 64), LDS_BYTES, stream, a);
#if defined(MK_TWOPASS)
    (void)hipMemsetAsync((char*)d_ws + WS_CTL, 0, CTL_ZERO_BYTES, stream);
    a.dry = 1; hipLaunchKernelGGL(yoco_fwd, dim3(grid), dim3(NWAVES * 64), LDS_BYTES, stream, a);
#endif
#else
    for (int p = 0; p < last; ++p) { a.ph_lo = p; a.ph_hi = p + 1;
#if defined(MK_DEBUG) && defined(MK_TIMEP)
        if (p == MK_TIMEP) hipLaunchKernelGGL(dbg_stamp, dim3(1), dim3(64), 0, stream, a, 0);
#endif
        for (int rep = ((p == MK_REP || ((MK_REPMASK >> p) & 1u)) ? MK_REPN : 1); rep > 0; --rep) { a.dry = rep > 1 ? 1 : 0; hipLaunchKernelGGL(yoco_fwd, dim3(grid), dim3(NWAVES * 64), LDS_BYTES, stream, a); }
#if defined(MK_DEBUG) && defined(MK_TIMEP)
        if (p == MK_TIMEP) hipLaunchKernelGGL(dbg_stamp, dim3(1), dim3(64), 0, stream, a, 1);
        if (p == last - 1) hipLaunchKernelGGL(dbg_final_time, dim3(1), dim3(64), 0, stream, a);
        continue;
#endif
#if defined(MK_DEBUG)
        constexpr int NSB = 16;
        if (p == 1) hipLaunchKernelGGL(dbg_k0, dim3(NSB), dim3(256), 0, stream, a);
        if (p == 3) hipLaunchKernelGGL(dbg_k1, dim3(NSB), dim3(256), 0, stream, a);
        if (p == 4) { hipLaunchKernelGGL(dbg_k2, dim3(NSB), dim3(256), 0, stream, a); hipLaunchKernelGGL(dbg_snapv, dim3(1024), dim3(256), 0, stream, a); }
        if (p == 5) hipLaunchKernelGGL(dbg_k3, dim3(NSB), dim3(256), 0, stream, a);
        if (p == 6) hipLaunchKernelGGL(dbg_k4, dim3(NSB), dim3(256), 0, stream, a);
        if (p == 8) hipLaunchKernelGGL(dbg_k5, dim3(NSB), dim3(256), 0, stream, a);
        if (p == 12) hipLaunchKernelGGL(dbg_k6a, dim3(NSB), dim3(256), 0, stream, a);
        if (p == 13) hipLaunchKernelGGL(dbg_k6, dim3(NSB), dim3(256), 0, stream, a);
        if (p == 19) hipLaunchKernelGGL(dbg_k7, dim3(NSB), dim3(256), 0, stream, a);
        if (p == 20) hipLaunchKernelGGL(dbg_k8, dim3(NSB), dim3(256), 0, stream, a);
        if (p == 21) hipLaunchKernelGGL(dbg_k9, dim3(NSB), dim3(256), 0, stream, a);
        if (p == last - 1) hipLaunchKernelGGL(dbg_final, dim3(1), dim3(64), 0, stream, a);
#endif
    }
#endif
    const hipError_t le = hipPeekAtLastError();
    if (le != hipSuccess) fprintf(stderr, "kernel_launch: launch failed: %s\n", hipGetErrorName(le));
}
```

```cpp
#include <hip/hip_runtime.h>
#include <cstdio>
#include <cstdint>

#define MK_BLK 0
#ifndef MK_ONE_LAUNCH
#define MK_ONE_LAUNCH 1
#endif
#ifndef MK_REP
#define MK_REP (-1)
#endif
#ifndef MK_DBLBAR
#define MK_DBLBAR 0
#endif
#ifndef MK_ALIGN_SWIGLU
#define MK_ALIGN_SWIGLU true
#endif
#ifndef MK_WARMMFMA
#define MK_WARMMFMA 0
#endif
#ifndef MK_BLK
#define MK_BLK 1
#endif
#ifndef MK_STAGGER
#define MK_STAGGER 0
#endif
#ifndef MK_XTAIL
#define MK_XTAIL 1
#endif
#ifndef MK_ATTN_LAZY
#define MK_ATTN_LAZY 1
#endif
#ifndef MK_ATTN_DELAY
#define MK_ATTN_DELAY 0
#endif
#ifndef MK_SCAN_PF
#define MK_SCAN_PF 0
#endif
#ifndef MK_SCAN_IL
#define MK_SCAN_IL 0
#endif
#ifndef MK_STAGKV
#define MK_STAGKV 0
#endif
#ifndef MK_NFOLD
#define MK_NFOLD 2
#endif
#ifndef MK_CONVUNROLL
#define MK_CONVUNROLL 16
#endif
#ifndef MK_DEFSPLIT0
#define MK_DEFSPLIT0 1000
#define MK_DEFSPLIT1 1000
#define MK_DEFSPLIT2 1000
#define MK_DEFSPLIT3 1000
#define MK_DEFSPLIT4 1000
#endif
#ifndef MK_DEFNT
#define MK_DEFNT 1
#endif
#ifndef MK_DEFUNROLL
#define MK_DEFUNROLL 64
#endif
#ifndef MK_DEFER
#define MK_DEFER 2
#endif
#ifndef MK_TQ
#define MK_TQ 2
#endif
#ifndef MK_HBF
#define MK_HBF 1
#endif
#ifndef MK_SPINEND
#define MK_SPINEND 0
#endif
#ifndef MK_SPINCLK
#define MK_SPINCLK 0
#endif
#ifndef MK_QLFUSE
#define MK_QLFUSE 1
#endif
#ifndef MK_HALFTAIL
#define MK_HALFTAIL 0
#endif
#ifndef MK_QFUSE
#define MK_QFUSE 1
#endif
#ifndef MK_BARWAIT
#define MK_BARWAIT 0
#endif
#ifndef MK_BARMASK
#define MK_BARMASK 0xffffffffu
#endif
#ifndef MK_BARWAIT_BLK
#define MK_BARWAIT_BLK 0
#endif
#ifndef MK_ATTN_PRIO
#define MK_ATTN_PRIO 0
#endif
#ifndef MK_ATTN_DRYMODE
#define MK_ATTN_DRYMODE 0
#endif
#ifndef MK_ATTN_IL
#define MK_ATTN_IL 0
#endif
#ifndef MK_SCRAMBLE
#define MK_SCRAMBLE 0
#endif
#ifndef MK_PRETOUCH
#define MK_PRETOUCH 0
#endif
#ifndef MK_SP2
#define MK_SP2 true
#endif
#ifndef MK_CLKPH
#define MK_CLKPH (-1)
#endif
#ifndef MK_CLKMODE
#define MK_CLKMODE 0
#endif
#ifndef MK_SPINMUL
#define MK_SPINMUL 1
#endif
#ifndef MK_NORM2
#define MK_NORM2 1
#endif
#ifndef MK_SPINMASK
#define MK_SPINMASK 0u
#endif
#ifndef MK_REPMASK
#define MK_REPMASK 0u
#endif
#ifndef MK_REPN
#define MK_REPN 2
#endif
#ifndef MK_LAST_PHASE
#define MK_LAST_PHASE 1000
#endif

namespace pg8 {
#define PG8_LAS __attribute__((address_space(3)))
typedef unsigned short bf16_t;
typedef short bf16x8 __attribute__((ext_vector_type(8)));
typedef float f32x4 __attribute__((ext_vector_type(4)));
typedef unsigned u32x4 __attribute__((ext_vector_type(4)));
constexpr int BM = 256, BK = 64, HALF = 128, HTB = HALF * BK * 2  , STAGE_BYTES = 8 * HTB, NXCD = 8, WGM = 8;

__host__ __device__ __forceinline__ int lds_byte(int r, int c) { const int st = (r >> 4) * 2 + (c >> 5), rr = r & 15, cc = c & 31, ob = rr * 64 + cc * 2; return st * 1024 + (ob ^ (((ob >> 9) & 1) << 5)); }
__host__ __device__ __forceinline__ void stage_rc(int b, int& R, int& C) { const int st = b / 1024, sb = b % 1024, swz = sb ^ (((sb >> 9) & 1) << 5); R = (st >> 1) * 16 + swz / 64; C = (st & 1) * 32 + (swz % 64) / 2; }
__host__ __device__ __forceinline__ int perm32(int rho) { const int n = rho >> 4, i = rho & 15; return 8 * (i >> 2) + 4 * n + (i & 3); }

struct Unit { int pm, pn, k0, nkt, part, half, par; };
struct Gemm { const bf16_t* A; const bf16_t* Bt; int M, N, K, lda, blkA, blkB; };

struct StaticOrder {
    static constexpr bool HAS_HALF = false;
    int nM, nN, nwg, G, c; bool xt;
    __host__ __device__ void init(int M, int N, int G_, int c_) { nM = M / BM; nN = N / BM; nwg = nM * nN; G = G_; c = c_; xt = false; }
    __host__ __device__ bool next(int i, Unit& u) const {
        int wgid;
        const int R = nwg / G, rem = nwg - R * G;
        if (xt && i == R && rem > 0 && G % NXCD == 0 && rem % NXCD == 0 && nwg % NXCD == 0) {
            const int v = (c % NXCD) * (G / NXCD) + c / NXCD; if (v >= rem) return false;
            const int per = rem / NXCD, q = nwg / NXCD; wgid = (v / per) * q + (q - per) + (v % per);
        } else {
        const long L = (long)i * G + c; if (L >= nwg) return false;
        wgid = (int)L; { const int q = nwg / NXCD, r = nwg % NXCD, xcd = wgid % NXCD, off = wgid / NXCD; wgid = (xcd < r ? xcd * (q + 1) : r * (q + 1) + (xcd - r) * q) + off; }
        }
        const int nig = WGM * nN, gid = wgid / nig, fm = gid * WGM, gsz = (nM - fm) < WGM ? (nM - fm) : WGM;
        u.pm = fm + ((wgid % nig) % gsz); u.pn = (wgid % nig) / gsz; u.k0 = 0; u.nkt = 0; u.part = 0; u.half = 0; return true;
    }
    __device__ __forceinline__ void a_ready(const Unit&) const {}
    __device__ __forceinline__ void done(const Unit&) const {}
};
struct TqOrder {
    static constexpr bool HAS_HALF = false;
    StaticOrder so;
    __host__ __device__ void init(int M, int N, int G_, int c_) { so.nM = M / 192; so.nN = N / BM; so.nwg = so.nM * so.nN; so.G = G_; so.c = c_; so.xt = false; }
    __host__ __device__ bool next(int i, Unit& u) const { return so.next(i, u); }
    __device__ __forceinline__ void a_ready(const Unit&) const {}
    __device__ __forceinline__ void done(const Unit&) const {}
};
struct SplitTailOrder {
    static constexpr bool HAS_HALF = false;
    StaticOrder so; int nt; bool split;
    __host__ __device__ void init(int K, int G_, int c_) { nt = K / BK; split = (G_ == 256); so.init(split ? 64 * BM : 72 * BM, 8 * BM, G_, c_); }
    __host__ __device__ bool next(int i, Unit& u) const {
        if (!split) return so.next(i, u);
        if (i < 2) return so.next(i, u);
        if (i > 2) return false;
        const int t = so.c >> 2, kq = so.c & 3; u.pm = 64 + (t >> 3); u.pn = t & 7; u.nkt = nt >> 2; u.k0 = kq * u.nkt; u.part = kq + 1; u.half = 0; return true;
    }
    __device__ __forceinline__ void a_ready(const Unit&) const {}
    __device__ __forceinline__ void done(const Unit&) const {}
};

struct HalfTailOrder {
    static constexpr bool HAS_HALF = true;
    StaticOrder so; int R, r; bool cut;
    __host__ __device__ void init(int M, int N, int G_, int c_) { so.init(M, N, G_, c_); R = so.nwg / G_; r = so.nwg - R * G_; cut = (r > 0 && 2 * r <= G_); }
    __host__ __device__ bool next(int i, Unit& u) const {
        if (!cut || i < R) return so.next(i, u);
        if (i > R || so.c >= 2 * r) return false;
        StaticOrder t = so; t.c = so.c >> 1; if (!t.next(R, u)) return false;
        u.half = 1 + (so.c & 1); return true;
    }
    __device__ __forceinline__ void a_ready(const Unit&) const {}
    __device__ __forceinline__ void done(const Unit&) const {}
};


template <class Epi, class Sched, bool ALIGN_EPI = false, bool SP2 = false, int TQ = 0>
__device__ __forceinline__ void gemm_phase(PG8_LAS unsigned char* lds, const Gemm g, const Sched& S, const Epi& E, int tid_) {
    const int tid = tid_, wid = __builtin_amdgcn_readfirstlane(tid >> 6), lane = tid & 63, wr = wid >> 2, wc = wid & 3, fr = lane & 15, fq = lane >> 4;
    const int K = g.K, nt = K / BK, lda = g.lda;
    unsigned voffA[2], voffB[2];
#pragma unroll
    for (int i = 0; i < 2; ++i) { int R, C; stage_rc(tid * 16 + i * 8192, R, C); const int Rb = Epi::PERM ? ((R & ~31) + perm32(R & 31)) : R;
        voffA[i] = (unsigned)(R * (g.blkA ? BK : lda) + C) * 2u; voffB[i] = (unsigned)(Rb * (g.blkB ? BK : K) + C) * 2u; }
    const size_t kstepA = g.blkA ? (size_t)BM * BK * 2 : (size_t)(BK * 2), kstepB = g.blkB ? (size_t)BM * BK * 2 : (size_t)(BK * 2);
    const size_t hstepA = (size_t)(TQ == 2 ? 64 : HALF) * (g.blkA ? BK : lda) * 2, hstepB = (size_t)HALF * (g.blkB ? BK : K) * 2;
    static_assert(!TQ || SP2, "TQ units need the SP2 loop");
    const size_t tstepA = TQ ? (size_t)192 * lda * 2 : g.blkA ? (size_t)nt * BM * BK * 2 : (size_t)BM * lda * 2, tstepB = g.blkB ? (size_t)nt * BM * BK * 2 : 2 * hstepB;
    const unsigned ldsw = (unsigned)wid * 1024u;
    const int aoff = lds_byte(TQ == 2 ? wr * 48 + fr : wr * 64 + fr, fq * 8), boff = lds_byte(wc * 32 + fr, fq * 8);
    const int aoff1 = TQ == 2 ? lds_byte(32 + wr * 48 + fr, fq * 8) : TQ == 1 ? lds_byte(wr * 32 + fr, fq * 8) : aoff;
#define PG8_SA(b, h) (((b) * 2 + (h)) * HTB)
#define PG8_SB(b, h) ((4 + (b) * 2 + (h)) * HTB)
#define PG8_STAGE(bufoff, gbase, voff) do { _Pragma("unroll") for (int _i = 0; _i < 2; ++_i) \
        __builtin_amdgcn_global_load_lds((const unsigned*)((const char*)(gbase) + (voff)[_i]), (PG8_LAS unsigned*)(lds + (bufoff) + ldsw + _i * 8192), 16, 0, 0); } while (0)
#define PG8_LDA(dst, b, h) do { _Pragma("unroll") for (int m = 0; m < (TQ == 2 ? 3 : 4); ++m) _Pragma("unroll") for (int k = 0; k < 2; ++k) dst[m][k] = *(const PG8_LAS bf16x8*)(lds + PG8_SA(b, h) + aoff + m * 2048 + k * 1024); } while (0)
#define PG8_LDB(dst, b, h) do { _Pragma("unroll") for (int n = 0; n < 2; ++n) _Pragma("unroll") for (int k = 0; k < 2; ++k) dst[n][k] = *(const PG8_LAS bf16x8*)(lds + PG8_SB(b, h) + boff + n * 2048 + k * 1024); } while (0)
#define PG8_MMA(ai, bj, At, Bt) do { __builtin_amdgcn_s_setprio(1); _Pragma("unroll") for (int m = 0; m < (TQ == 2 ? 3 : 4); ++m) _Pragma("unroll") for (int n = 0; n < 2; ++n) _Pragma("unroll") for (int k = 0; k < 2; ++k) \
        acc[ai][bj][m][n] = __builtin_amdgcn_mfma_f32_16x16x32_bf16(Bt[n][k], At[m][k], acc[ai][bj][m][n], 0, 0, 0); __builtin_amdgcn_s_setprio(0); } while (0)
#define PG8_STAGE_A1(bufoff, gbase) do { if constexpr (TQ == 1) { _Pragma("unroll") for (int _i = 0; _i < 2; ++_i)   \
        __builtin_amdgcn_global_load_lds((const unsigned*)((const char*)(gbase) + voffA[0]), (PG8_LAS unsigned*)(lds + (bufoff) + ldsw + _i * 8192), 16, 0, 0); } else PG8_STAGE(bufoff, gbase, voffA); } while (0)
#define PG8_LDA1(dst, b) do { _Pragma("unroll") for (int m = 0; m < (TQ == 2 ? 3 : TQ == 1 ? 2 : 4); ++m) _Pragma("unroll") for (int k = 0; k < 2; ++k) dst[m][k] = *(const PG8_LAS bf16x8*)(lds + PG8_SA(b, 1) + aoff1 + m * 2048 + k * 1024); } while (0)
#define PG8_MMA1(bj, At, Bt) do { __builtin_amdgcn_s_setprio(1); _Pragma("unroll") for (int m = 0; m < (TQ == 2 ? 3 : TQ == 1 ? 2 : 4); ++m) _Pragma("unroll") for (int n = 0; n < 2; ++n) _Pragma("unroll") for (int k = 0; k < 2; ++k) \
        acc[1][bj][m][n] = __builtin_amdgcn_mfma_f32_16x16x32_bf16(Bt[n][k], At[m][k], acc[1][bj][m][n], 0, 0, 0); __builtin_amdgcn_s_setprio(0); } while (0)
#define PG8_WAIT_V(n) asm volatile("s_waitcnt vmcnt(" #n ")" ::: "memory")
#define PG8_WAIT_L(n) asm volatile("s_waitcnt lgkmcnt(" #n ")" ::: "memory")
#define PG8_BAR __builtin_amdgcn_s_barrier()
#define PG8_SCHED __builtin_amdgcn_sched_barrier(0)
    Unit cur, nxt; int ui = 0;
    if (!S.next(0, cur)) return;
    f32x4 acc[2][2][4][2];
#pragma unroll
    for (int a = 0; a < 2; ++a)
#pragma unroll
        for (int b = 0; b < 2; ++b)
#pragma unroll
            for (int m = 0; m < 4; ++m)
#pragma unroll
                for (int n = 0; n < 2; ++n) acc[a][b][m][n] = (f32x4){0.f, 0.f, 0.f, 0.f};
    bf16x8 At[4][2], B0[2][2], B1[2][2];
    const char* cA = (const char*)g.A + (size_t)cur.pm * tstepA + (size_t)cur.k0 * kstepA; const char* cB = (const char*)g.Bt + (size_t)cur.pn * tstepB + (size_t)cur.k0 * kstepB;
    S.a_ready(cur);
    if constexpr (SP2) {
        PG8_STAGE(PG8_SB(0, 0), cB, voffB); PG8_STAGE(PG8_SB(0, 1), cB + hstepB, voffB); PG8_STAGE(PG8_SA(0, 0), cA, voffA); PG8_STAGE_A1(PG8_SA(0, 1), cA + hstepA);
        if (wr == 1) PG8_BAR;
        PG8_WAIT_V(2); PG8_BAR;
        PG8_STAGE(PG8_SB(1, 0), cB + kstepB, voffB); PG8_STAGE(PG8_SA(1, 0), cA + kstepA, voffA); PG8_STAGE(PG8_SB(1, 1), cB + hstepB + kstepB, voffB);
        PG8_WAIT_V(6); PG8_BAR;
    } else {
        PG8_STAGE(PG8_SB(0, 0), cB, voffB); PG8_STAGE(PG8_SA(0, 0), cA, voffA); PG8_STAGE(PG8_SB(0, 1), cB + hstepB, voffB); PG8_STAGE(PG8_SA(0, 1), cA + hstepA, voffA);
        if (wr == 1) PG8_BAR;
        PG8_WAIT_V(4); PG8_BAR;
        PG8_STAGE(PG8_SB(1, 0), cB + kstepB, voffB); PG8_STAGE(PG8_SA(1, 0), cA + kstepA, voffA); PG8_STAGE(PG8_SB(1, 1), cB + hstepB + kstepB, voffB);
        PG8_WAIT_V(6); PG8_BAR;
    }
    for (;;) {
        const bool has_next = S.next(ui + 1, nxt);
        const char* nA = has_next ? (const char*)g.A + (size_t)nxt.pm * tstepA + (size_t)nxt.k0 * kstepA : cA; const char* nB = has_next ? (const char*)g.Bt + (size_t)nxt.pn * tstepB + (size_t)nxt.k0 * kstepB : cB;
        const int ntc = cur.nkt ? cur.nkt : nt;
        cur.par = ui & 1;
        if constexpr (Epi::PRE) E.prefetch(lds, cur, tid);
#define PG8_SP2_BODY(DO0, DO1) do { \
            PG8_LDB(B0, 0, 0); PG8_LDB(B1, 0, 1); PG8_SCHED; if (DO0) PG8_LDA(At, 0, 0); PG8_STAGE_A1(PG8_SA(1, 1), a1 + hstepA); \
            PG8_WAIT_V(8); PG8_WAIT_L(0); PG8_BAR; if (DO0) { PG8_MMA(0, 0, At, B0); PG8_MMA(0, 1, At, B1); } PG8_BAR; PG8_SCHED; \
            if (DO1) PG8_LDA1(At, 0); PG8_STAGE(PG8_SB(0, 0), b2, voffB); PG8_STAGE(PG8_SB(0, 1), b2 + hstepB, voffB); PG8_STAGE(PG8_SA(0, 0), a2, voffA); \
            PG8_WAIT_V(8); PG8_WAIT_L(0); PG8_BAR; if (DO1) { PG8_MMA1(0, At, B0); PG8_MMA1(1, At, B1); } PG8_BAR; PG8_SCHED; \
            PG8_LDB(B0, 1, 0); PG8_LDB(B1, 1, 1); PG8_SCHED; if (DO0) PG8_LDA(At, 1, 0); PG8_STAGE_A1(PG8_SA(0, 1), a2 + hstepA); \
            PG8_WAIT_V(8); PG8_WAIT_L(0); PG8_BAR; if (DO0) { PG8_MMA(0, 0, At, B0); PG8_MMA(0, 1, At, B1); } PG8_BAR; PG8_SCHED; \
            if (DO1) PG8_LDA1(At, 1); PG8_STAGE(PG8_SB(1, 0), b3, voffB); PG8_STAGE(PG8_SB(1, 1), b3 + hstepB, voffB); PG8_STAGE(PG8_SA(1, 0), a3, voffA); \
            PG8_WAIT_V(8); PG8_WAIT_L(0); PG8_BAR; if (DO1) { PG8_MMA1(0, At, B0); PG8_MMA1(1, At, B1); } PG8_BAR; PG8_SCHED; } while (0)
#define PG8_TLOOP(DO0, DO1) do { for (int t = 0; t < ntc; t += 2) { \
            const bool last = (t == ntc - 2); \
            const char* a1 = cA + (size_t)(t + 1) * kstepA; \
            const char* a2 = last ? nA : cA + (size_t)(t + 2) * kstepA; const char* b2 = last ? nB : cB + (size_t)(t + 2) * kstepB; \
            const char* a3 = a2 + kstepA; const char* b3 = b2 + kstepB; \
            if (last && has_next) S.a_ready(nxt); \
            PG8_SP2_BODY(DO0, DO1); } } while (0)
        if constexpr (SP2) {
            if constexpr (Sched::HAS_HALF) { if (cur.half == 0) PG8_TLOOP(true, true); else if (cur.half == 1) PG8_TLOOP(true, false); else PG8_TLOOP(false, true); }
            else PG8_TLOOP(true, true);
        } else {
        static_assert(SP2 || !Sched::HAS_HALF, "half units need the SP2 loop");
        for (int t = 0; t < ntc; t += 2) {
            const bool last = (t == ntc - 2);
            const char* a1 = cA + (size_t)(t + 1) * kstepA;
            const char* a2 = last ? nA : cA + (size_t)(t + 2) * kstepA; const char* b2 = last ? nB : cB + (size_t)(t + 2) * kstepB;
            const char* a3 = a2 + kstepA; const char* b3 = b2 + kstepB;
            if (last && has_next) S.a_ready(nxt);
            PG8_LDB(B0, 0, 0); PG8_SCHED; PG8_LDA(At, 0, 0); PG8_STAGE(PG8_SA(1, 1), a1 + hstepA, voffA);
            PG8_WAIT_L(8); PG8_BAR; PG8_WAIT_L(0); PG8_MMA(0, 0, At, B0); PG8_BAR; PG8_SCHED;
            PG8_LDB(B1, 0, 1); PG8_STAGE(PG8_SB(0, 0), b2, voffB);
            PG8_BAR; PG8_WAIT_L(0); PG8_MMA(0, 1, At, B1); PG8_BAR;
            PG8_LDA(At, 0, 1); PG8_STAGE(PG8_SA(0, 0), a2, voffA);
            PG8_BAR; PG8_WAIT_L(0); PG8_MMA(1, 0, At, B0); PG8_BAR; PG8_SCHED;
            PG8_STAGE(PG8_SB(0, 1), b2 + hstepB, voffB);
            PG8_WAIT_V(6); PG8_BAR; PG8_MMA(1, 1, At, B1); PG8_BAR;
            PG8_LDB(B0, 1, 0); PG8_SCHED; PG8_LDA(At, 1, 0); PG8_STAGE(PG8_SA(0, 1), a2 + hstepA, voffA);
            PG8_WAIT_L(8); PG8_BAR; PG8_WAIT_L(0); PG8_MMA(0, 0, At, B0); PG8_BAR; PG8_SCHED;
            PG8_LDB(B1, 1, 1); PG8_STAGE(PG8_SB(1, 0), b3, voffB);
            PG8_BAR; PG8_WAIT_L(0); PG8_MMA(0, 1, At, B1); PG8_BAR;
            PG8_LDA(At, 1, 1); PG8_STAGE(PG8_SA(1, 0), a3, voffA);
            PG8_BAR; PG8_WAIT_L(0); PG8_MMA(1, 0, At, B0); PG8_BAR; PG8_SCHED;
            PG8_STAGE(PG8_SB(1, 1), b3 + hstepB, voffB);
            PG8_WAIT_V(6); PG8_BAR; PG8_MMA(1, 1, At, B1); PG8_BAR;
        }
        }
#undef PG8_TLOOP
#undef PG8_SP2_BODY
        if constexpr (ALIGN_EPI) { if (wr == 0) PG8_BAR; }
        E(acc, cur, wr, wc, fr, fq);
        if (!has_next) break;
#pragma unroll
        for (int a = 0; a < 2; ++a)
#pragma unroll
            for (int b = 0; b < 2; ++b)
#pragma unroll
                for (int m = 0; m < 4; ++m)
#pragma unroll
                    for (int n = 0; n < 2; ++n) acc[a][b][m][n] = (f32x4){0.f, 0.f, 0.f, 0.f};
        cur = nxt; cA = nA; cB = nB; ++ui;
        if constexpr (ALIGN_EPI) { if (wr == 1) PG8_BAR; }
    }
    PG8_WAIT_V(0);
    if constexpr (!ALIGN_EPI) { if (wr == 0) PG8_BAR; }
    PG8_BAR;
#undef PG8_SA
#undef PG8_SB
#undef PG8_STAGE
#undef PG8_LDA
#undef PG8_LDB
#undef PG8_MMA
#undef PG8_STAGE_A1
#undef PG8_LDA1
#undef PG8_MMA1
#undef PG8_WAIT_V
#undef PG8_WAIT_L
#undef PG8_BAR
#undef PG8_SCHED
}
}
constexpr int DM = 2048, NBP = 8, SEQ = 2048, NBS = 32, DSEQ = 64, PAST = 1024, DFF = 5632;
constexpr int MP = NBP * SEQ, MS = NBS * DSEQ, MT = MP + MS;
constexpr int RH = 8, RDK = 256, RDV = 512, RIN = 2 * RH * RDK + 2 * RH * RDV, RHV = RH * RDV;
constexpr int MH = 16, NOPE = 128, ROPE = 64, QKH = 192, VHD = 128, KVL = 512, QLR = 512, QW = MH * QKH;
constexpr int KVT = PAST + DSEQ, KVROWS = MP + NBS * KVT;
constexpr int DKVP = 768, KVW = MH * (NOPE + VHD);
constexpr float EPS = 1e-6f;

constexpr size_t OUT_YP = 0, OUT_YS = (size_t)MP * DM, OUT_RETP = OUT_YS + (size_t)MS * DM, OUT_CKVP = OUT_RETP + (size_t)NBP * RH * RDK * RDV,
                 OUT_KRP = OUT_CKVP + (size_t)MP * KVL, OUT_RETS = OUT_KRP + (size_t)MP * ROPE, OUT_CKVS = OUT_RETS + (size_t)NBS * RH * RDK * RDV,
                 OUT_KRS = OUT_CKVS + (size_t)MS * KVL, OUT_END = OUT_KRS + (size_t)MS * ROPE;
static_assert(OUT_END == 90308608, "output size");

constexpr size_t MiB = 1u << 20;
constexpr size_t WS_CTL = 0, CTL_ZERO_BYTES = 1 * MiB;
constexpr size_t WS_COSR = 1 * MiB, WS_SINR = 2 * MiB;
constexpr size_t WS_COSM = 3 * MiB, WS_SINM = 3 * MiB + 256 * 1024;
constexpr size_t WS_SSQKR = 3 * MiB + 512 * 1024;
constexpr size_t WS_GQK = 3 * MiB + 768 * 1024;
constexpr size_t WS_RS = 4 * MiB;
constexpr size_t WS_KRALL = 21 * MiB;
constexpr size_t WS_CALL = 28 * MiB;
constexpr size_t WS_XN = 78 * MiB;
constexpr size_t WS_SMALL = 150 * MiB;
constexpr size_t WS_QLN = WS_SMALL + 36 * MiB;
constexpr size_t WS_QSSQ = WS_SMALL;
constexpr size_t WS_WL1 = 204 * MiB;
constexpr size_t SZ_WIN = (size_t)2 * DFF * DM * 2, SZ_WOUT = (size_t)DM * DFF * 2;
constexpr size_t WS_WIN10 = WS_WL1, WS_WOUT10 = WS_WIN10 + SZ_WIN, WS_WIN11 = WS_WOUT10 + SZ_WOUT, WS_WOUT11 = WS_WIN11 + SZ_WIN;
constexpr size_t WS_WDQ = WS_WOUT11 + SZ_WOUT, WS_WUQ = WS_WDQ + 2 * MiB, WS_WO = WS_WUQ + 3 * MiB, WS_WUKV = WS_WO + 8 * MiB;
constexpr size_t WS_WL0 = WS_WUKV + 4 * MiB;
static_assert(WS_WL0 == 353 * MiB, "ws map");
constexpr size_t WS_WIN00 = WS_WL0, WS_WOUT00 = WS_WIN00 + SZ_WIN, WS_WIN01 = WS_WOUT00 + SZ_WOUT, WS_WOUT01 = WS_WIN01 + SZ_WIN;
constexpr size_t WS_WRIN = WS_WOUT01 + SZ_WOUT, WS_WROUT = WS_WRIN + 48 * MiB, WS_WDKV = WS_WROUT + 16 * MiB;
constexpr size_t WS_Q = WS_WL0, WS_O = WS_WL0 + 108 * MiB;
constexpr size_t WS_BIG = WS_WDKV + 3 * MiB;
static_assert(WS_BIG == 552 * MiB && WS_O + (size_t)MT * DM * 2 <= WS_BIG, "ws map");
constexpr size_t WS_PART = WS_BIG + 200 * MiB;
constexpr size_t WS_END = WS_BIG + (size_t)MT * RIN * 2;
static_assert(WS_END == 984 * MiB, "ws map");
constexpr size_t WS_FIXCNT = 32 * 1024;
constexpr size_t WS_SSQH = 8 * MiB, SSQH_STRIDE = (size_t)MT * 32;
static_assert(WS_RS + (size_t)KVROWS * 16 * 4 <= WS_SSQH && WS_SSQH + 6 * SSQH_STRIDE <= WS_KRALL, "ws map");
constexpr int CW_BAR = 4096;

constexpr int RING_OFF = 0, RING_BYTES = 144 * 1024;
constexpr int LDSCTL_OFF = RING_BYTES, MISC_OFF = LDSCTL_OFF + 320;
constexpr int LDS_BYTES = 155648;
constexpr int NWAVES = 8;

#define GAS __attribute__((address_space(1)))
#define LAS __attribute__((address_space(3)))
typedef unsigned short bf16;
typedef unsigned v4u __attribute__((ext_vector_type(4)));
typedef unsigned v2u __attribute__((ext_vector_type(2)));
typedef float f32x4 __attribute__((ext_vector_type(4)));
typedef float f32x16 __attribute__((ext_vector_type(16)));
typedef short bf16x8 __attribute__((ext_vector_type(8)));
typedef short s16x4 __attribute__((ext_vector_type(4)));
typedef GAS unsigned gu32;
#define RLX_AGENT __ATOMIC_RELAXED, __HIP_MEMORY_SCOPE_AGENT
#define LDS_WAIT() asm volatile("s_waitcnt lgkmcnt(0)" ::: "memory")
#define VM_WAIT() asm volatile("s_waitcnt vmcnt(0)" ::: "memory")
typedef float f32x2_t __attribute__((ext_vector_type(2)));
typedef __bf16 bf16x2_t __attribute__((ext_vector_type(2)));
__device__ __forceinline__ unsigned cvtpk(float lo, float hi) { const f32x2_t v = {lo, hi}; const bf16x2_t b = __builtin_convertvector(v, bf16x2_t); return __builtin_bit_cast(unsigned, b); }
__device__ __forceinline__ float bflo(unsigned w) { return __uint_as_float(w << 16); }
__device__ __forceinline__ float bfhi(unsigned w) { return __uint_as_float(w & 0xffff0000u); }
__device__ __forceinline__ int lane_id_asm() { int l; asm volatile("v_mbcnt_lo_u32_b32 %0, -1, 0\n\tv_mbcnt_hi_u32_b32 %0, -1, %0" : "=v"(l)); return l; }
__device__ __forceinline__ float shfl_xor_l(float v, int o, int lane) { return __int_as_float(__builtin_amdgcn_ds_bpermute((lane ^ o) << 2, __float_as_int(v))); }
__device__ __forceinline__ float wave_sum(float v, int lane) {
#pragma unroll
    for (int o = 1; o < 64; o <<= 1) v += shfl_xor_l(v, o, lane);
    return v;
}
__device__ __forceinline__ float silu_f(float a) { return a * __builtin_amdgcn_rcpf(1.0f + __builtin_amdgcn_exp2f(-1.4426950408889634f * a)); }
__device__ __forceinline__ float lg2gamma(int h) {
    return h == 0 ? -0.04580368961312479f : h == 1 ? -0.02272007650008353f : h == 2 ? -0.011315313227834146f : h == 3 ? -0.005646563141142063f :
           h == 4 ? -0.0028205190623786626f : h == 5 ? -0.0014095702546713536f : h == 6 ? -0.0007046129765893727f : -0.0003522634716290214f;
}

#define XB_TMO      128
#define XB_XCNT(j)  (256  + 64 * (j))
#define XB_XSUB(j)  (1280 + 64 * (j))
#define XB_XGEN(j)  (2304 + 64 * (j))
#define XB_TOP      3328
#define XB_TOPGEN   3392
#define XCD_BAR_WORDS 3456
#define XB_SPIN_CAP (1u << 18)

__device__ __forceinline__ unsigned xb_ld(unsigned* p)              { return __hip_atomic_load(p, __ATOMIC_RELAXED, __HIP_MEMORY_SCOPE_AGENT); }
__device__ __forceinline__ unsigned xb_add(unsigned* p, unsigned v) { return __hip_atomic_fetch_add(p, v, __ATOMIC_RELAXED, __HIP_MEMORY_SCOPE_AGENT); }
__device__ __forceinline__ unsigned xb_xcc_id() { return (unsigned)__builtin_amdgcn_s_getreg((3 << 11) | 20) & 0xFu; }
#define XB_SPIN(cond, bar) do { unsigned _sp = 0; while (cond) { __builtin_amdgcn_s_sleep(1); \
    if ((++_sp & 255u) == 0u) { if (xb_ld(&(bar)[XB_TMO])) break; if (_sp > XB_SPIN_CAP) { atomicAdd(&(bar)[XB_TMO], 1u); break; } } } } while (0)

struct XcdBarrier {
    unsigned* bar; unsigned x;
    volatile LAS unsigned* st;
};
__device__ __forceinline__ XcdBarrier xcd_barrier_post(unsigned* bar, volatile LAS unsigned* st) {
    XcdBarrier b; b.bar = bar; b.x = xb_xcc_id(); b.st = st;
    if (threadIdx.x == 0) (void)xb_add(&bar[XB_XCNT(b.x)], 1u);
    return b;
}
__device__ __forceinline__ void xcd_barrier_complete(unsigned* bar, unsigned x, unsigned& nloc, unsigned& nx) {
    const unsigned G = gridDim.x * gridDim.y * gridDim.z;
    unsigned sum, cnt, mine, sp = 0u;
    for (;;) {
        sum = 0u; cnt = 0u; mine = 0u;
#pragma unroll
        for (unsigned j = 0; j < 16; ++j) { const unsigned c = xb_ld(&bar[XB_XCNT(j)]); sum += c; cnt += (c > 0u) ? 1u : 0u; mine = (j == x) ? c : mine; }
        if (sum == G) break;
        __builtin_amdgcn_s_sleep(1);
        if ((++sp & 255u) == 0u) { if (xb_ld(&bar[XB_TMO])) break; if (sp > XB_SPIN_CAP) { atomicAdd(&bar[XB_TMO], 1u); break; } }
    }
    nloc = mine > 0u ? mine : 1u; nx = cnt > 0u ? cnt : 1u;
}
__device__ __forceinline__ void xcd_barrier(const XcdBarrier& b, int wave_id) {
    asm volatile("s_waitcnt vmcnt(0)" ::: "memory");
    __syncthreads();
    if (wave_id == 0 && lane_id_asm() == 0) {
        unsigned* bar = b.bar;
        __builtin_amdgcn_s_waitcnt(0);
        unsigned nloc = b.st[0], nx = b.st[1];
        if (nloc == 0u) { xcd_barrier_complete(bar, b.x, nloc, nx); b.st[0] = nloc; b.st[1] = nx; }
        const unsigned old = xb_add(&bar[XB_XSUB(b.x)], 1u);
        const unsigned gen = old / nloc;
        if (old + 1u == (gen + 1u) * nloc) {
            __builtin_amdgcn_fence(__ATOMIC_RELEASE, "agent");
            asm volatile("s_waitcnt vmcnt(0)" ::: "memory");
            const unsigned og = xb_add(&bar[XB_TOP], 1u);
            const unsigned tg = og / nx;
            if (og + 1u == (tg + 1u) * nx) xb_add(&bar[XB_TOPGEN], 1u);
            else XB_SPIN(xb_ld(&bar[XB_TOPGEN]) == tg, bar);
            __builtin_amdgcn_fence(__ATOMIC_ACQUIRE, "agent");
            xb_add(&bar[XB_XGEN(b.x)], 1u);
            asm volatile("s_waitcnt vmcnt(0)" ::: "memory");
        } else {
            XB_SPIN(xb_ld(&bar[XB_XGEN(b.x)]) == gen, bar);
            __builtin_amdgcn_fence(__ATOMIC_ACQUIRE, "agent");
            asm volatile("s_waitcnt vmcnt(0)" ::: "memory");
        }
    }
    __syncthreads();
}

using pg8::Unit; using pg8::HALF; using pg8::BM;
constexpr int RSBUF_OFF = 128 * 1024;
__device__ __forceinline__ float rs_of8(const f32x4 a, const f32x4 b) { return 1.0f / sqrtf((((a[0] + a[1]) + (a[2] + a[3])) + ((b[0] + b[1]) + (b[2] + b[3]))) * (1.0f / (float)DM) + EPS); }
__device__ __forceinline__ void ssq_row_store(float* p, float tot) { float z = 0.f; asm volatile("" : "+v"(z)); *(GAS f32x4*)p = (f32x4){tot, z, z, z}; *(GAS f32x4*)(p + 4) = (f32x4){z, z, z, z}; }
__device__ __forceinline__ void rs_prefetch(LAS unsigned char* ring, const float* ssq, const Unit& u, int tid) {
    const int wid = __builtin_amdgcn_readfirstlane(tid >> 6);
    __builtin_amdgcn_global_load_lds((const unsigned*)(ssq + (size_t)u.pm * (BM * 8) + tid * 4), (LAS unsigned*)(ring + RSBUF_OFF + u.par * 8192 + wid * 1024), 16, 0, 0);
}
__device__ __forceinline__ void rs_load8(LAS unsigned char* ring, const Unit& u, int wr, int fr, float (&rs)[2][4]) {
#pragma unroll
    for (int ai = 0; ai < 2; ++ai)
#pragma unroll
        for (int m = 0; m < 4; ++m) { const LAS f32x4* p = (const LAS f32x4*)(ring + RSBUF_OFF + u.par * 8192 + (wr * 64 + fr + ai * HALF + m * 16) * 32); rs[ai][m] = rs_of8(p[0], p[1]); }
}
struct EpiSwiGLU {
    static constexpr bool PRE = (MK_NFOLD != 0); static constexpr bool PERM = true;
    bf16* O; int ldc; const float* ssq; LAS unsigned char* ring;
    __device__ __forceinline__ void prefetch(LAS unsigned char* lds, const Unit& u, int tid) const { if (ssq) rs_prefetch(lds, ssq, u, tid); }
    __device__ __forceinline__ void operator()(const f32x4 (&acc)[2][2][4][2], const Unit& u, int wr, int wc, int fr, int fq) const {
        const int row0 = u.pm * BM + wr * 64 + fr, col0 = u.pn * HALF + wc * 32 + 8 * fq;
        float rs[2][4];
        if (ssq) rs_load8(ring, u, wr, fr, rs); else {
#pragma unroll
            for (int i = 0; i < 8; ++i) rs[i >> 2][i & 3] = 1.0f; }
#pragma unroll
        for (int ai = 0; ai < 2; ++ai) { if (u.half && ai != u.half - 1) continue;
#pragma unroll
            for (int m = 0; m < 4; ++m) {
                const int row = row0 + ai * HALF + m * 16;
                bf16* rowp = MK_BLK ? O + ((size_t)(row >> 8) * (DFF / 64) + (col0 >> 6)) * (256 * 64) + (row & 255) * 64 + (col0 & 63) : O + (size_t)row * ldc + col0;
                const f32x4 a0 = acc[ai][0][m][0] * rs[ai][m], a1 = acc[ai][0][m][1] * rs[ai][m], b0 = acc[ai][1][m][0] * rs[ai][m], b1 = acc[ai][1][m][1] * rs[ai][m];
                v4u w;
                w.x = cvtpk(silu_f(a0[0]) * b0[0], silu_f(a0[1]) * b0[1]); w.y = cvtpk(silu_f(a0[2]) * b0[2], silu_f(a0[3]) * b0[3]);
                w.z = cvtpk(silu_f(a1[0]) * b1[0], silu_f(a1[1]) * b1[1]); w.w = cvtpk(silu_f(a1[2]) * b1[2], silu_f(a1[3]) * b1[3]);
                *(GAS v4u*)rowp = w; } }
    }
};
struct EpiResid {
    static constexpr bool PRE = false; static constexpr bool PERM = false;
    float* H; int ldc; float scale; float* P; int pstride; const float* Hin; const float* Hin2;
    __device__ __forceinline__ void operator()(const f32x4 (&acc)[2][2][4][2], const Unit& u, int wr, int wc, int fr, int fq) const {
        const int row0 = u.pm * BM + wr * 64 + fr, col0 = u.pn * BM + wc * 32 + 4 * fq;
        if (u.part) {
#pragma unroll
            for (int ai = 0; ai < 2; ++ai)
#pragma unroll
                for (int m = 0; m < 4; ++m) { float* rowp = P + (size_t)((u.part - 1) * MS + (row0 + ai * HALF + m * 16 - MP)) * pstride + col0;
#pragma unroll
                    for (int bj = 0; bj < 2; ++bj)
#pragma unroll
                        for (int n = 0; n < 2; ++n) *(GAS f32x4*)(rowp + bj * HALF + n * 16) = scale * acc[ai][bj][m][n]; }
            return;
        }
#pragma unroll
        for (int ai = 0; ai < 2; ++ai) {
            f32x4 h[4][2][2];
#pragma unroll
            for (int m = 0; m < 4; ++m) { const int row = row0 + ai * HALF + m * 16; const float* rowp = (row < MP ? Hin + (size_t)row * ldc : Hin2 + (size_t)(row - MP) * ldc) + col0;
#pragma unroll
                for (int bj = 0; bj < 2; ++bj)
#pragma unroll
                    for (int n = 0; n < 2; ++n) h[m][bj][n] = *(const GAS f32x4*)(rowp + bj * HALF + n * 16); }
#pragma unroll
            for (int m = 0; m < 4; ++m) { float* rowp = H + (size_t)(row0 + ai * HALF + m * 16) * ldc + col0;
#pragma unroll
                for (int bj = 0; bj < 2; ++bj)
#pragma unroll
                    for (int n = 0; n < 2; ++n) *(GAS f32x4*)(rowp + bj * HALF + n * 16) = h[m][bj][n] + scale * acc[ai][bj][m][n]; }
            asm volatile("" ::: "memory"); }
    }
};
struct EpiResid2 {
    static constexpr bool PRE = false; static constexpr bool PERM = false;
    float* H; int ldc; float scale; float* P; int pstride; const float* Hin; const float* Hin2;
    bf16* HB; float* ssq; unsigned* cnt; LAS float* part;
    __device__ __forceinline__ void operator()(const f32x4 (&acc_)[2][2][4][2], const Unit& u, int wr, int wc, int fr_, int fq_) const {
        f32x4 (&acc)[2][2][4][2] = const_cast<f32x4 (&)[2][2][4][2]>(acc_);
        int fr = fr_, fq = fq_; asm volatile("" : "+v"(fr), "+v"(fq));
        const int row0 = u.pm * BM + wr * 64 + fr, col0 = u.pn * BM + wc * 32 + 4 * fq;
        const bool lead = (wr == 0 && wc == 0 && (fq * 16 + fr) == 0);
        if (u.part) {
#pragma unroll
            for (int ai = 0; ai < 2; ++ai)
#pragma unroll
                for (int m = 0; m < 4; ++m) { float* rowp = P + ((size_t)(u.part - 1) * MS + (row0 + ai * HALF + m * 16 - MP)) * pstride + col0;
#pragma unroll
                    for (int bj = 0; bj < 2; ++bj)
#pragma unroll
                        for (int n = 0; n < 2; ++n) *(GAS f32x4*)(rowp + bj * HALF + n * 16) = scale * acc[ai][bj][m][n]; }
            return;
        }
#pragma unroll
        for (int ai = 0; ai < 2; ++ai) {
            f32x4 h[4][2][2];
#pragma unroll
            for (int m = 0; m < 4; ++m) { const int row = row0 + ai * HALF + m * 16; const float* rowp = (row < MP ? Hin + (size_t)row * ldc : Hin2 + (size_t)(row - MP) * ldc) + col0;
#pragma unroll
                for (int bj = 0; bj < 2; ++bj)
#pragma unroll
                    for (int n = 0; n < 2; ++n) h[m][bj][n] = *(const GAS f32x4*)(rowp + bj * HALF + n * 16); }
#pragma unroll
            for (int m = 0; m < 4; ++m) { const int row = row0 + ai * HALF + m * 16; float* rowp = H + (size_t)row * ldc + col0; float s = 0.f;
#pragma unroll
                for (int bj = 0; bj < 2; ++bj) { const f32x4 v0 = h[m][bj][0] + scale * acc[ai][bj][m][0], v1 = h[m][bj][1] + scale * acc[ai][bj][m][1];
                    *(GAS f32x4*)(rowp + bj * HALF) = v0; *(GAS f32x4*)(rowp + bj * HALF + 16) = v1;
                    if (HB) { bf16* hb = HB + (size_t)row * ldc + col0 + bj * HALF; v2u w; w.x = cvtpk(v0[0], v0[1]); w.y = cvtpk(v0[2], v0[3]); *(GAS v2u*)hb = w; w.x = cvtpk(v1[0], v1[1]); w.y = cvtpk(v1[2], v1[3]); *(GAS v2u*)(hb + 16) = w; }
                    s += (v0[0] * v0[0] + v0[1] * v0[1]) + (v0[2] * v0[2] + v0[3] * v0[3]) + (v1[0] * v1[0] + v1[1] * v1[1]) + (v1[2] * v1[2] + v1[3] * v1[3]); }
                if (ssq) { const int ln_ = fq * 16 + fr; s += shfl_xor_l(s, 16, ln_); s += shfl_xor_l(s, 32, ln_);
                    if (fq == 0) part[(ai * HALF + wr * 64 + m * 16 + fr) * 4 + wc] = s; } }
            asm volatile("" ::: "memory"); }
        if (ssq) {
            asm volatile("s_waitcnt lgkmcnt(0)" ::: "memory"); __builtin_amdgcn_s_barrier(); asm volatile("" ::: "memory");
            const int t = (wr * 4 + wc) * 64 + fq * 16 + fr;
            if (t < 256) { const f32x4 p = *(const LAS f32x4*)(part + t * 4);
                ((GAS float*)ssq)[((size_t)u.pm * BM + t) * 8 + u.pn] = (p[0] + p[1]) + (p[2] + p[3]); }
        }
    }
};
struct EpiResid3 {
    static constexpr bool PRE = false; static constexpr bool PERM = true;
    float* Y; int ldc; float scale; float* P; int pstride; const float* Xin; const float* Xin2;
    bf16* HB; float* ssq; LAS float* part;
    __device__ __forceinline__ void operator()(const f32x4 (&acc)[2][2][4][2], const Unit& u, int wr, int wc, int fr_, int fq_) const {
        int fr = fr_, fq = fq_; asm volatile("" : "+v"(fr), "+v"(fq));
        constexpr bool TQE = (MK_TQ != 0);
        const int rbase = u.pm * (TQE ? 192 : BM), row0 = rbase + wr * 64 + fr, col0 = u.pn * BM + wc * 32 + 8 * fq;
#define ER3_MM(ai) (MK_TQ == 2 ? 3 : (TQE && (ai)) ? 2 : 4)
#define ER3_RT(ai, m) (MK_TQ == 2 ? (ai) * 96 + wr * 48 + (m) * 16 + fr : (ai) == 0 ? wr * 64 + (m) * 16 + fr : HALF + (TQE ? wr * 32 : wr * 64) + (m) * 16 + fr)
        if (u.part) {
#pragma unroll
            for (int ai = 0; ai < 2; ++ai)
#pragma unroll
                for (int m = 0; m < 4; ++m) { float* rowp = P + ((size_t)(u.part - 1) * MS + (row0 + ai * HALF + m * 16 - MP)) * pstride + col0;
#pragma unroll
                    for (int bj = 0; bj < 2; ++bj)
#pragma unroll
                        for (int n = 0; n < 2; ++n) *(GAS f32x4*)(rowp + bj * HALF + n * 4) = scale * acc[ai][bj][m][n]; }
            return;
        }
#pragma unroll
        for (int ai = 0; ai < 2; ++ai) {
            f32x4 r[4][2][2];
            if (Xin) {
#pragma unroll
                for (int m = 0; m < ER3_MM(ai); ++m) { const int row = rbase + ER3_RT(ai, m); const float* rowp = (row < MP ? Xin + (size_t)row * ldc : Xin2 + (size_t)(row - MP) * ldc) + col0;
#pragma unroll
                    for (int bj = 0; bj < 2; ++bj)
#pragma unroll
                        for (int n = 0; n < 2; ++n) r[m][bj][n] = *(const GAS f32x4*)(rowp + bj * HALF + n * 4); }
            } else { v4u hb[4][2];
#pragma unroll
                for (int m = 0; m < ER3_MM(ai); ++m)
#pragma unroll
                    for (int bj = 0; bj < 2; ++bj) hb[m][bj] = *(const GAS v4u*)(HB + (size_t)(rbase + ER3_RT(ai, m)) * ldc + col0 + bj * HALF);
#pragma unroll
                for (int m = 0; m < ER3_MM(ai); ++m)
#pragma unroll
                    for (int bj = 0; bj < 2; ++bj) { r[m][bj][0] = (f32x4){bflo(hb[m][bj].x), bfhi(hb[m][bj].x), bflo(hb[m][bj].y), bfhi(hb[m][bj].y)}; r[m][bj][1] = (f32x4){bflo(hb[m][bj].z), bfhi(hb[m][bj].z), bflo(hb[m][bj].w), bfhi(hb[m][bj].w)}; }
            }
#pragma unroll
            for (int m = 0; m < ER3_MM(ai); ++m) { const int row = rbase + ER3_RT(ai, m); float s = 0.f;
#pragma unroll
                for (int bj = 0; bj < 2; ++bj) { const f32x4 v0 = r[m][bj][0] + scale * acc[ai][bj][m][0], v1 = r[m][bj][1] + scale * acc[ai][bj][m][1];
                    if (Y) { float* yp = Y + (size_t)row * ldc + col0 + bj * HALF; *(GAS f32x4*)yp = v0; *(GAS f32x4*)(yp + 4) = v1; }
                    else { v4u w; w.x = cvtpk(v0[0], v0[1]); w.y = cvtpk(v0[2], v0[3]); w.z = cvtpk(v1[0], v1[1]); w.w = cvtpk(v1[2], v1[3]);
                        *(GAS v4u*)(HB + (size_t)row * ldc + col0 + bj * HALF) = w; }
                    s += (v0[0] * v0[0] + v0[1] * v0[1]) + (v0[2] * v0[2] + v0[3] * v0[3]) + (v1[0] * v1[0] + v1[1] * v1[1]) + (v1[2] * v1[2] + v1[3] * v1[3]); }
                if (ssq) { const int ln_ = fq * 16 + fr; s += shfl_xor_l(s, 16, ln_); s += shfl_xor_l(s, 32, ln_);
                    if (fq == 0) part[ER3_RT(ai, m) * 4 + wc] = s; } }
            asm volatile("" ::: "memory"); }
        if (ssq) {
            asm volatile("s_waitcnt lgkmcnt(0)" ::: "memory"); __builtin_amdgcn_s_barrier(); asm volatile("" ::: "memory");
            const int t = (wr * 4 + wc) * 64 + fq * 16 + fr;
            if (t < (TQE ? 192 : 256)) { const f32x4 p = *(const LAS f32x4*)(part + t * 4);
                ((GAS float*)ssq)[((size_t)rbase + t) * 8 + u.pn] = (p[0] + p[1]) + (p[2] + p[3]); }
        }
#undef ER3_MM
#undef ER3_RT
    }
};
struct EpiF32 {
    static constexpr bool PRE = false; static constexpr bool PERM = false;
    float* C; int ldc;
    __device__ __forceinline__ void operator()(const f32x4 (&acc)[2][2][4][2], const Unit& u, int wr, int wc, int fr, int fq) const {
        const int row0 = u.pm * BM + wr * 64 + fr, col0 = u.pn * BM + wc * 32 + 4 * fq;
#pragma unroll
        for (int ai = 0; ai < 2; ++ai)
#pragma unroll
            for (int m = 0; m < 4; ++m) { float* rowp = C + (size_t)(row0 + ai * HALF + m * 16) * ldc + col0;
#pragma unroll
                for (int bj = 0; bj < 2; ++bj)
#pragma unroll
                    for (int n = 0; n < 2; ++n) *(GAS f32x4*)(rowp + bj * HALF + n * 16) = acc[ai][bj][m][n]; }
    }
};
struct EpiBf16 {
    static constexpr bool PRE = false; static constexpr bool PERM = true;
    bf16* O; int ldc;
    __device__ __forceinline__ void operator()(const f32x4 (&acc)[2][2][4][2], const Unit& u, int wr, int wc, int fr, int fq) const {
        const int row0 = u.pm * BM + wr * 64 + fr, col0 = u.pn * BM + wc * 32 + 8 * fq;
#pragma unroll
        for (int ai = 0; ai < 2; ++ai)
#pragma unroll
            for (int m = 0; m < 4; ++m) { bf16* rowp = O + (size_t)(row0 + ai * HALF + m * 16) * ldc + col0;
#pragma unroll
                for (int bj = 0; bj < 2; ++bj) { const f32x4 v0 = acc[ai][bj][m][0], v1 = acc[ai][bj][m][1];
                    v4u w; w.x = cvtpk(v0[0], v0[1]); w.y = cvtpk(v0[2], v0[3]); w.z = cvtpk(v1[0], v1[1]); w.w = cvtpk(v1[2], v1[3]);
                    *(GAS v4u*)(rowp + bj * HALF) = w; } }
    }
};
struct EpiQlat {
    static constexpr bool PRE = (MK_NFOLD != 0); static constexpr bool PERM = true;
    bf16* O; int ldc; float* ssq; LAS float* part;
    const float* hssq; LAS unsigned char* ring;
    __device__ __forceinline__ void prefetch(LAS unsigned char* lds, const Unit& u, int tid) const { if (hssq) rs_prefetch(lds, hssq, u, tid); }
    __device__ __forceinline__ void operator()(const f32x4 (&acc)[2][2][4][2], const Unit& u, int wr, int wc, int fr, int fq) const {
        const int row0 = u.pm * BM + wr * 64 + fr, col0 = u.pn * BM + wc * 32 + 8 * fq;
        float rs[2][4];
        if (hssq) rs_load8(ring, u, wr, fr, rs); else {
#pragma unroll
            for (int i = 0; i < 8; ++i) rs[i >> 2][i & 3] = 1.0f; }
#pragma unroll
        for (int ai = 0; ai < 2; ++ai)
#pragma unroll
            for (int m = 0; m < 4; ++m) { const int row = row0 + ai * HALF + m * 16; bf16* rowp = O + (size_t)row * ldc + col0; float s = 0.f;
#pragma unroll
                for (int bj = 0; bj < 2; ++bj) { const f32x4 v0 = acc[ai][bj][m][0] * rs[ai][m], v1 = acc[ai][bj][m][1] * rs[ai][m];
                    v4u w; w.x = cvtpk(v0[0], v0[1]); w.y = cvtpk(v0[2], v0[3]); w.z = cvtpk(v1[0], v1[1]); w.w = cvtpk(v1[2], v1[3]);
                    *(GAS v4u*)(rowp + bj * HALF) = w;
                    s += (v0[0] * v0[0] + v0[1] * v0[1]) + (v0[2] * v0[2] + v0[3] * v0[3]) + (v1[0] * v1[0] + v1[1] * v1[1]) + (v1[2] * v1[2] + v1[3] * v1[3]); }
                { const int ln_ = fq * 16 + fr; s += shfl_xor_l(s, 16, ln_); s += shfl_xor_l(s, 32, ln_); }
                if (fq == 0) part[(ai * HALF + wr * 64 + m * 16 + fr) * 4 + wc] = s; }
        asm volatile("s_waitcnt lgkmcnt(0)" ::: "memory"); __builtin_amdgcn_s_barrier(); asm volatile("" ::: "memory");
        const int t = (wr * 4 + wc) * 64 + fq * 16 + fr;
        if (t < 256) { const f32x4 p = *(const LAS f32x4*)(part + t * 4); ssq[(size_t)(u.pm * BM + t) * 2 + u.pn] = (p[0] + p[1]) + (p[2] + p[3]); }
    }
};
struct EpiQraw {
    static constexpr bool PRE = false; static constexpr bool PERM = true;
    bf16* O; int ldc; const float* ssq;
    __device__ __forceinline__ void operator()(const f32x4 (&acc)[2][2][4][2], const Unit& u, int wr, int wc, int fr, int fq) const {
        const int row0 = u.pm * BM + wr * 64 + fr, col0 = u.pn * BM + wc * 32 + 8 * fq;
#pragma unroll
        for (int ai = 0; ai < 2; ++ai) { float rs[4];
#pragma unroll
            for (int m = 0; m < 4; ++m) { const int row = row0 + ai * HALF + m * 16; const GAS float* sp = (const GAS float*)ssq + (size_t)row * 2; rs[m] = 1.0f / sqrtf((sp[0] + sp[1]) * (1.0f / QLR) + EPS); }
#pragma unroll
            for (int m = 0; m < 4; ++m) { bf16* rowp = O + (size_t)(row0 + ai * HALF + m * 16) * ldc + col0;
#pragma unroll
                for (int bj = 0; bj < 2; ++bj) { const f32x4 v0 = acc[ai][bj][m][0] * rs[m], v1 = acc[ai][bj][m][1] * rs[m];
                    v4u w; w.x = cvtpk(v0[0], v0[1]); w.y = cvtpk(v0[2], v0[3]); w.z = cvtpk(v1[0], v1[1]); w.w = cvtpk(v1[2], v1[3]);
                    *(GAS v4u*)(rowp + bj * HALF) = w; } } }
    }
};
struct EpiKV {
    static constexpr bool PRE = false; static constexpr bool PERM = true;
    bf16* O; int ldc; float* rs; const float* ssqkr; LAS float* part;
    __device__ __forceinline__ void operator()(const f32x4 (&acc)[2][2][4][2], const Unit& u, int wr, int wc, int fr, int fq) const {
        const int row0 = u.pm * BM + wr * 64 + fr, col0 = u.pn * BM + wc * 32 + 8 * fq;
#pragma unroll
        for (int ai = 0; ai < 2; ++ai)
#pragma unroll
            for (int m = 0; m < 4; ++m) { const int row = row0 + ai * HALF + m * 16; bf16* rowp = O + (size_t)row * ldc + col0;
#pragma unroll
                for (int bj = 0; bj < 2; ++bj) { const f32x4 v0 = acc[ai][bj][m][0], v1 = acc[ai][bj][m][1];
                    v4u w; w.x = cvtpk(v0[0], v0[1]); w.y = cvtpk(v0[2], v0[3]); w.z = cvtpk(v1[0], v1[1]); w.w = cvtpk(v1[2], v1[3]);
                    *(GAS v4u*)(rowp + bj * HALF) = w; }
                const f32x4 k0 = acc[ai][0][m][0], k1 = acc[ai][0][m][1];
                float s = (k0[0] * k0[0] + k0[1] * k0[1]) + (k0[2] * k0[2] + k0[3] * k0[3]) + (k1[0] * k1[0] + k1[1] * k1[1]) + (k1[2] * k1[2] + k1[3] * k1[3]);
                { const int ln_ = fq * 16 + fr; s += shfl_xor_l(s, 16, ln_); s += shfl_xor_l(s, 32, ln_); }
                if (fq == 0) part[(ai * HALF + wr * 64 + m * 16 + fr) * 4 + wc] = s; }
        asm volatile("s_waitcnt lgkmcnt(0)" ::: "memory"); __builtin_amdgcn_s_barrier(); asm volatile("" ::: "memory");
        const int t = (wr * 4 + wc) * 64 + fq * 16 + fr;
        if (t < 256) { const f32x4 p = *(const LAS f32x4*)(part + t * 4); const int row = u.pm * BM + t;
            rs[(size_t)row * 16 + u.pn] = 1.0f / sqrtf(((p[0] + p[1]) + (p[2] + p[3]) + ((const GAS float*)ssqkr)[row]) * (1.0f / QKH) + EPS); }
    }
};
struct EpiRet {
    static constexpr bool PRE = (MK_NFOLD != 0); static constexpr bool PERM = true;
    bf16* O; int ldc; const float* cosT; const float* sinT;
    const float* ssq; LAS unsigned char* ring;
    __device__ __forceinline__ void prefetch(LAS unsigned char* lds, const Unit& u, int tid) const { if (ssq) rs_prefetch(lds, ssq, u, tid); }
    __device__ __forceinline__ void operator()(const f32x4 (&acc)[2][2][4][2], const Unit& u, int wr, int wc, int fr_, int fq_) const {
        int fr = fr_, fq = fq_; asm volatile("" : "+v"(fr), "+v"(fq));
        const int row0 = u.pm * BM + wr * 64 + fr, col0 = u.pn * BM + wc * 32 + 8 * fq, j0 = wc * 32 + 8 * fq;
        float rs[2][4];
        if (ssq) rs_load8(ring, u, wr, fr, rs); else {
#pragma unroll
            for (int i = 0; i < 8; ++i) rs[i >> 2][i & 3] = 1.0f; }
        if (u.pn < 16) {
            const int h = u.pn & 7; const bool isq = u.pn < 8; const float lg = lg2gamma(h);
#pragma unroll
            for (int ai = 0; ai < 2; ++ai) { if (u.half && ai != u.half - 1) continue;
                f32x4 c0[4], c1[4], s0[4], s1[4];
#pragma unroll
                for (int m = 0; m < 4; ++m) { const int row = row0 + ai * HALF + m * 16; const int pos = row < MP ? (row & (SEQ - 1)) : PAST + (row & (DSEQ - 1));
                    c0[m] = *(const GAS f32x4*)(cosT + pos * 128 + j0); c1[m] = *(const GAS f32x4*)(cosT + pos * 128 + j0 + 4);
                    s0[m] = *(const GAS f32x4*)(sinT + pos * 128 + j0); s1[m] = *(const GAS f32x4*)(sinT + pos * 128 + j0 + 4); }
#pragma unroll
                for (int m = 0; m < 4; ++m) { const int row = row0 + ai * HALF + m * 16; bf16* rowp = O + (size_t)row * ldc + col0;
                    const float e = (float)((row & 63) + 1) * lg;
                    const float fac = (isq ? __builtin_amdgcn_exp2f(e) * 0.0625f : __builtin_amdgcn_exp2f(-e)) * rs[ai][m];
                    const f32x4 x10 = acc[ai][0][m][0], x11 = acc[ai][0][m][1], x20 = acc[ai][1][m][0], x21 = acc[ai][1][m][1];
                    const f32x4 a0 = (x10 * c0[m] - x20 * s0[m]) * fac, a1 = (x11 * c1[m] - x21 * s1[m]) * fac, b0 = (x10 * s0[m] + x20 * c0[m]) * fac, b1 = (x11 * s1[m] + x21 * c1[m]) * fac;
                    v4u w; w.x = cvtpk(a0[0], a0[1]); w.y = cvtpk(a0[2], a0[3]); w.z = cvtpk(a1[0], a1[1]); w.w = cvtpk(a1[2], a1[3]);
                    *(GAS v4u*)rowp = w;
                    w.x = cvtpk(b0[0], b0[1]); w.y = cvtpk(b0[2], b0[3]); w.z = cvtpk(b1[0], b1[1]); w.w = cvtpk(b1[2], b1[3]);
                    *(GAS v4u*)(rowp + HALF) = w; }
                asm volatile("" ::: "memory"); }
        } else {
            const bool isg = u.pn >= 32;
#pragma unroll
            for (int ai = 0; ai < 2; ++ai) { if (u.half && ai != u.half - 1) continue;
#pragma unroll
                for (int m = 0; m < 4; ++m) { bf16* rowp = O + (size_t)(row0 + ai * HALF + m * 16) * ldc + col0;
#pragma unroll
                    for (int bj = 0; bj < 2; ++bj) { f32x4 v0 = acc[ai][bj][m][0] * rs[ai][m], v1 = acc[ai][bj][m][1] * rs[ai][m];
                        if (isg) {
#pragma unroll
                            for (int i = 0; i < 4; ++i) { v0[i] = silu_f(v0[i]); v1[i] = silu_f(v1[i]); } }
                        v4u w; w.x = cvtpk(v0[0], v0[1]); w.y = cvtpk(v0[2], v0[3]); w.z = cvtpk(v1[0], v1[1]); w.w = cvtpk(v1[2], v1[3]);
                        *(GAS v4u*)(rowp + bj * HALF) = w; } } }
        }
    }
};
struct Args { const float* in[25]; float* out; unsigned char* ws; int ph_lo, ph_hi, dry, pad; };
enum { I_XP = 0, I_XS, I_STATE, I_CCKV, I_CKR, I_F1N, I_F1IN, I_F1OUT, I_MIXN, I_F2N, I_F2IN, I_F2OUT, I_RIN, I_RGN, I_ROUT, I_KVN, I_WDKV, I_KVLN, I_WUKV, I_KN,
       I_WDQ, I_QLN, I_WUQ, I_QN, I_WO };
struct Frame { LAS unsigned char* lds; int tid, lane, wave, vcu, G; };

__device__ __forceinline__ int dst_row_map(int mode, int n) {
    if (mode == 1) { const int hf = n >= DFF ? 1 : 0; const int nn = n - hf * DFF; return (nn >> 7) * 256 + hf * 128 + (nn & 127); }
    return n;
}
template <int UNR = MK_CONVUNROLL>
__device__ __forceinline__ void conv_item(const float* W, int K, int N, bf16* WT, int mode, LAS float* scr, int item, int lane, int blocked = 0, const float* kgain = nullptr) {
    const int nblk = N >> 6, kb = item / nblk, nb = item - kb * nblk, k0 = 64 * kb, n0 = 64 * nb;
    const GAS float* src = (const GAS float*)W + (size_t)k0 * N + n0 + lane;
    f32x4 kg0 = {1.f, 1.f, 1.f, 1.f}, kg1 = kg0;
    if (kgain) { const GAS f32x4* gp = (const GAS f32x4*)(kgain + k0 + 8 * (lane & 7)); kg0 = gp[0]; kg1 = gp[1]; }
    if constexpr (UNR >= 64) { float t_[64];
#pragma unroll
        for (int i = 0; i < 64; ++i) t_[i] = src[(size_t)i * N];
#pragma unroll
        for (int i = 0; i < 64; ++i) scr[i * 65 + lane] = t_[i]; }
    else {
#pragma unroll UNR
        for (int i = 0; i < 64; ++i) scr[i * 65 + lane] = src[(size_t)i * N]; }
    LDS_WAIT(); asm volatile("" ::: "memory");
#if MK_WARMMFMA
    { f32x4 d_ = {0.f, 0.f, 0.f, 0.f}; bf16x8 z_ = {1, 2, 3, 4, 5, 6, 7, 8};
#pragma unroll
      for (int i = 0; i < MK_WARMMFMA; ++i) d_ = __builtin_amdgcn_mfma_f32_16x16x32_bf16(z_, z_, d_, 0, 0, 0);
      asm volatile("" :: "v"(d_)); }
#endif
    const int c = lane & 7;
#pragma unroll
    for (int j = 0; j < 8; ++j) { const int n = (lane >> 3) + 8 * j; const LAS float* s = scr + (8 * c) * 65 + n;
        v4u o; o.x = cvtpk(s[0 * 65] * kg0.x, s[1 * 65] * kg0.y); o.y = cvtpk(s[2 * 65] * kg0.z, s[3 * 65] * kg0.w); o.z = cvtpk(s[4 * 65] * kg1.x, s[5 * 65] * kg1.y); o.w = cvtpk(s[6 * 65] * kg1.z, s[7 * 65] * kg1.w);
        const int dr = dst_row_map(mode, n0 + n);
        *(GAS v4u*)(blocked ? WT + ((size_t)(dr >> 8) * (K >> 6) + kb) * (256 * 64) + (dr & 255) * 64 + 8 * c : WT + (size_t)dr * K + k0 + 8 * c) = o; }
    LDS_WAIT(); asm volatile("" ::: "memory");
}
__device__ __forceinline__ void sincos_d(double a, float& s, float& c) {
    const double q = __builtin_rint(a * 0.63661977236758134308);
    double r = __builtin_fma(-q, 1.57079632679489655800e+00, a); r = __builtin_fma(-q, 6.12323399573676603587e-17, r);
    const double r2 = r * r;
    const double sp = r * (1.0 + r2 * (-1.0 / 6 + r2 * (1.0 / 120 + r2 * (-1.0 / 5040 + r2 * (1.0 / 362880 + r2 * (-1.0 / 39916800 + r2 * (1.0 / 6227020800.0)))))));
    const double cp = 1.0 + r2 * (-0.5 + r2 * (1.0 / 24 + r2 * (-1.0 / 720 + r2 * (1.0 / 40320 + r2 * (-1.0 / 3628800 + r2 * (1.0 / 479001600.0))))));
    const int qi = (int)q & 3;
    s = (float)(qi == 0 ? sp : qi == 1 ? cp : qi == 2 ? -sp : -cp);
    c = (float)(qi == 0 ? cp : qi == 1 ? -sp : qi == 2 ? -cp : sp);
}
__device__ __forceinline__ double powi_d(double r, int j) { double o = 1.0, b = r; for (int k = 0; k < 8; ++k) { if (j & (1 << k)) o *= b; b *= b; } return o; }

__device__ __forceinline__ void rms_row_2048(const float* xrow, const float* g, bf16* orow, float* hrow, int lane, const float* prow = nullptr, size_t pq = 0, float* ssqp = nullptr) {
    const GAS f32x4* xr = (const GAS f32x4*)xrow + lane;
    f32x4 v[8]; float s = 0.f;
#pragma unroll
    for (int j = 0; j < 8; ++j) v[j] = xr[64 * j];
    if (prow) {
#pragma unroll
        for (int q = 0; q < 4; ++q) { const GAS f32x4* pr = (const GAS f32x4*)(prow + q * pq) + lane;
#pragma unroll
            for (int j = 0; j < 8; ++j) v[j] += pr[64 * j]; }
    }
#pragma unroll
    for (int j = 0; j < 8; ++j) s += (v[j].x * v[j].x + v[j].y * v[j].y) + (v[j].z * v[j].z + v[j].w * v[j].w);
    if (ssqp) { const float tot = wave_sum(s, lane); GAS v2u* o8 = (GAS v2u*)orow + lane;
#pragma unroll
        for (int j = 0; j < 8; ++j) { v2u w; w.x = cvtpk(v[j].x, v[j].y); w.y = cvtpk(v[j].z, v[j].w); o8[64 * j] = w; }
        if (lane == 0) ssq_row_store(ssqp, tot); }
    else if (g) { const GAS f32x4* gr = (const GAS f32x4*)g + lane;
        const float rs = 1.0f / sqrtf(wave_sum(s, lane) * (1.0f / DM) + EPS);
        GAS v2u* o8 = (GAS v2u*)orow + lane;
#pragma unroll
        for (int j = 0; j < 8; ++j) { const f32x4 gg = gr[64 * j]; v2u w; w.x = cvtpk(v[j].x * rs * gg.x, v[j].y * rs * gg.y); w.y = cvtpk(v[j].z * rs * gg.z, v[j].w * rs * gg.w); o8[64 * j] = w; } }
    if (hrow) { GAS f32x4* hr = (GAS f32x4*)hrow + lane;
#pragma unroll
        for (int j = 0; j < 8; ++j) hr[64 * j] = v[j]; }
}
__device__ __forceinline__ void rms_row2_2048(const float* xa, const float* xb, const float* g, bf16* oa, bf16* ob, int lane, float* qa = nullptr, float* qb = nullptr) {
    const GAS f32x4* ra = (const GAS f32x4*)xa + lane; const GAS f32x4* rb = (const GAS f32x4*)xb + lane; const GAS f32x4* gr = (const GAS f32x4*)g + lane;
    f32x4 va[8], vb[8]; float sa = 0.f, sb = 0.f;
#pragma unroll
    for (int j = 0; j < 8; ++j) va[j] = ra[64 * j];
#pragma unroll
    for (int j = 0; j < 8; ++j) vb[j] = rb[64 * j];
#pragma unroll
    for (int j = 0; j < 8; ++j) { sa += (va[j].x * va[j].x + va[j].y * va[j].y) + (va[j].z * va[j].z + va[j].w * va[j].w); sb += (vb[j].x * vb[j].x + vb[j].y * vb[j].y) + (vb[j].z * vb[j].z + vb[j].w * vb[j].w); }
    GAS v2u* pa = (GAS v2u*)oa + lane; GAS v2u* pb = (GAS v2u*)ob + lane;
    if (qa) { const float ta = wave_sum(sa, lane), tb = wave_sum(sb, lane);
#pragma unroll
        for (int j = 0; j < 8; ++j) { v2u w; w.x = cvtpk(va[j].x, va[j].y); w.y = cvtpk(va[j].z, va[j].w); pa[64 * j] = w; w.x = cvtpk(vb[j].x, vb[j].y); w.y = cvtpk(vb[j].z, vb[j].w); pb[64 * j] = w; }
        if (lane == 0) { ssq_row_store(qa, ta); ssq_row_store(qb, tb); }
        return; }
    const float rsa = 1.0f / sqrtf(wave_sum(sa, lane) * (1.0f / DM) + EPS), rsb = 1.0f / sqrtf(wave_sum(sb, lane) * (1.0f / DM) + EPS);
#pragma unroll
    for (int j = 0; j < 8; ++j) { const f32x4 gg = gr[64 * j]; v2u w;
        w.x = cvtpk(va[j].x * rsa * gg.x, va[j].y * rsa * gg.y); w.y = cvtpk(va[j].z * rsa * gg.z, va[j].w * rsa * gg.w); pa[64 * j] = w;
        w.x = cvtpk(vb[j].x * rsb * gg.x, vb[j].y * rsb * gg.y); w.y = cvtpk(vb[j].z * rsb * gg.z, vb[j].w * rsb * gg.w); pb[64 * j] = w; }
}
__device__ __forceinline__ void norm_phase(const Frame& F, float* h, const float* g, bf16* xn, const float* P, int pstride, int dry, const float* hin_s = nullptr, float* ssq = nullptr) {
    const int gw = F.vcu * NWAVES + F.wave, NGW = F.G * NWAVES;
    int m0 = gw;
    if (MK_NORM2) for (; m0 + NGW < MP; m0 += 2 * NGW) rms_row2_2048(h + (size_t)m0 * DM, h + (size_t)(m0 + NGW) * DM, g, xn + (size_t)m0 * DM, xn + (size_t)(m0 + NGW) * DM, F.lane, ssq ? ssq + (size_t)m0 * 8 : nullptr, ssq ? ssq + (size_t)(m0 + NGW) * 8 : nullptr);
    for (int m = m0; m < MT; m += NGW) { const bool fix = P != nullptr && m >= MP && F.G == 256;
        rms_row_2048((fix && hin_s) ? hin_s + (size_t)(m - MP) * DM : h + (size_t)m * DM, g, xn + (size_t)m * DM, (fix && !dry) ? h + (size_t)m * DM : nullptr, F.lane, fix ? P + (size_t)(m - MP) * pstride : nullptr, (size_t)MS * pstride, ssq ? ssq + (size_t)m * 8 : nullptr); }
}
__device__ __forceinline__ void tail_fix_phase(const Frame& F, float* h, bf16* xn, const float* P, int pstride, const float* hin_s, float* ssq) {
    const int gw = F.vcu * NWAVES + F.wave, NGW = F.G * NWAVES;
    if (F.G != 256) return;
    for (int m = MP + gw; m < MT; m += NGW)
        rms_row_2048(hin_s ? hin_s + (size_t)(m - MP) * DM : h + (size_t)m * DM, nullptr, xn + (size_t)m * DM, h + (size_t)m * DM, F.lane, P + (size_t)(m - MP) * pstride, (size_t)MS * pstride, ssq + (size_t)m * 8);
}
__device__ __forceinline__ void tail_row_b(const float* xrow, bf16* hb, float* yrow, const float* prow, size_t pq, float* ssqp, int lane) {
    f32x4 v[8];
    if (xrow) { const GAS f32x4* xr = (const GAS f32x4*)xrow + lane;
#pragma unroll
        for (int j = 0; j < 8; ++j) v[j] = xr[64 * j]; }
    else { const GAS v2u* hr = (const GAS v2u*)hb + lane; v2u w[8];
#pragma unroll
        for (int j = 0; j < 8; ++j) w[j] = hr[64 * j];
#pragma unroll
        for (int j = 0; j < 8; ++j) v[j] = (f32x4){bflo(w[j].x), bfhi(w[j].x), bflo(w[j].y), bfhi(w[j].y)}; }
#pragma unroll
    for (int q = 0; q < 4; ++q) { const GAS f32x4* pr = (const GAS f32x4*)(prow + q * pq) + lane;
#pragma unroll
        for (int j = 0; j < 8; ++j) v[j] += pr[64 * j]; }
    if (yrow) { GAS f32x4* yr = (GAS f32x4*)yrow + lane;
#pragma unroll
        for (int j = 0; j < 8; ++j) yr[64 * j] = v[j];
        return; }
    float s = 0.f;
#pragma unroll
    for (int j = 0; j < 8; ++j) s += (v[j].x * v[j].x + v[j].y * v[j].y) + (v[j].z * v[j].z + v[j].w * v[j].w);
    const float tot = wave_sum(s, lane); GAS v2u* o8 = (GAS v2u*)hb + lane;
#pragma unroll
    for (int j = 0; j < 8; ++j) { v2u w; w.x = cvtpk(v[j].x, v[j].y); w.y = cvtpk(v[j].z, v[j].w); o8[64 * j] = w; }
    if (lane == 0) ssq_row_store(ssqp, tot);
}
__device__ __forceinline__ void tail_fix_phase_b(const Frame& F, bf16* xn, float* yout, const float* P, int pstride, const float* xin_s, float* ssq) {
    const int gw = F.vcu * NWAVES + F.wave, NGW = F.G * NWAVES;
    if (F.G != 256) return;
    for (int m = MP + gw; m < MT; m += NGW)
        tail_row_b(xin_s ? xin_s + (size_t)(m - MP) * DM : nullptr, xn + (size_t)m * DM, yout ? yout + (size_t)m * DM : nullptr, P + (size_t)(m - MP) * pstride, (size_t)MS * pstride, ssq ? ssq + (size_t)m * 8 : nullptr, F.lane);
}
__device__ __forceinline__ void fixup_phase(const Frame& F, float* h, const float* P, int pstride, int dry) {
    const int gw = F.vcu * NWAVES + F.wave, NGW = F.G * NWAVES;
    if (F.G != 256) return;
    for (int m = MP + gw; m < MT; m += NGW) rms_row_2048(h + (size_t)m * DM, nullptr, nullptr, dry ? nullptr : h + (size_t)m * DM, F.lane, P + (size_t)(m - MP) * pstride, (size_t)MS * pstride);
}
__device__ __forceinline__ int kv_row_of_token(int tok) { return tok < MP ? tok : MP + ((tok - MP) >> 6) * KVT + PAST + (tok & 63); }
__device__ __forceinline__ int pos_of_token(int tok) { return tok < MP ? (tok & (SEQ - 1)) : PAST + (tok & (DSEQ - 1)); }

__device__ __forceinline__ void p0_prologue(const Args& A, const Frame& F) {
    unsigned char* ws = A.ws;
    const int gw = F.vcu * NWAVES + F.wave, NGW = F.G * NWAVES;
    LAS float* scr = (LAS float*)(F.lds + RING_OFF + F.wave * 16640);
    int base = 0;
#if MK_PRETOUCH
    {
        const size_t gt_ = (size_t)(gw * 64 + F.lane), NGT_ = (size_t)NGW * 64; unsigned acc_ = 0;
#define TOUCH(ptr, bytes) do { const GAS unsigned char* p_ = (const GAS unsigned char*)(ptr); for (size_t o_ = gt_ * 4096; o_ < (size_t)(bytes); o_ += NGT_ * 4096) acc_ += *(const GAS unsigned*)(p_ + o_); } while (0)
        TOUCH(ws, WS_END); TOUCH(A.out, OUT_END * 4);
        TOUCH(A.in[I_XP], (size_t)MP * DM * 4); TOUCH(A.in[I_XS], (size_t)MS * DM * 4); TOUCH(A.in[I_STATE], (size_t)NBS * RH * RDK * RDV * 4); TOUCH(A.in[I_CCKV], (size_t)NBS * PAST * KVL * 4); TOUCH(A.in[I_CKR], (size_t)NBS * PAST * ROPE * 4);
        TOUCH(A.in[I_F1IN], (size_t)2 * DM * 2 * DFF * 4); TOUCH(A.in[I_F2IN], (size_t)2 * DM * 2 * DFF * 4); TOUCH(A.in[I_F1OUT], (size_t)2 * DFF * DM * 4); TOUCH(A.in[I_F2OUT], (size_t)2 * DFF * DM * 4);
        TOUCH(A.in[I_RIN], (size_t)DM * RIN * 4); TOUCH(A.in[I_ROUT], (size_t)RHV * DM * 4); TOUCH(A.in[I_WO], (size_t)DM * DM * 4); TOUCH(A.in[I_WUKV], (size_t)KVL * KVW * 4);
#undef TOUCH
        if (acc_ == 0x9e3779b9u && gt_ == 0x7ffffffful) ((GAS unsigned*)ws)[1] = acc_;
    }
#endif
#define CONV(Wp, Kk, Nn, dst, mode) CONVG(Wp, Kk, Nn, dst, mode, 0, nullptr)
#define CONVB(Wp, Kk, Nn, dst, mode, blk) CONVG(Wp, Kk, Nn, dst, mode, blk, nullptr)
#define CONVG(Wp, Kk, Nn, dst, mode, blk, kg) do { const int nitems = ((Kk) >> 6) * ((Nn) >> 6); \
        for (int it = ((gw - base) % NGW + NGW) % NGW; it < nitems; it += NGW) conv_item((Wp), (Kk), (Nn), (bf16*)(ws + (dst)), (mode), scr, it, F.lane, (blk), (kg)); base = (base + nitems) % NGW; } while (0)
    CONVG(A.in[I_F1IN], DM, 2 * DFF, WS_WIN00, 1, 0, MK_NFOLD ? A.in[I_F1N] : nullptr);
    const bool defer = MK_DEFER && F.G == 256, defer2 = MK_DEFER == 2 && F.G == 256;
    if (!defer) CONVG(A.in[I_F1IN] + (size_t)DM * 2 * DFF, DM, 2 * DFF, WS_WIN10, 1, 0, MK_NFOLD ? A.in[I_F1N] + DM : nullptr);
    if (!defer2) CONVG(A.in[I_F2IN], DM, 2 * DFF, WS_WIN01, 1, 0, MK_NFOLD ? A.in[I_F2N] : nullptr);
    if (!defer) CONVG(A.in[I_F2IN] + (size_t)DM * 2 * DFF, DM, 2 * DFF, WS_WIN11, 1, 0, MK_NFOLD ? A.in[I_F2N] + DM : nullptr);
    if (!defer2) CONVB(A.in[I_F1OUT], DFF, DM, WS_WOUT00, 0, MK_BLK);
    if (!defer) CONVB(A.in[I_F1OUT] + (size_t)DFF * DM, DFF, DM, WS_WOUT10, 0, MK_BLK);
    if (!defer2) CONVB(A.in[I_F2OUT], DFF, DM, WS_WOUT01, 0, MK_BLK);
    if (!defer) CONVB(A.in[I_F2OUT] + (size_t)DFF * DM, DFF, DM, WS_WOUT11, 0, MK_BLK);
    if (!defer2) CONVG(A.in[I_RIN], DM, RIN, WS_WRIN, 0, 0, MK_NFOLD ? A.in[I_MIXN] : nullptr);
    if (!defer2) CONV(A.in[I_ROUT], RHV, DM, WS_WROUT, 0);
    if (!defer2) CONVG(A.in[I_WDKV], DM, KVL + ROPE, WS_WDKV, 0, 0, MK_NFOLD ? A.in[I_KVN] : nullptr);
    if (!defer2) CONV(A.in[I_WUKV], KVL, KVW, WS_WUKV, 0);
    if (!defer2) CONVG(A.in[I_WDQ], DM, QLR, WS_WDQ, 0, 0, MK_NFOLD ? A.in[I_MIXN] + DM : nullptr);
    if (!defer2) CONVG(A.in[I_WUQ], QLR, QW, WS_WUQ, 0, 0, MK_QLFUSE ? A.in[I_QLN] : nullptr);
    if (!defer2) CONV(A.in[I_WO], DM, DM, WS_WO, 0);
#undef CONV
#undef CONVB
#undef CONVG
    const int gt = gw * 64 + F.lane, NGT = NGW * 64;
    for (int i = gt; i < (DKVP - KVL - ROPE) * DM / 8; i += NGT) *((GAS v4u*)(ws + WS_WDKV + (size_t)(KVL + ROPE) * DM * 2) + i) = (v4u){0u, 0u, 0u, 0u};
    for (int i = gt; i < 2048 * 128; i += NGT) { const int pos = i >> 7, j = i & 127; float s, c; sincos_d((double)pos * powi_d(0.930572040929699, j), s, c);
        ((GAS float*)(ws + WS_COSR))[i] = c; ((GAS float*)(ws + WS_SINR))[i] = s; }
    for (int i = gt; i < 2048 * 32; i += NGT) { const int pos = i >> 5, j = i & 31; float s, c; sincos_d((double)pos * powi_d(0.7498942093324559, j), s, c);
        ((GAS float*)(ws + WS_COSM))[i] = c; ((GAS float*)(ws + WS_SINM))[i] = s; }
    if (gt < QKH) ((GAS float*)(ws + WS_GQK))[gt] = A.in[I_QN][gt] * A.in[I_KN][gt] * 0.10411754627697264f;
    for (int r0 = gw; r0 < NBS * PAST; r0 += 2 * NGW) {
        f32x4 a[2], bb[2]; float kr[2]; int kvrow[2];
#pragma unroll
        for (int q = 0; q < 2; ++q) { const int r = (r0 + q * NGW < NBS * PAST) ? r0 + q * NGW : r0; const int b = r >> 10, s = r & (PAST - 1); kvrow[q] = MP + b * KVT + s;
            const GAS f32x4* src = (const GAS f32x4*)(A.in[I_CCKV] + (size_t)r * KVL) + 2 * F.lane; a[q] = src[0]; bb[q] = src[1];
            kr[q] = ((const GAS float*)A.in[I_CKR])[(size_t)r * ROPE + F.lane]; }
        float q2[2] = {kr[0] * kr[0], kr[1] * kr[1]};
#pragma unroll
        for (int o = 1; o < 64; o <<= 1) { q2[0] += shfl_xor_l(q2[0], o, F.lane); q2[1] += shfl_xor_l(q2[1], o, F.lane); }
#pragma unroll
        for (int q = 0; q < 2; ++q) { v4u w; w.x = cvtpk(a[q].x, a[q].y); w.y = cvtpk(a[q].z, a[q].w); w.z = cvtpk(bb[q].x, bb[q].y); w.w = cvtpk(bb[q].z, bb[q].w);
            *((GAS v4u*)(ws + WS_CALL + (size_t)kvrow[q] * KVL * 2) + F.lane) = w;
            ((GAS bf16*)(ws + WS_KRALL))[(size_t)kvrow[q] * ROPE + F.lane] = (bf16)(cvtpk(kr[q], 0.f) & 0xffffu);
            if (F.lane == 0) ((GAS float*)(ws + WS_SSQKR))[kvrow[q]] = q2[q]; } }
    { int m0 = gw;
      float* q0 = MK_NFOLD ? (float*)(ws + WS_SSQH) : nullptr;
      for (; m0 + NGW < MP; m0 += 2 * NGW) rms_row2_2048(A.in[I_XP] + (size_t)m0 * DM, A.in[I_XP] + (size_t)(m0 + NGW) * DM, A.in[I_F1N], (bf16*)(ws + WS_XN) + (size_t)m0 * DM, (bf16*)(ws + WS_XN) + (size_t)(m0 + NGW) * DM, F.lane, q0 ? q0 + (size_t)m0 * 8 : nullptr, q0 ? q0 + (size_t)(m0 + NGW) * 8 : nullptr);
      for (int m = m0; m < MT; m += NGW) { const float* xrow = m < MP ? A.in[I_XP] + (size_t)m * DM : A.in[I_XS] + (size_t)(m - MP) * DM;
        rms_row_2048(xrow, A.in[I_F1N], (bf16*)(ws + WS_XN) + (size_t)m * DM, nullptr, F.lane, nullptr, 0, q0 ? q0 + (size_t)m * 8 : nullptr); } }
}

struct DefD { const float* W; int K, N; bf16* WT; int mode, blocked; const float* kg; int item; };
__device__ __forceinline__ void conv_load64(const DefD& d, int lane, float (&t)[64], f32x4 (&kg)[2]) {
    const int nblk = d.N >> 6, kb = d.item / nblk, nb = d.item - kb * nblk, k0 = 64 * kb, n0 = 64 * nb;
    const GAS float* src = (const GAS float*)d.W + (size_t)k0 * d.N + n0 + lane;
#pragma unroll
    for (int i = 0; i < 64; ++i) t[i] = MK_DEFNT ? __builtin_nontemporal_load(src + (size_t)i * d.N) : src[(size_t)i * d.N];
    kg[0] = (f32x4){1.f, 1.f, 1.f, 1.f}; kg[1] = kg[0];
    if (d.kg) { const GAS f32x4* gp = (const GAS f32x4*)(d.kg + k0 + 8 * (lane & 7)); kg[0] = gp[0]; kg[1] = gp[1]; }
}
__device__ __forceinline__ void conv_finish64(const DefD& d, LAS float* scr, int lane, const float (&t)[64], const f32x4 (&kg)[2]) {
    const int nblk = d.N >> 6, kb = d.item / nblk, nb = d.item - kb * nblk, k0 = 64 * kb, n0 = 64 * nb;
#pragma unroll
    for (int i = 0; i < 64; ++i) scr[i * 65 + lane] = t[i];
    LDS_WAIT(); asm volatile("" ::: "memory");
    const int c = lane & 7;
#pragma unroll
    for (int j = 0; j < 8; ++j) { const int n = (lane >> 3) + 8 * j; const LAS float* s = scr + (8 * c) * 65 + n;
        v4u o; o.x = cvtpk(s[0 * 65] * kg[0].x, s[1 * 65] * kg[0].y); o.y = cvtpk(s[2 * 65] * kg[0].z, s[3 * 65] * kg[0].w); o.z = cvtpk(s[4 * 65] * kg[1].x, s[5 * 65] * kg[1].y); o.w = cvtpk(s[6 * 65] * kg[1].z, s[7 * 65] * kg[1].w);
        const int dr = dst_row_map(d.mode, n0 + n);
        GAS v4u* op = (GAS v4u*)(d.blocked ? d.WT + ((size_t)(dr >> 8) * (d.K >> 6) + kb) * (256 * 64) + (dr & 255) * 64 + 8 * c : d.WT + (size_t)dr * d.K + k0 + 8 * c);
        if (MK_DEFNT) __builtin_nontemporal_store(o, op); else *op = o; }
    LDS_WAIT(); asm volatile("" ::: "memory");
}
__device__ __forceinline__ void conv_deferred(const Args& A, const Frame& F, int slot) {
    if (!(MK_DEFER && F.G == 256)) return;
    unsigned char* ws = A.ws; LAS float* scr = (LAS float*)(F.lds + RING_OFF + F.wave * 16640);
#if MK_DEFER == 2
    if (slot > 5) return;
    const int first = slot == 1 ? 128 : slot == 4 ? 144 : 96;
    const int q0 = slot == 0 ? 0 : slot == 1 ? 8960 : slot == 2 ? 16640 : slot == 3 ? 25376 : slot == 4 ? 30368 : 36000, q1 = slot == 0 ? 8960 : slot == 1 ? 16640 : slot == 2 ? 25376 : slot == 3 ? 30368 : slot == 4 ? 36000 : 38816;
    const int qm = q0 + (int)((long)(q1 - q0) * (slot == 0 ? MK_DEFSPLIT0 : slot == 1 ? MK_DEFSPLIT1 : slot == 2 ? MK_DEFSPLIT2 : slot == 3 ? MK_DEFSPLIT3 : MK_DEFSPLIT4) / 1000);
    const int vrank = MK_XTAIL ? ((int)blockIdx.x % 8) * 32 + (int)blockIdx.x / 8 : (int)blockIdx.x;
    const bool idle = vrank >= first;
    const int nidle = idle ? 256 - first : first, r = idle ? vrank - first : vrank, s0 = idle ? q0 : qm, s1 = idle ? qm : q1;
    auto desc = [&](int it) -> DefD {
        if (it < 2816) return DefD{A.in[I_F1OUT], DFF, DM, (bf16*)(ws + WS_WOUT00), 0, MK_BLK, nullptr, it};
        if (it < 8960) return DefD{A.in[I_RIN], DM, RIN, (bf16*)(ws + WS_WRIN), 0, 0, MK_NFOLD ? A.in[I_MIXN] : nullptr, it - 2816};
        if (it < 11008) return DefD{A.in[I_ROUT], RHV, DM, (bf16*)(ws + WS_WROUT), 0, 0, nullptr, it - 8960};
        if (it < 16640) return DefD{A.in[I_F2IN], DM, 2 * DFF, (bf16*)(ws + WS_WIN01), 1, 0, MK_NFOLD ? A.in[I_F2N] : nullptr, it - 11008};
        if (it < 19456) return DefD{A.in[I_F2OUT], DFF, DM, (bf16*)(ws + WS_WOUT01), 0, MK_BLK, nullptr, it - 16640};
        if (it < 19744) return DefD{A.in[I_WDKV], DM, KVL + ROPE, (bf16*)(ws + WS_WDKV), 0, 0, MK_NFOLD ? A.in[I_KVN] : nullptr, it - 19456};
        if (it < 25376) return DefD{A.in[I_F1IN] + (size_t)DM * 2 * DFF, DM, 2 * DFF, (bf16*)(ws + WS_WIN10), 1, 0, MK_NFOLD ? A.in[I_F1N] + DM : nullptr, it - 19744};
        if (it < 28192) return DefD{A.in[I_F1OUT] + (size_t)DFF * DM, DFF, DM, (bf16*)(ws + WS_WOUT10), 0, MK_BLK, nullptr, it - 25376};
        if (it < 28448) return DefD{A.in[I_WDQ], DM, QLR, (bf16*)(ws + WS_WDQ), 0, 0, MK_NFOLD ? A.in[I_MIXN] + DM : nullptr, it - 28192};
        if (it < 28832) return DefD{A.in[I_WUQ], QLR, QW, (bf16*)(ws + WS_WUQ), 0, 0, MK_QLFUSE ? A.in[I_QLN] : nullptr, it - 28448};
        if (it < 29344) return DefD{A.in[I_WUKV], KVL, KVW, (bf16*)(ws + WS_WUKV), 0, 0, nullptr, it - 28832};
        if (it < 30368) return DefD{A.in[I_WO], DM, DM, (bf16*)(ws + WS_WO), 0, 0, nullptr, it - 29344};
        if (it < 36000) return DefD{A.in[I_F2IN] + (size_t)DM * 2 * DFF, DM, 2 * DFF, (bf16*)(ws + WS_WIN11), 1, 0, MK_NFOLD ? A.in[I_F2N] + DM : nullptr, it - 30368};
        return DefD{A.in[I_F2OUT] + (size_t)DFF * DM, DFF, DM, (bf16*)(ws + WS_WOUT11), 0, MK_BLK, nullptr, it - 36000}; };
    int it = s0 + r * NWAVES + F.wave; const int st = nidle * NWAVES;
    if (it >= s1) return;
    float ta[64]; f32x4 ka[2]; DefD d = desc(it); conv_load64(d, F.lane, ta, ka);
    for (;;) { const int itn = it + st; const bool more = itn < s1; DefD dn = d; float tb[64]; f32x4 kb[2];
        if (more) { dn = desc(itn); conv_load64(dn, F.lane, tb, kb); }
        conv_finish64(d, scr, F.lane, ta, ka);
        if (!more) break;
#pragma unroll
        for (int i = 0; i < 64; ++i) ta[i] = tb[i];
        ka[0] = kb[0]; ka[1] = kb[1]; d = dn; it = itn; }
#else
    if (slot > 3) return;
    const int first = slot == 1 ? 128 : 96, nidle = 256 - first, r = (int)blockIdx.x - first;
    if (r < 0) return;
    const int s0 = slot == 0 ? 0 : slot == 1 ? 5120 : slot == 2 ? 9216 : 14336, s1 = slot == 0 ? 5120 : slot == 1 ? 9216 : slot == 2 ? 14336 : 16896;
    for (int it = s0 + r * NWAVES + F.wave; it < s1; it += nidle * NWAVES) {
        if (it < 5632) conv_item<MK_DEFUNROLL>(A.in[I_F1IN] + (size_t)DM * 2 * DFF, DM, 2 * DFF, (bf16*)(ws + WS_WIN10), 1, scr, it, F.lane, 0, MK_NFOLD ? A.in[I_F1N] + DM : nullptr);
        else if (it < 8448) conv_item<MK_DEFUNROLL>(A.in[I_F1OUT] + (size_t)DFF * DM, DFF, DM, (bf16*)(ws + WS_WOUT10), 0, scr, it - 5632, F.lane, MK_BLK, nullptr);
        else if (it < 14080) conv_item<MK_DEFUNROLL>(A.in[I_F2IN] + (size_t)DM * 2 * DFF, DM, 2 * DFF, (bf16*)(ws + WS_WIN11), 1, scr, it - 8448, F.lane, 0, MK_NFOLD ? A.in[I_F2N] + DM : nullptr);
        else conv_item<MK_DEFUNROLL>(A.in[I_F2OUT] + (size_t)DFF * DM, DFF, DM, (bf16*)(ws + WS_WOUT11), 0, scr, it - 14080, F.lane, MK_BLK, nullptr);
    }
#endif
}
static_assert((DM / 64) * (2 * DFF / 64) == 5632 && (DFF / 64) * (DM / 64) == 2816 && (DM / 64) * (RIN / 64) == 6144 && (RHV / 64) * (DM / 64) == 2048 && (DM / 64) * ((KVL + ROPE) / 64) == 288
              && (DM / 64) * (QLR / 64) == 256 && (QLR / 64) * (QW / 64) == 384 && (KVL / 64) * (KVW / 64) == 512 && (DM / 64) * (DM / 64) == 1024, "deferred item counts");

__device__ __forceinline__ void gn_gate_phase(const Args& A, const Frame& F) {
    const int gw = F.vcu * NWAVES + F.wave, NGW = F.G * NWAVES; bf16* QKVG = (bf16*)(A.ws + WS_BIG);
    for (int it = gw; it < MT * 2; it += NGW) { const int tok = it >> 1, h0 = (it & 1) * 4;
        bf16* op = QKVG + (size_t)tok * RIN + 4096 + h0 * RDV + 8 * F.lane;
        v4u ow[4], gv[4];
#pragma unroll
        for (int q = 0; q < 4; ++q) { ow[q] = *(const GAS v4u*)(op + q * RDV); gv[q] = *(const GAS v4u*)(op + q * RDV + 4096); }
        float x[4][8], s[4];
#pragma unroll
        for (int q = 0; q < 4; ++q) { x[q][0] = bflo(ow[q].x); x[q][1] = bfhi(ow[q].x); x[q][2] = bflo(ow[q].y); x[q][3] = bfhi(ow[q].y); x[q][4] = bflo(ow[q].z); x[q][5] = bfhi(ow[q].z); x[q][6] = bflo(ow[q].w); x[q][7] = bfhi(ow[q].w);
            s[q] = ((x[q][0] + x[q][1]) + (x[q][2] + x[q][3])) + ((x[q][4] + x[q][5]) + (x[q][6] + x[q][7])); }
#pragma unroll
        for (int o = 1; o < 64; o <<= 1) {
#pragma unroll
            for (int q = 0; q < 4; ++q) s[q] += shfl_xor_l(s[q], o, F.lane); }
        float v[4];
#pragma unroll
        for (int q = 0; q < 4; ++q) { const float mu = s[q] * (1.0f / RDV); v[q] = 0.f;
#pragma unroll
            for (int i = 0; i < 8; ++i) { x[q][i] -= mu; v[q] += x[q][i] * x[q][i]; } }
#pragma unroll
        for (int o = 1; o < 64; o <<= 1) {
#pragma unroll
            for (int q = 0; q < 4; ++q) v[q] += shfl_xor_l(v[q], o, F.lane); }
#pragma unroll
        for (int q = 0; q < 4; ++q) { const float rstd = 1.0f / sqrtf(v[q] * (1.0f / RDV) + EPS);
            const GAS f32x4* gp = (const GAS f32x4*)(A.in[I_RGN] + (h0 + q) * RDV + 8 * F.lane); const f32x4 g0 = gp[0], g1 = gp[1];
            const float gg[8] = {g0.x, g0.y, g0.z, g0.w, g1.x, g1.y, g1.z, g1.w};
            const float sg[8] = {bflo(gv[q].x), bfhi(gv[q].x), bflo(gv[q].y), bfhi(gv[q].y), bflo(gv[q].z), bfhi(gv[q].z), bflo(gv[q].w), bfhi(gv[q].w)};
            float y[8];
#pragma unroll
            for (int i = 0; i < 8; ++i) y[i] = sg[i] * (x[q][i] * rstd * gg[i]);
            v4u w; w.x = cvtpk(y[0], y[1]); w.y = cvtpk(y[2], y[3]); w.z = cvtpk(y[4], y[5]); w.w = cvtpk(y[6], y[7]);
            if (!A.dry) *(GAS v4u*)(op + q * RDV) = w; }
    }
}

__device__ __forceinline__ void latent_phase(const Args& A, const Frame& F) {
    const int gw = F.vcu * NWAVES + F.wave, NGW = F.G * NWAVES; unsigned char* ws = A.ws;
    for (int tok = gw; tok < MT; tok += NGW) {
        const GAS float* row = (const GAS float*)(ws + WS_SMALL) + (size_t)tok * DKVP;
        f32x4 a = ((const GAS f32x4*)row)[F.lane], b = ((const GAS f32x4*)row)[64 + F.lane];
        float rsh = 1.0f;
        if (MK_NFOLD) { const GAS f32x4* qp = (const GAS f32x4*)(ws + WS_SSQH + 3 * SSQH_STRIDE) + (size_t)tok * 2; rsh = rs_of8(qp[0], qp[1]); a *= rsh; b *= rsh; }
        const float ss = wave_sum((a.x * a.x + a.y * a.y) + (a.z * a.z + a.w * a.w) + (b.x * b.x + b.y * b.y) + (b.z * b.z + b.w * b.w), F.lane);
        const float rs = 1.0f / sqrtf(ss * (1.0f / KVL) + EPS);
        const f32x4 ga = ((const GAS f32x4*)A.in[I_KVLN])[F.lane], gb = ((const GAS f32x4*)A.in[I_KVLN])[64 + F.lane];
        const f32x4 ca = a * rs * ga, cb = b * rs * gb;
        float* cout = tok < MP ? A.out + OUT_CKVP + (size_t)tok * KVL : A.out + OUT_CKVS + (size_t)(tok - MP) * KVL;
        if (!A.dry) { ((GAS f32x4*)cout)[F.lane] = ca; ((GAS f32x4*)cout)[64 + F.lane] = cb; }
        const int kvrow = kv_row_of_token(tok), pos = pos_of_token(tok);
        GAS v2u* cb16 = (GAS v2u*)(ws + WS_CALL + (size_t)kvrow * KVL * 2);
        v2u w; w.x = cvtpk(ca.x, ca.y); w.y = cvtpk(ca.z, ca.w); cb16[F.lane] = w; w.x = cvtpk(cb.x, cb.y); w.y = cvtpk(cb.z, cb.w); cb16[64 + F.lane] = w;
        const int j = F.lane & 31;
        const float x1 = row[KVL + j] * rsh, x2 = row[KVL + 32 + j] * rsh;
        const float c = ((const GAS float*)(ws + WS_COSM))[pos * 32 + j], s = ((const GAS float*)(ws + WS_SINM))[pos * 32 + j];
        const float o1 = x1 * c - x2 * s, o2 = x1 * s + x2 * c;
        float* kout = tok < MP ? A.out + OUT_KRP + (size_t)tok * ROPE : A.out + OUT_KRS + (size_t)(tok - MP) * ROPE;
        GAS bf16* kb = (GAS bf16*)(ws + WS_KRALL) + (size_t)kvrow * ROPE;
        if (F.lane < 32 && !A.dry) { ((GAS float*)kout)[j] = o1; ((GAS float*)kout)[32 + j] = o2; kb[j] = (bf16)(cvtpk(o1, 0.f) & 0xffffu); kb[32 + j] = (bf16)(cvtpk(o2, 0.f) & 0xffffu); }
        const float q = wave_sum(F.lane < 32 ? (o1 * o1 + o2 * o2) : 0.f, F.lane);
        if (F.lane == 0) ((GAS float*)(ws + WS_SSQKR))[kvrow] = q;
        if (!MK_NFOLD) rms_row_2048(A.out + (size_t)tok * DM, A.in[I_F1N] + DM, (bf16*)(ws + WS_XN) + (size_t)tok * DM, nullptr, F.lane);
    }
}
__device__ __forceinline__ void qlat_norm_phase(const Args& A, const Frame& F) {
    const int gw = F.vcu * NWAVES + F.wave, NGW = F.G * NWAVES; unsigned char* ws = A.ws;
    for (int tok = gw; tok < MT; tok += NGW) {
        const GAS f32x4* row = (const GAS f32x4*)(ws + WS_SMALL) + (size_t)tok * (QLR / 4);
        const f32x4 a = row[F.lane], b = row[64 + F.lane];
        const float ss = wave_sum((a.x * a.x + a.y * a.y) + (a.z * a.z + a.w * a.w) + (b.x * b.x + b.y * b.y) + (b.z * b.z + b.w * b.w), F.lane);
        const float rs = 1.0f / sqrtf(ss * (1.0f / QLR) + EPS);
        const f32x4 ga = ((const GAS f32x4*)A.in[I_QLN])[F.lane], gb = ((const GAS f32x4*)A.in[I_QLN])[64 + F.lane];
        const f32x4 ca = a * rs * ga, cb = b * rs * gb;
        GAS v2u* o = (GAS v2u*)(ws + WS_QLN + (size_t)tok * QLR * 2);
        v2u w; w.x = cvtpk(ca.x, ca.y); w.y = cvtpk(ca.z, ca.w); o[F.lane] = w; w.x = cvtpk(cb.x, cb.y); w.y = cvtpk(cb.z, cb.w); o[64 + F.lane] = w;
    }
}
__device__ __forceinline__ void qfin_phase(const Args& A, const Frame& F) {
    const int gw = F.vcu * NWAVES + F.wave, NGW = F.G * NWAVES; unsigned char* ws = A.ws;
    const int head = F.lane >> 2, sub = F.lane & 3;
    const GAS float* gqk = (const GAS float*)(ws + WS_GQK);
    float gn[32], ga[8], gb[8];
#pragma unroll
    for (int i = 0; i < 32; ++i) gn[i] = gqk[32 * sub + i];
#pragma unroll
    for (int i = 0; i < 8; ++i) { ga[i] = gqk[NOPE + 8 * sub + i]; gb[i] = gqk[NOPE + 32 + 8 * sub + i]; }
    struct Row { v4u nw[4], r1, r2; f32x4 c0, c1, s0, s1; };
#define QF_LOAD(R, tok) do { const bf16* b_ = (const bf16*)(ws + WS_Q) + (size_t)(tok) * QW + head * QKH; \
        _Pragma("unroll") for (int i = 0; i < 4; ++i) R.nw[i] = *(const GAS v4u*)(b_ + 32 * sub + 8 * i); \
        R.r1 = *(const GAS v4u*)(b_ + NOPE + 8 * sub); R.r2 = *(const GAS v4u*)(b_ + NOPE + 32 + 8 * sub); const int pos_ = pos_of_token(tok); \
        const GAS f32x4* cp_ = (const GAS f32x4*)((const GAS float*)(ws + WS_COSM) + pos_ * 32 + 8 * sub); const GAS f32x4* sp_ = (const GAS f32x4*)((const GAS float*)(ws + WS_SINM) + pos_ * 32 + 8 * sub); \
        R.c0 = cp_[0]; R.c1 = cp_[1]; R.s0 = sp_[0]; R.s1 = sp_[1]; } while (0)
    Row cur, nxt;
    if (gw < MT) QF_LOAD(cur, gw);
    for (int tok = gw; tok < MT; tok += NGW) {
        const bool more = tok + NGW < MT;
        if (more) QF_LOAD(nxt, tok + NGW);
        bf16* base = (bf16*)(ws + WS_Q) + (size_t)tok * QW + head * QKH;
        const float cc[8] = {cur.c0.x, cur.c0.y, cur.c0.z, cur.c0.w, cur.c1.x, cur.c1.y, cur.c1.z, cur.c1.w}, sn[8] = {cur.s0.x, cur.s0.y, cur.s0.z, cur.s0.w, cur.s1.x, cur.s1.y, cur.s1.z, cur.s1.w};
        const float a[8] = {bflo(cur.r1.x), bfhi(cur.r1.x), bflo(cur.r1.y), bfhi(cur.r1.y), bflo(cur.r1.z), bfhi(cur.r1.z), bflo(cur.r1.w), bfhi(cur.r1.w)};
        const float b[8] = {bflo(cur.r2.x), bfhi(cur.r2.x), bflo(cur.r2.y), bfhi(cur.r2.y), bflo(cur.r2.z), bfhi(cur.r2.z), bflo(cur.r2.w), bfhi(cur.r2.w)};
        float ra[8], rb[8], ss = 0.f;
#pragma unroll
        for (int i = 0; i < 8; ++i) { ra[i] = a[i] * cc[i] - b[i] * sn[i]; rb[i] = a[i] * sn[i] + b[i] * cc[i]; ss += ra[i] * ra[i] + rb[i] * rb[i]; }
        float nf[32];
#pragma unroll
        for (int i = 0; i < 4; ++i) { nf[8 * i + 0] = bflo(cur.nw[i].x); nf[8 * i + 1] = bfhi(cur.nw[i].x); nf[8 * i + 2] = bflo(cur.nw[i].y); nf[8 * i + 3] = bfhi(cur.nw[i].y);
            nf[8 * i + 4] = bflo(cur.nw[i].z); nf[8 * i + 5] = bfhi(cur.nw[i].z); nf[8 * i + 6] = bflo(cur.nw[i].w); nf[8 * i + 7] = bfhi(cur.nw[i].w); }
#pragma unroll
        for (int i = 0; i < 32; ++i) ss += nf[i] * nf[i];
        ss += shfl_xor_l(ss, 1, F.lane); ss += shfl_xor_l(ss, 2, F.lane);
        const float rs = 1.0f / sqrtf(ss * (1.0f / QKH) + EPS);
#pragma unroll
        for (int i = 0; i < 4; ++i) { float o[8];
#pragma unroll
            for (int e = 0; e < 8; ++e) o[e] = nf[8 * i + e] * rs * gn[8 * i + e];
            v4u w; w.x = cvtpk(o[0], o[1]); w.y = cvtpk(o[2], o[3]); w.z = cvtpk(o[4], o[5]); w.w = cvtpk(o[6], o[7]);
            if (!A.dry) *(GAS v4u*)(base + 32 * sub + 8 * i) = w; }
        { float o[8], p[8];
#pragma unroll
            for (int e = 0; e < 8; ++e) { o[e] = ra[e] * rs * ga[e]; p[e] = rb[e] * rs * gb[e]; }
            v4u w; w.x = cvtpk(o[0], o[1]); w.y = cvtpk(o[2], o[3]); w.z = cvtpk(o[4], o[5]); w.w = cvtpk(o[6], o[7]);
            if (!A.dry) *(GAS v4u*)(base + NOPE + 8 * sub) = w;
            w.x = cvtpk(p[0], p[1]); w.y = cvtpk(p[2], p[3]); w.z = cvtpk(p[4], p[5]); w.w = cvtpk(p[6], p[7]);
            if (!A.dry) *(GAS v4u*)(base + NOPE + 32 + 8 * sub) = w; }
        if (more) cur = nxt;
    }
#undef QF_LOAD
}
constexpr int SC_QS = 264, SC_KS = 264, SC_VS = 136, SC_PS = 72;
constexpr int SC_Q = 0, SC_K = SC_Q + 64 * SC_QS * 2, SC_V = SC_K + 64 * SC_KS * 2, SC_P = SC_V + 64 * SC_VS * 2, SC_END = SC_P + 64 * SC_PS * 2;
static_assert(SC_END <= RING_BYTES, "scan LDS");
__device__ __forceinline__ s16x4 tr16(const LAS unsigned char* p) {
    typedef short v4i16_t __attribute__((ext_vector_type(4)));
    return __builtin_bit_cast(s16x4, __builtin_amdgcn_ds_read_tr16_b64_v4i16((LAS v4i16_t*)p)); }
__device__ __forceinline__ bf16x8 cat4(s16x4 l, s16x4 h) { return (bf16x8){l[0], l[1], l[2], l[3], h[0], h[1], h[2], h[3]}; }

__device__ __forceinline__ void scan_unit(LAS unsigned char* lds, bf16* QKVG, size_t tok0, int nch, int h, int jv, const float* Sin, float* Sout, int tid, int dry) {
    const int wid = __builtin_amdgcn_readfirstlane(tid >> 6), lane = tid & 63, fr = lane & 15, fq = lane >> 4;
    f32x4 S[16];
    const int dvcol = jv * 128 + wid * 16 + fr;
    if (Sin) {
#pragma unroll
        for (int T = 0; T < 16; ++T)
#pragma unroll
            for (int i = 0; i < 4; ++i) S[T][i] = ((const GAS float*)Sin)[(size_t)(16 * T + 4 * fq + i) * RDV + dvcol];
    } else {
#pragma unroll
        for (int T = 0; T < 16; ++T) S[T] = (f32x4){0.f, 0.f, 0.f, 0.f};
    }
    const float g64 = __builtin_amdgcn_exp2f(64.0f * lg2gamma(h));
    const GAS bf16* gq = (const GAS bf16*)QKVG + tok0 * RIN + h * RDK;
    const GAS bf16* gk = gq + 2048;
    GAS bf16* gv = (GAS bf16*)QKVG + tok0 * RIN + 4096 + h * RDV + jv * 128;
    bf16x8 pq[4], pk[4], pv[2];
#define SC_LOAD(cc) do { _Pragma("unroll") for (int i = 0; i < 4; ++i) { const int idx = tid + 512 * i, r = idx >> 5, c = idx & 31; \
            pq[i] = *(const GAS bf16x8*)(gq + (size_t)((cc) * 64 + r) * RIN + 8 * c); pk[i] = *(const GAS bf16x8*)(gk + (size_t)((cc) * 64 + r) * RIN + 8 * c); } \
        _Pragma("unroll") for (int i = 0; i < 2; ++i) { const int idx = tid + 512 * i, r = idx >> 4, c = idx & 15; pv[i] = *(const GAS bf16x8*)(gv + (size_t)((cc) * 64 + r) * RIN + 8 * c); } } while (0)
#define SC_WRITE() do { _Pragma("unroll") for (int i = 0; i < 4; ++i) { const int idx = tid + 512 * i, r = idx >> 5, c = idx & 31; \
            *(LAS bf16x8*)(lds + SC_Q + (r * SC_QS + 8 * c) * 2) = pq[i]; *(LAS bf16x8*)(lds + SC_K + (r * SC_KS + 8 * c) * 2) = pk[i]; } \
        _Pragma("unroll") for (int i = 0; i < 2; ++i) { const int idx = tid + 512 * i, r = idx >> 4, c = idx & 15; *(LAS bf16x8*)(lds + SC_V + (r * SC_VS + 8 * c) * 2) = pv[i]; } } while (0)
    SC_LOAD(0);
    const int tq = fr >> 2, tp = fr & 3;
#define SC_TOUCH(cc_, x0, x1) do { const int ct_ = (cc_) < nch ? (cc_) : nch - 1; int t_ = tid; asm volatile("" : "+v"(t_)); \
        x0 = *(const GAS unsigned*)(gq + (size_t)(ct_ * 64 + (t_ >> 3)) * RIN + (t_ & 3) * 64 + ((t_ >> 2) & 1) * 2048); \
        x1 = *(const GAS unsigned*)(gv + (size_t)(ct_ * 64 + ((t_ >> 1) & 63)) * RIN + (t_ & 1) * 64); } while (0)
    unsigned dA0 = 0u, dA1 = 0u, dB0 = 0u, dB1 = 0u;
    if (MK_SCAN_PF && nch > 1) SC_TOUCH(1, dB0, dB1);
    auto step = [&](const int cc, unsigned& i0, unsigned& i1, const unsigned c0, const unsigned c1) __attribute__((always_inline)) {
        SC_WRITE();
        if (cc + 1 < nch) SC_LOAD(cc + 1);
        if (MK_SCAN_PF && nch > 1) SC_TOUCH(cc + 2, i0, i1);
        __syncthreads();
#pragma unroll
        for (int e = 0; e < 2; ++e) { const int idx = 2 * wid + e, ts = idx >> 2, tt = idx & 3;
            f32x4 a = (f32x4){0.f, 0.f, 0.f, 0.f};
            if (ts <= tt) {
#pragma unroll
                for (int ks = 0; ks < 8; ++ks) { const bf16x8 ak = *(const LAS bf16x8*)(lds + SC_K + ((16 * ts + fr) * SC_KS + 32 * ks + 8 * fq) * 2);
                    const bf16x8 bq = *(const LAS bf16x8*)(lds + SC_Q + ((16 * tt + fr) * SC_QS + 32 * ks + 8 * fq) * 2);
                    a = __builtin_amdgcn_mfma_f32_16x16x32_bf16(ak, bq, a, 0, 0, 0); }
            }
            float v[4];
#pragma unroll
            for (int i = 0; i < 4; ++i) v[i] = (ts < tt || (ts == tt && fr >= 4 * fq + i)) ? a[i] : 0.f;
            v2u w; w.x = cvtpk(v[0], v[1]); w.y = cvtpk(v[2], v[3]);
            *(LAS v2u*)(lds + SC_P + ((16 * tt + fr) * SC_PS + 16 * ts + 4 * fq) * 2) = w; }
        __syncthreads();
#if defined(MK_DEBUG)
        if (cc == 0 && jv == 0) { const int pidx = Sin ? 64 + (int)((tok0 - MP) >> 6) * 8 + h : (int)(tok0 >> 11) * 8 + h;
            *(GAS v4u*)((GAS unsigned char*)QKVG + (size_t)(985 + 24) * 1048576 - (size_t)552 * 1048576 + (size_t)pidx * 8192 + (tid >> 3) * 128 + (tid & 7) * 16) = *(const LAS v4u*)(lds + SC_P + ((tid >> 3) * SC_PS + 8 * (tid & 7)) * 2); }
#endif
        f32x4 O[4];
#pragma unroll
        for (int tt = 0; tt < 4; ++tt) O[tt] = (f32x4){0.f, 0.f, 0.f, 0.f};
#pragma unroll
        for (int ks = 0; ks < 8; ++ks) {
            v4u aw; aw.x = cvtpk(S[2 * ks][0], S[2 * ks][1]); aw.y = cvtpk(S[2 * ks][2], S[2 * ks][3]); aw.z = cvtpk(S[2 * ks + 1][0], S[2 * ks + 1][1]); aw.w = cvtpk(S[2 * ks + 1][2], S[2 * ks + 1][3]);
            const bf16x8 av = __builtin_bit_cast(bf16x8, aw);
#pragma unroll
            for (int tt = 0; tt < 4; ++tt) { const LAS unsigned char* qp = lds + SC_Q + ((16 * tt + fr) * SC_QS + 32 * ks + 4 * fq) * 2;
                const v2u lo = *(const LAS v2u*)qp, hi = *(const LAS v2u*)(qp + 32);
                v4u bw; bw.x = lo.x; bw.y = lo.y; bw.z = hi.x; bw.w = hi.y;
                O[tt] = __builtin_amdgcn_mfma_f32_16x16x32_bf16(av, __builtin_bit_cast(bf16x8, bw), O[tt], 0, 0, 0); } }
        bf16x8 vA[2];
#pragma unroll
        for (int k2 = 0; k2 < 2; ++k2) { const LAS unsigned char* vp = lds + SC_V + ((32 * k2 + 8 * fq + tq) * SC_VS + 16 * wid + 4 * tp) * 2;
            vA[k2] = cat4(tr16(vp), tr16(vp + 4 * SC_VS * 2)); }
#pragma unroll
        for (int tt = 0; tt < 4; ++tt)
#pragma unroll
            for (int k2 = 0; k2 < 2; ++k2) { if (k2 == 1 && tt < 2) continue;
                const bf16x8 bp = *(const LAS bf16x8*)(lds + SC_P + ((16 * tt + fr) * SC_PS + 32 * k2 + 8 * fq) * 2);
                O[tt] = __builtin_amdgcn_mfma_f32_16x16x32_bf16(vA[k2], bp, O[tt], 0, 0, 0); }
#pragma unroll
        for (int tt = 0; tt < 4; ++tt) { v2u w; w.x = cvtpk(O[tt][0], O[tt][1]); w.y = cvtpk(O[tt][2], O[tt][3]);
            if (!dry) *(GAS v2u*)(gv + (size_t)(cc * 64 + 16 * tt + fr) * RIN + 16 * wid + 4 * fq) = w; }
#pragma unroll
        for (int T = 0; T < 16; ++T)
#pragma unroll
            for (int k2 = 0; k2 < 2; ++k2) { const LAS unsigned char* kp = lds + SC_K + ((32 * k2 + 8 * fq + tq) * SC_KS + 16 * T + 4 * tp) * 2;
                const bf16x8 ak = cat4(tr16(kp), tr16(kp + 4 * SC_KS * 2));
                S[T] = __builtin_amdgcn_mfma_f32_16x16x32_bf16(ak, vA[k2], S[T], 0, 0, 0); }
#pragma unroll
        for (int T = 0; T < 16; ++T) S[T] = S[T] * g64;
        if (MK_SCAN_PF && nch > 1) asm volatile("" :: "v"(c0), "v"(c1));
        __syncthreads();
    };
    for (int cc = 0; cc < nch; cc += 2) { step(cc, dA0, dA1, dB0, dB1); if (cc + 1 < nch) step(cc + 1, dB0, dB1, dA0, dA1); }
#undef SC_LOAD
#undef SC_WRITE
#undef SC_TOUCH
#pragma unroll
    for (int T = 0; T < 16; ++T)
#pragma unroll
        for (int i = 0; i < 4; ++i) if (!dry) ((GAS float*)Sout)[(size_t)(16 * T + 4 * fq + i) * RDV + dvcol] = S[T][i];
}
constexpr int AT_VB = 64 * VHD * 2, AT_KNB = 64 * NOPE * 2, AT_KRB = 64 * ROPE * 2;
constexpr int AT_V = 0, AT_KN = AT_V + 2 * AT_VB, AT_KR = AT_KN + 2 * AT_KNB, AT_RS = AT_KR + 2 * AT_KRB, AT_SCR = AT_RS + 2 * 256, AT_END = AT_SCR + NWAVES * 256;
static_assert(AT_END <= RING_BYTES, "attention LDS");
__device__ __forceinline__ int crow(int r, int hi) { return (r & 3) + 8 * (r >> 2) + 4 * hi; }
__device__ __forceinline__ int v_rd_base(int lane) { return ((lane & 3) << 3) | (((lane >> 2) & 3) << 6) | (((lane >> 4) & 1) << 5) | (((lane >> 5) & 1) << 8); }
constexpr int v_rd_off(int d0, int ks, int half) { return d0 * 512 + ks * 4096 + half * 2048; }
template <int OFF> __device__ __forceinline__ s16x4 tr_read(int vb) {
    s16x4 r; asm volatile("ds_read_b64_tr_b16 %0, %1 offset:%2" : "=&v"(r) : "v"(vb), "i"(OFF) : "memory"); return r;
}
template <int D0, int HF> __device__ __forceinline__ void pv_half(f32x16& od, int vb, bf16x8 pa0, bf16x8 pa1) {
    const s16x4 l0 = tr_read<v_rd_off(D0, 2 * HF, 0)>(vb), h0 = tr_read<v_rd_off(D0, 2 * HF, 1)>(vb), l1 = tr_read<v_rd_off(D0, 2 * HF + 1, 0)>(vb), h1 = tr_read<v_rd_off(D0, 2 * HF + 1, 1)>(vb);
    asm volatile("s_waitcnt lgkmcnt(0)" ::: "memory"); __builtin_amdgcn_sched_barrier(0);
    od = __builtin_amdgcn_mfma_f32_32x32x16_bf16(pa0, cat4(l0, h0), od, 0, 0, 0);
    od = __builtin_amdgcn_mfma_f32_32x32x16_bf16(pa1, cat4(l1, h1), od, 0, 0, 0);
}
template <int D0, int HF> __device__ __forceinline__ void pv_pair(f32x16& oa, f32x16& ob, int vb, bf16x8 pa0, bf16x8 pa1) {
    const s16x4 l0 = tr_read<v_rd_off(D0, 2 * HF, 0)>(vb), h0 = tr_read<v_rd_off(D0, 2 * HF, 1)>(vb), l1 = tr_read<v_rd_off(D0, 2 * HF + 1, 0)>(vb), h1 = tr_read<v_rd_off(D0, 2 * HF + 1, 1)>(vb);
    const s16x4 m0 = tr_read<v_rd_off(D0 + 1, 2 * HF, 0)>(vb), n0 = tr_read<v_rd_off(D0 + 1, 2 * HF, 1)>(vb), m1 = tr_read<v_rd_off(D0 + 1, 2 * HF + 1, 0)>(vb), n1 = tr_read<v_rd_off(D0 + 1, 2 * HF + 1, 1)>(vb);
    asm volatile("s_waitcnt lgkmcnt(4)" ::: "memory"); __builtin_amdgcn_sched_barrier(0);
    if (MK_ATTN_PRIO) __builtin_amdgcn_s_setprio(1);
    oa = __builtin_amdgcn_mfma_f32_32x32x16_bf16(pa0, cat4(l0, h0), oa, 0, 0, 0);
    oa = __builtin_amdgcn_mfma_f32_32x32x16_bf16(pa1, cat4(l1, h1), oa, 0, 0, 0);
    asm volatile("s_waitcnt lgkmcnt(0)" ::: "memory"); __builtin_amdgcn_sched_barrier(0);
    ob = __builtin_amdgcn_mfma_f32_32x32x16_bf16(pa0, cat4(m0, n0), ob, 0, 0, 0);
    ob = __builtin_amdgcn_mfma_f32_32x32x16_bf16(pa1, cat4(m1, n1), ob, 0, 0, 0);
    if (MK_ATTN_PRIO) __builtin_amdgcn_s_setprio(0);
}
struct VFrag2 { s16x4 l0, h0, l1, h1, m0, n0, m1, n1; };
template <int D0, int HF> __device__ __forceinline__ void v_fetch2(VFrag2& f, int vb) {
    f.l0 = tr_read<v_rd_off(D0, 2 * HF, 0)>(vb); f.h0 = tr_read<v_rd_off(D0, 2 * HF, 1)>(vb); f.l1 = tr_read<v_rd_off(D0, 2 * HF + 1, 0)>(vb); f.h1 = tr_read<v_rd_off(D0, 2 * HF + 1, 1)>(vb);
    f.m0 = tr_read<v_rd_off(D0 + 1, 2 * HF, 0)>(vb); f.n0 = tr_read<v_rd_off(D0 + 1, 2 * HF, 1)>(vb); f.m1 = tr_read<v_rd_off(D0 + 1, 2 * HF + 1, 0)>(vb); f.n1 = tr_read<v_rd_off(D0 + 1, 2 * HF + 1, 1)>(vb);
}
__device__ __forceinline__ void pv_mma2(f32x16& oa, f32x16& ob, const VFrag2& f, bf16x8 pa0, bf16x8 pa1) {
    oa = __builtin_amdgcn_mfma_f32_32x32x16_bf16(pa0, cat4(f.l0, f.h0), oa, 0, 0, 0);
    oa = __builtin_amdgcn_mfma_f32_32x32x16_bf16(pa1, cat4(f.l1, f.h1), oa, 0, 0, 0);
    ob = __builtin_amdgcn_mfma_f32_32x32x16_bf16(pa0, cat4(f.m0, f.n0), ob, 0, 0, 0);
    ob = __builtin_amdgcn_mfma_f32_32x32x16_bf16(pa1, cat4(f.m1, f.n1), ob, 0, 0, 0);
}
__device__ __forceinline__ void attn_unit(LAS unsigned char* lds, const bf16* Q, const bf16* KV, const bf16* KR, const float* RSs, const float* cosM, const float* sinM, const LAS float* gqk, bf16* Ob,
                                          int qrow0, int kvrow0, int NT, int h, int nact, int lim0, bool prompt, int tid, int dry) {
    const int wid = __builtin_amdgcn_readfirstlane(tid >> 6), lane = tid & 63, r32 = lane & 31, hi = lane >> 5;
    const bool active = wid < nact; const int limit = prompt ? lim0 + (wid >> 1) : lim0;
    const int rb = prompt ? wid : (wid & 1);
    LAS float* scrw = (LAS float*)(lds + AT_SCR + wid * 256); LAS float* li_l = scrw; LAS float* al_l = scrw + 32;
    float m_reg = -1e30f, l_reg = 0.f;
    bf16x8 qr[12];
    { const int qrow = qrow0 + (active ? rb * 32 + r32 : 0);
      const GAS bf16* Qw = (const GAS bf16*)Q + (size_t)qrow * QW + h * QKH + hi * 8;
#pragma unroll
      for (int d0 = 0; d0 < 12; ++d0) qr[d0] = *(const GAS bf16x8*)(Qw + d0 * 16);
#if MK_QFUSE
      const int pos = pos_of_token(qrow);
      int hi_q = hi; asm volatile("" : "+v"(hi_q));
      float ra[2][8], rb[2][8], ss = 0.f;
#pragma unroll
      for (int p = 0; p < 2; ++p) { const int j0 = p * 16 + hi_q * 8;
          const f32x4 c0 = *(const GAS f32x4*)(cosM + pos * 32 + j0), c1 = *(const GAS f32x4*)(cosM + pos * 32 + j0 + 4), s0 = *(const GAS f32x4*)(sinM + pos * 32 + j0), s1 = *(const GAS f32x4*)(sinM + pos * 32 + j0 + 4);
          const float cc[8] = {c0.x, c0.y, c0.z, c0.w, c1.x, c1.y, c1.z, c1.w}, sn[8] = {s0.x, s0.y, s0.z, s0.w, s1.x, s1.y, s1.z, s1.w};
          const v4u x1 = __builtin_bit_cast(v4u, qr[8 + p]), x2 = __builtin_bit_cast(v4u, qr[10 + p]);
          const float a[8] = {bflo(x1.x), bfhi(x1.x), bflo(x1.y), bfhi(x1.y), bflo(x1.z), bfhi(x1.z), bflo(x1.w), bfhi(x1.w)};
          const float b[8] = {bflo(x2.x), bfhi(x2.x), bflo(x2.y), bfhi(x2.y), bflo(x2.z), bfhi(x2.z), bflo(x2.w), bfhi(x2.w)};
#pragma unroll
          for (int e = 0; e < 8; ++e) { ra[p][e] = a[e] * cc[e] - b[e] * sn[e]; rb[p][e] = a[e] * sn[e] + b[e] * cc[e]; ss += ra[p][e] * ra[p][e] + rb[p][e] * rb[p][e]; } }
#pragma unroll
      for (int d0 = 0; d0 < 8; ++d0) { const v4u x = __builtin_bit_cast(v4u, qr[d0]);
          ss += (bflo(x.x) * bflo(x.x) + bfhi(x.x) * bfhi(x.x)) + (bflo(x.y) * bflo(x.y) + bfhi(x.y) * bfhi(x.y)) + (bflo(x.z) * bflo(x.z) + bfhi(x.z) * bfhi(x.z)) + (bflo(x.w) * bflo(x.w) + bfhi(x.w) * bfhi(x.w)); }
      { auto rr = __builtin_amdgcn_permlane32_swap(__float_as_uint(ss), __float_as_uint(ss), false, false); ss = __uint_as_float(rr[0]) + __uint_as_float(rr[1]); }
      const float rs = 1.0f / sqrtf(ss * (1.0f / QKH) + EPS);
#pragma unroll
      for (int d0 = 0; d0 < 8; ++d0) asm volatile("" : "+v"(qr[d0]));
#pragma unroll
      for (int d0 = 0; d0 < 12; ++d0) { const f32x4 g0 = *(const LAS f32x4*)(gqk + d0 * 16 + hi * 8), g1 = *(const LAS f32x4*)(gqk + d0 * 16 + hi * 8 + 4);
          float v[8];
          if (d0 < 8) { const v4u x = __builtin_bit_cast(v4u, qr[d0]); v[0] = bflo(x.x); v[1] = bfhi(x.x); v[2] = bflo(x.y); v[3] = bfhi(x.y); v[4] = bflo(x.z); v[5] = bfhi(x.z); v[6] = bflo(x.w); v[7] = bfhi(x.w); }
          else {
#pragma unroll
              for (int e = 0; e < 8; ++e) v[e] = d0 < 10 ? ra[d0 - 8][e] : rb[d0 - 10][e]; }
          v4u w; w.x = cvtpk(v[0] * rs * g0.x, v[1] * rs * g0.y); w.y = cvtpk(v[2] * rs * g0.z, v[3] * rs * g0.w); w.z = cvtpk(v[4] * rs * g1.x, v[5] * rs * g1.y); w.w = cvtpk(v[6] * rs * g1.z, v[7] * rs * g1.w);
          qr[d0] = __builtin_bit_cast(bf16x8, w); }
#endif
    }
    f32x16 o[4];
#pragma unroll
    for (int d = 0; d < 4; ++d)
#pragma unroll
        for (int r = 0; r < 16; ++r) o[d][r] = 0.f;
    const GAS unsigned char* kvb = (const GAS unsigned char*)KV + ((size_t)kvrow0 * KVW + h * 256) * 2;
    const GAS unsigned char* krb = (const GAS unsigned char*)KR + (size_t)kvrow0 * ROPE * 2;
#define AT_OFFV(i, ln) ([&]{ const int P = (wid + 8 * (i)) * 64 + (ln); const int sub = P >> 5, within = P & 31, kk = ((sub >> 2) << 3) | (within >> 2), k = (kk & ~0xC) | ((kk & 4) << 1) | ((kk & 8) >> 1), c = (sub & 3) * 32 + (within & 3) * 8; return (unsigned)(k * KVW + NOPE + c) * 2u; }())
#define AT_OFFKN(i, ln) ([&]{ const int P = (wid + 8 * (i)) * 64 + (ln); const int r = P >> 4, cpos = P & 15, c = cpos ^ (r & 15); return (unsigned)(r * KVW + 8 * c) * 2u; }())
#define AT_OFFKR(ln) ([&]{ const int P = wid * 64 + (ln), r = P >> 3, cpos = P & 7, c = cpos ^ ((r >> 1) & 7); return (unsigned)(r * ROPE + 8 * c) * 2u; }())
    const GAS float* rsb = (const GAS float*)RSs + (size_t)kvrow0 * MH + h;
#define AT_DMA(j, b) do { const size_t tk_ = (size_t)(j) * 64 * KVW * 2; int ln_ = lane; asm volatile("" : "+v"(ln_)); \
        _Pragma("unroll") for (int i = 0; i < 2; ++i) { \
            __builtin_amdgcn_global_load_lds((const GAS unsigned*)(kvb + tk_ + AT_OFFKN(i, ln_)), (LAS unsigned*)(lds + AT_KN + (b) * AT_KNB + (wid + 8 * i) * 1024), 16, 0, 0); \
            __builtin_amdgcn_global_load_lds((const GAS unsigned*)(kvb + tk_ + AT_OFFV(i, ln_)), (LAS unsigned*)(lds + AT_V + (b) * AT_VB + (wid + 8 * i) * 1024), 16, 0, 0); } \
        __builtin_amdgcn_global_load_lds((const GAS unsigned*)(krb + (size_t)(j) * 64 * ROPE * 2 + AT_OFFKR(ln_)), (LAS unsigned*)(lds + AT_KR + (b) * AT_KRB + wid * 1024), 16, 0, 0); \
        if (wid == 0) __builtin_amdgcn_global_load_lds((const GAS unsigned*)(rsb + ((size_t)(j) * 64 + ln_) * MH), (LAS unsigned*)(lds + AT_RS + (b) * 256), 4, 0, 0); } while (0)
    AT_DMA(0, 0); asm volatile("s_waitcnt vmcnt(0)" ::: "memory"); __syncthreads();
    for (int j = 0; j < NT; ++j) {
        const int cur = j & 1;
        if (j + 1 < NT && !(dry && MK_ATTN_DRYMODE == 4)) AT_DMA(j + 1, cur ^ 1);
        if (active && j <= limit && !(dry && MK_ATTN_DRYMODE == 1)) {
            if (MK_ATTN_DELAY && prompt && wid >= 4) __builtin_amdgcn_s_sleep(MK_ATTN_DELAY);
            const LAS unsigned char* Kn = lds + AT_KN + cur * AT_KNB; const LAS unsigned char* Kr = lds + AT_KR + cur * AT_KRB; const LAS unsigned char* Rt = lds + AT_RS + cur * 256;
            int lnv_ = lane; asm volatile("" : "+v"(lnv_)); const int vb = (int)(uintptr_t)(lds + AT_V) + v_rd_base(lnv_) + cur * AT_VB;
#define PK4(P, BASE, OUT) do { unsigned a0 = cvtpk(P[BASE + 0], P[BASE + 1]), a1 = cvtpk(P[BASE + 2], P[BASE + 3]);   \
    unsigned b0_ = cvtpk(P[BASE + 4], P[BASE + 5]), b1_ = cvtpk(P[BASE + 6], P[BASE + 7]);                              \
    auto r0 = __builtin_amdgcn_permlane32_swap(a0, b0_, false, false); auto r1 = __builtin_amdgcn_permlane32_swap(a1, b1_, false, false); \
    v4u w_ = {r0[0], r1[0], r0[1], r1[1]}; OUT = __builtin_bit_cast(bf16x8, w_); } while (0)
#define AT_HALF(HF) do { f32x16 p0; _Pragma("unroll") for (int r = 0; r < 16; ++r) p0[r] = 0.f; \
            const int krow = 32 * HF + r32, ksw = (krow & 15) << 4, kswr = ((krow >> 1) & 7) << 4;     \
            bf16x8 ka[4], kb[4], kc[4];     \
            _Pragma("unroll") for (int i = 0; i < 4; ++i) { ka[i] = *(const LAS bf16x8*)(Kn + krow * 256 + (((i * 16 + hi * 8) * 2) ^ ksw)); } \
            _Pragma("unroll") for (int i = 0; i < 4; ++i) { kb[i] = *(const LAS bf16x8*)(Kn + krow * 256 + ((((4 + i) * 16 + hi * 8) * 2) ^ ksw)); } \
            __builtin_amdgcn_sched_barrier(0); if (MK_ATTN_PRIO) __builtin_amdgcn_s_setprio(1); \
            _Pragma("unroll") for (int i = 0; i < 4; ++i) p0 = __builtin_amdgcn_mfma_f32_32x32x16_bf16(ka[i], qr[i], p0, 0, 0, 0); \
            _Pragma("unroll") for (int i = 0; i < 4; ++i) { kc[i] = *(const LAS bf16x8*)(Kr + krow * 128 + (((i * 16 + hi * 8) * 2) ^ kswr)); } \
            __builtin_amdgcn_sched_barrier(0); \
            _Pragma("unroll") for (int i = 0; i < 4; ++i) p0 = __builtin_amdgcn_mfma_f32_32x32x16_bf16(kb[i], qr[4 + i], p0, 0, 0, 0); \
            _Pragma("unroll") for (int i = 0; i < 4; ++i) p0 = __builtin_amdgcn_mfma_f32_32x32x16_bf16(kc[i], qr[8 + i], p0, 0, 0, 0); \
            if (MK_ATTN_PRIO) __builtin_amdgcn_s_setprio(0); \
            _Pragma("unroll") for (int g = 0; g < 4; ++g) { const f32x4 rs4 = *(const LAS f32x4*)(Rt + (32 * HF + 8 * g + 4 * hi) * 4); \
                p0[4 * g + 0] *= rs4[0]; p0[4 * g + 1] *= rs4[1]; p0[4 * g + 2] *= rs4[2]; p0[4 * g + 3] *= rs4[3]; } \
            float pmax = p0[0]; _Pragma("unroll") for (int r = 1; r < 16; ++r) pmax = fmaxf(pmax, p0[r]); \
            { auto rr = __builtin_amdgcn_permlane32_swap(__float_as_uint(pmax), __float_as_uint(pmax), false, false); pmax = fmaxf(__uint_as_float(rr[0]), __uint_as_float(rr[1])); } \
            const float mn = MK_ATTN_LAZY ? ((pmax > m_reg + 8.0f) ? pmax : m_reg) : fmaxf(m_reg, pmax);     \
            const float alpha = __builtin_amdgcn_exp2f(m_reg - mn); m_reg = mn; \
            float ps = 0.f; _Pragma("unroll") for (int r = 0; r < 16; ++r) { p0[r] = __builtin_amdgcn_exp2f(p0[r] - mn); ps += p0[r]; } \
            { auto rr = __builtin_amdgcn_permlane32_swap(__float_as_uint(ps), __float_as_uint(ps), false, false); ps = __uint_as_float(rr[0]) + __uint_as_float(rr[1]); } \
            l_reg = l_reg * alpha + ps; \
            if (__any(alpha < 1.f)) { if (hi == 0) al_l[r32] = alpha; asm volatile("s_waitcnt lgkmcnt(0)" ::: "memory"); \
                _Pragma("unroll") for (int r = 0; r < 16; ++r) { const float al = al_l[crow(r, hi)]; _Pragma("unroll") for (int d = 0; d < 4; ++d) o[d][r] *= al; } } \
            bf16x8 pa0, pa1; PK4(p0, 0, pa0); PK4(p0, 8, pa1); \
            pv_pair<0, HF>(o[0], o[1], vb, pa0, pa1); pv_pair<2, HF>(o[2], o[3], vb, pa0, pa1); } while (0)
            if (prompt || wid < 2) AT_HALF(0);
            __builtin_amdgcn_sched_barrier(0);
            if (prompt || wid >= 2) AT_HALF(1);
#undef PK4
#undef AT_HALF
        }
        asm volatile("s_waitcnt vmcnt(0)" ::: "memory");
        __syncthreads();
    }
#undef AT_DMA
#undef AT_OFFV
#undef AT_OFFKN
#undef AT_OFFKR
    if (!prompt) {
        LAS float* mo = (LAS float*)(lds + AT_V) + (wid & 1) * 4096 + lane;
        LAS float* pscr = (LAS float*)(lds + AT_SCR + (wid | 2) * 256);
        if (wid == 2 || wid == 3) {
#pragma unroll
            for (int d = 0; d < 4; ++d)
#pragma unroll
                for (int r = 0; r < 16; ++r) mo[(d * 16 + r) * 64] = o[d][r];
            if (hi == 0) { pscr[r32] = m_reg; pscr[32 + r32] = l_reg; } }
        asm volatile("s_waitcnt lgkmcnt(0)" ::: "memory"); __syncthreads();
        if (wid < 2) {
            const float m2 = pscr[r32], l2 = pscr[32 + r32];
            const float mn = fmaxf(m_reg, m2), a1 = __builtin_amdgcn_exp2f(m_reg - mn), a2 = __builtin_amdgcn_exp2f(m2 - mn);
            l_reg = l_reg * a1 + l2 * a2;
            if (hi == 0) { al_l[r32] = a1; li_l[r32] = a2; } asm volatile("s_waitcnt lgkmcnt(0)" ::: "memory");
#pragma unroll
            for (int r = 0; r < 16; ++r) { const float A1 = al_l[crow(r, hi)], A2 = li_l[crow(r, hi)];
#pragma unroll
                for (int d = 0; d < 4; ++d) o[d][r] = o[d][r] * A1 + mo[(d * 16 + r) * 64] * A2; }
            asm volatile("s_waitcnt lgkmcnt(0)" ::: "memory");
        }
    }
    if ((prompt ? active : wid < 2) && !dry) {
        if (hi == 0) li_l[r32] = l_reg; asm volatile("s_waitcnt lgkmcnt(0)" ::: "memory");
        int r32b = r32, hib = hi; asm volatile("" : "+v"(r32b), "+v"(hib));
        GAS bf16* Ow = (GAS bf16*)Ob + (size_t)(qrow0 + wid * 32) * DM + h * VHD + r32b;
#pragma unroll
        for (int r = 0; r < 16; ++r) { const int orow = crow(r, hib); const float rl = __builtin_amdgcn_rcpf(li_l[orow]);
#pragma unroll
            for (int d0 = 0; d0 < 4; ++d0) Ow[(size_t)orow * DM + d0 * 32] = (bf16)(cvtpk(o[d0][r] * rl, 0.f) & 0xffffu); }
    }
    __syncthreads();
}
__device__ __forceinline__ void attn_phase(const Args& A, const Frame& F) {
    unsigned char* ws = A.ws;
    const bf16* Q = (const bf16*)(ws + WS_Q); const bf16* KV = (const bf16*)(ws + WS_BIG); const bf16* KR = (const bf16*)(ws + WS_KRALL);
    bf16* Ob = (bf16*)(ws + WS_O);
    LAS float* gqk = (LAS float*)(F.lds + LDSCTL_OFF + 1024);
    if (MK_QFUSE) { if (F.tid < QKH) gqk[F.tid] = ((const GAS float*)(ws + WS_GQK))[F.tid]; __syncthreads(); }
    for (int u0 = blockIdx.x; u0 < 1024 + 512; u0 += F.G) {
        int u = u0;
        if (F.G == 256 && MK_ATTN_IL && ((blockIdx.x >> 5) & 1)) { const int it = u0 >> 8; u = ((it + 4) % 6) * 256 + (u0 & 255); }
        int qrow0, kvrow0, NT, h, nact, lim0; bool prompt;
        if (u < 1024) {
            const int rd = u >> 8, c = u & 255, x = c & 7, k = c >> 3, m = k >> 2, i = k & 3, bh = (rd >> 1) * 64 + x * 8 + m, b = bh >> 4;
            const int qb = (rd & 1) ? i : 7 - i;
            h = bh & 15; qrow0 = b * SEQ + qb * 256; kvrow0 = b * SEQ; NT = 4 * qb + 4; nact = 8; lim0 = 4 * qb; prompt = true;
        } else { const int v = u - 1024, b = v >> 4; h = v & 15; qrow0 = MP + b * DSEQ; kvrow0 = MP + b * KVT; NT = KVT / 64; nact = 4; lim0 = NT - 1; prompt = false; }
        attn_unit(F.lds, Q, KV, KR, (const float*)(ws + WS_RS), (const float*)(ws + WS_COSM), (const float*)(ws + WS_SINM), gqk, Ob, qrow0, kvrow0, NT, h, nact, lim0, prompt, F.wave * 64 + lane_id_asm(), A.dry);
    }
}
__device__ __forceinline__ void scan_phase2(const Args& A, const Frame& F) {
    bf16* QKVG = (bf16*)(A.ws + WS_BIG);
    for (int u0 = blockIdx.x; u0 < 256 + 1024; u0 += F.G) {
        int u = u0;
        if (F.G == 256 && MK_SCAN_IL && ((blockIdx.x >> 3) & 1)) { const int it = u0 >> 8; u = ((it + 1) % 5) * 256 + (u0 & 255); }
        const bool pr = u < 256; const int v = pr ? u : u - 256, b = v >> 5, h = (v >> 2) & 7, jv = v & 3;
        const size_t so = (size_t)(b * RH + h) * RDK * RDV;
        scan_unit(F.lds, QKVG, pr ? (size_t)b * SEQ : (size_t)MP + (size_t)b * DSEQ, pr ? SEQ / 64 : 1, h, jv, pr ? nullptr : A.in[I_STATE] + so, A.out + (pr ? OUT_RETP : OUT_RETS) + so, F.tid, A.dry);
    }
}

#define CAS __attribute__((address_space(4)))
__device__ __forceinline__ Args load_args(const CAS Args* p) { Args a;
#pragma unroll
    for (int i = 0; i < 25; ++i) a.in[i] = p->in[i];
    a.out = p->out; a.ws = p->ws; a.ph_lo = p->ph_lo; a.ph_hi = p->ph_hi; a.dry = p->dry; a.pad = 0; return a; }
__global__ void __launch_bounds__(NWAVES * 64, 2) yoco_fwd(Args args) {
    extern __shared__ __attribute__((aligned(16))) unsigned char lds[];
    Frame F0;
    F0.lds = (LAS unsigned char*)lds;
    const int wave0 = __builtin_amdgcn_readfirstlane((int)threadIdx.x >> 6);
    F0.G = gridDim.x; { const int bx = blockIdx.x; F0.vcu = (F0.G % 8 == 0) ? (bx % 8) * (F0.G / 8) + bx / 8 : bx; }
    unsigned char* ws0 = args.ws;
    for (int u = threadIdx.x; u < (LDS_BYTES - LDSCTL_OFF) / 4; u += NWAVES * 64) ((LAS unsigned*)(F0.lds + LDSCTL_OFF))[u] = 0u;
    __syncthreads();
    XcdBarrier bar; bar.bar = (unsigned*)(ws0 + WS_CTL) + CW_BAR; bar.x = 0; bar.st = nullptr;
#if MK_ONE_LAUNCH
    bar = xcd_barrier_post((unsigned*)(ws0 + WS_CTL) + CW_BAR, (volatile LAS unsigned*)(F0.lds + MISC_OFF) + 8);
#endif
    const int lo = args.ph_lo, hi = args.ph_hi;
    int pc = 0;
#if MK_SCRAMBLE
#define MK_CID ((int)((blockIdx.x * 97u) % gridDim.x))
#else
#define MK_CID ((int)blockIdx.x)
#endif
#define CLK_T0() do { if (MK_CLKPH >= 0 && pc == MK_CLKPH && blockIdx.x == 0 && threadIdx.x == 0) { *(volatile LAS unsigned long long*)(F0.lds + MISC_OFF + 72) = wall_clock64(); *(volatile LAS unsigned long long*)(F0.lds + MISC_OFF + 80) = clock64(); } } while (0)
#define CLK_T1() do { if (MK_CLKPH >= 0 && pc == MK_CLKPH && blockIdx.x == 0 && threadIdx.x == 0) { const unsigned long long w1 = wall_clock64(), c1 = clock64(); \
        const float mhz = (float)(c1 - *(volatile LAS unsigned long long*)(F0.lds + MISC_OFF + 80)) / (float)(w1 - *(volatile LAS unsigned long long*)(F0.lds + MISC_OFF + 72)) * 100.0f; \
        *(volatile LAS float*)(F0.lds + MISC_OFF + 88) = MK_CLKMODE == 0 ? 100.0f * __builtin_rintf(mhz * 0.01f) : 100.0f * __builtin_rintf((float)(c1 - *(volatile LAS unsigned long long*)(F0.lds + MISC_OFF + 80)) * (1.0f / (13.0f * 32.0f)) * 0.01f); } } while (0)
#define BARW_T0() do { if (MK_BARWAIT && ((MK_BARMASK >> pc) & 1u) && blockIdx.x == MK_BARWAIT_BLK && threadIdx.x == 0) *(volatile LAS unsigned long long*)(F0.lds + MISC_OFF + 96) = wall_clock64(); } while (0)
#define BARW_T1() do { if (MK_BARWAIT && ((MK_BARMASK >> pc) & 1u) && blockIdx.x == MK_BARWAIT_BLK && threadIdx.x == 0) *(volatile LAS unsigned long long*)(F0.lds + MISC_OFF + 104) += wall_clock64() - *(volatile LAS unsigned long long*)(F0.lds + MISC_OFF + 96); } while (0)
#define SPIN_T0() do { if (((MK_SPINMASK >> pc) & 1u) && blockIdx.x == 0 && (wave0 == 0 && lane_id_asm() == 0)) { *(volatile LAS unsigned long long*)(F0.lds + MISC_OFF + 64) = wall_clock64(); *(volatile LAS unsigned long long*)(F0.lds + MISC_OFF + 112) = clock64(); } } while (0)
#define SPIN_WAIT() do { if (((MK_SPINMASK >> pc) & 1u) && blockIdx.x == 0) { if ((wave0 == 0 && lane_id_asm() == 0)) { const unsigned long long t0_ = *(volatile LAS unsigned long long*)(F0.lds + MISC_OFF + 64), t1_ = wall_clock64(); \
        const unsigned long long d_ = MK_SPINCLK ? (clock64() - *(volatile LAS unsigned long long*)(F0.lds + MISC_OFF + 112)) / 24 : (t1_ - t0_);     \
        if (MK_SPINEND) *(volatile LAS unsigned long long*)(F0.lds + MISC_OFF + 120) += d_; else while (wall_clock64() - t1_ < d_ * MK_SPINMUL) __builtin_amdgcn_s_sleep(8); } __syncthreads(); } } while (0)
#define PH_BEGIN if (pc >= lo && pc < hi) { SPIN_T0(); CLK_T0(); Frame F; { int t_ = wave0 * 64 + lane_id_asm(); F.lds = F0.lds; F.tid = t_; F.lane = t_ & 63; F.wave = __builtin_amdgcn_readfirstlane(t_ >> 6); F.G = F0.G; F.vcu = F0.vcu; } \
    const CAS Args* ap_ = (const CAS Args*)__builtin_amdgcn_kernarg_segment_ptr(); asm volatile("" : "+s"(ap_)); const Args args = load_args(ap_); \
    unsigned char* ws = args.ws; float* hres = args.out; \
    bf16* XN = (bf16*)(ws + WS_XN); bf16* HID = (bf16*)(ws + WS_BIG); bf16* QKVG = (bf16*)(ws + WS_BIG); (void)XN; (void)HID; (void)QKVG; (void)hres;
#if MK_ONE_LAUNCH
#define PH_END if (pc + 1 < hi) { BARW_T0(); xcd_barrier(bar, wave0); BARW_T1(); if (MK_DBLBAR) xcd_barrier(bar, wave0); } CLK_T1(); SPIN_WAIT(); } ++pc;
#else
#define PH_END } ++pc;
#endif
    typedef pg8::StaticOrder SO;
#if MK_NFOLD == 2 && MK_HBF && MK_TQ
    typedef pg8::TqOrder ResOrder;
#define RES_TQ MK_TQ
#else
    typedef pg8::SplitTailOrder ResOrder;
#define RES_TQ 0
#endif
#if MK_NFOLD == 2 && MK_HBF
    typedef EpiResid3 EpiRes;
#elif MK_NFOLD == 2
    typedef EpiResid2 EpiRes;
#else
    typedef EpiResid EpiRes;
#endif
#define SSQH(i) ((float*)(ws + WS_SSQH + (size_t)(i) * SSQH_STRIDE))
#if MK_HALFTAIL
    typedef pg8::HalfTailOrder FfnInOrder;
#else
    typedef pg8::StaticOrder FfnInOrder;
#endif

    PH_BEGIN
#ifndef DIS_PRO
 p0_prologue(args, F);
#endif
 PH_END

    for (int l = 0; l < 2; ++l) {
        for (int f = 0; f < 2; ++f) {
            if (MK_NFOLD < 2 && l + f > 0 && !(l == 1 && f == 0)) { PH_BEGIN
                norm_phase(F, hres, (f == 0 ? args.in[I_F1N] : args.in[I_F2N]) + l * DM, XN, f == 1 ? (const float*)(ws + WS_BIG) : nullptr, (l == 0) ? RIN / 2 : DM, args.dry, nullptr, MK_NFOLD ? SSQH(l == 0 ? 2 : 5) : nullptr); PH_END }
            PH_BEGIN {
                const size_t wo = l == 0 ? (f == 0 ? WS_WIN00 : WS_WIN01) : (f == 0 ? WS_WIN10 : WS_WIN11);
                pg8::Gemm g{XN, (const bf16*)(ws + wo), MT, 2 * DFF, DM, DM, 0, 0}; FfnInOrder S; S.init(MT, 2 * DFF, F.G, MK_CID); S.xt = MK_XTAIL && MK_DEFER == 2;
                EpiSwiGLU E{HID, DFF, MK_NFOLD ? SSQH(l == 0 ? (f == 0 ? 0 : 2) : (f == 0 ? 3 : 5)) : nullptr, F.lds + RING_OFF};
                pg8::gemm_phase<EpiSwiGLU, FfnInOrder, MK_ALIGN_SWIGLU, MK_SP2>(F.lds + RING_OFF, g, S, E, F.tid);
                conv_deferred(args, F, l == 0 ? (f == 0 ? 0 : 2) : (f == 0 ? 3 : (MK_DEFER == 2 ? 5 : 9))); } PH_END
            PH_BEGIN {
                const size_t wo = l == 0 ? (f == 0 ? WS_WOUT00 : WS_WOUT01) : (f == 0 ? WS_WOUT10 : WS_WOUT11);
                pg8::Gemm g{HID, (const bf16*)(ws + wo), MT, DM, DFF, DFF, MK_BLK, MK_BLK}; ResOrder S;
#if MK_NFOLD == 2 && MK_HBF && MK_TQ
                S.init(MT, DM, F.G, MK_CID);
#else
                S.init(DFF, F.G, MK_CID);
#endif
                const bool first = (l + f == 0);
#if MK_NFOLD == 2 && MK_HBF
                const bool lastg = (l == 1 && f == 1);
                EpiResid3 E{lastg ? hres : nullptr, DM, 0.5f, (float*)(ws + WS_PART), DM, first ? args.in[I_XP] : nullptr, first ? args.in[I_XS] : nullptr,
                            XN, lastg ? nullptr : SSQH(l == 0 ? (f == 0 ? 1 : 3) : 4), (LAS float*)(F.lds + LDSCTL_OFF + 1024)};
#elif MK_NFOLD == 2
                const bool lastg = (l == 1 && f == 1);
                EpiResid2 E{hres, DM, 0.5f, (float*)(ws + WS_PART), DM, first ? args.in[I_XP] : hres, first ? args.in[I_XS] : hres + (size_t)MP * DM,
                            lastg ? nullptr : XN, lastg ? nullptr : SSQH(l == 0 ? (f == 0 ? 1 : 3) : 4), (unsigned*)(ws + WS_FIXCNT) + (l * 2 + f) * 64, (LAS float*)(F.lds + LDSCTL_OFF + 1024)};
#else
                EpiResid E{hres, DM, args.dry ? 0.f : 0.5f, (float*)(ws + WS_PART), DM, first ? args.in[I_XP] : hres, first ? args.in[I_XS] : hres + (size_t)MP * DM};
#endif
                if (MK_STAGGER && ((blockIdx.x >> 3) & 3)) { const unsigned long long t0_ = wall_clock64(), d_ = (unsigned long long)(((blockIdx.x >> 3) & 3) * MK_STAGGER); while (wall_clock64() - t0_ < d_) __builtin_amdgcn_s_sleep(4); }
                pg8::gemm_phase<EpiRes, ResOrder, true, MK_SP2, RES_TQ>(F.lds + RING_OFF, g, S, E, F.tid); } PH_END
            if (MK_NFOLD == 2 && !RES_TQ && !(l == 1 && f == 1)) { PH_BEGIN
                if (MK_HBF) tail_fix_phase_b(F, XN, nullptr, (const float*)(ws + WS_PART), DM, (l + f == 0) ? args.in[I_XS] : nullptr, SSQH(l == 0 ? (f == 0 ? 1 : 3) : 4));
                else tail_fix_phase(F, hres, XN, (const float*)(ws + WS_PART), DM, (l + f == 0) ? args.in[I_XS] : nullptr, SSQH(l == 0 ? (f == 0 ? 1 : 3) : 4)); PH_END }
            if (f == 0) {
                if (MK_NFOLD < 2) { PH_BEGIN norm_phase(F, hres, args.in[I_MIXN] + l * DM, XN, (const float*)(ws + WS_PART), DM, args.dry, l == 0 ? args.in[I_XS] : nullptr, MK_NFOLD ? SSQH(l == 0 ? 1 : 4) : nullptr); PH_END }
                if (l == 0) {
                    PH_BEGIN {
                        pg8::Gemm g{XN, (const bf16*)(ws + WS_WRIN), MT, RIN, DM, DM, 0, 0}; FfnInOrder S; S.init(MT, RIN, F.G, MK_CID); S.xt = MK_XTAIL && MK_DEFER == 2;
                        EpiRet E{QKVG, RIN, (const float*)(ws + WS_COSR), (const float*)(ws + WS_SINR), MK_NFOLD ? SSQH(1) : nullptr, F.lds + RING_OFF};
                        pg8::gemm_phase<EpiRet, FfnInOrder, true, MK_SP2>(F.lds + RING_OFF, g, S, E, F.tid);
                        conv_deferred(args, F, 1); } PH_END
                    PH_BEGIN
#ifndef DIS_SCAN
 scan_phase2(args, F);
#endif
 PH_END
                    PH_BEGIN gn_gate_phase(args, F); PH_END
                    PH_BEGIN {
                        pg8::Gemm g{QKVG + 4096, (const bf16*)(ws + WS_WROUT), MT, DM, RHV, RIN, 0, 0}; ResOrder S;
#if MK_NFOLD == 2 && MK_HBF && MK_TQ
                        S.init(MT, DM, F.G, MK_CID);
#else
                        S.init(RHV, F.G, MK_CID);
#endif
#if MK_NFOLD == 2 && MK_HBF
                        EpiResid3 E{nullptr, DM, 1.0f, (float*)(ws + WS_BIG), RIN / 2, nullptr, nullptr, XN, SSQH(2), (LAS float*)(F.lds + LDSCTL_OFF + 1024)};
#elif MK_NFOLD == 2
                        EpiResid2 E{hres, DM, 1.0f, (float*)(ws + WS_BIG), RIN / 2, hres, hres + (size_t)MP * DM, XN, SSQH(2), (unsigned*)(ws + WS_FIXCNT) + 4 * 64, (LAS float*)(F.lds + LDSCTL_OFF + 1024)};
#else
                        EpiResid E{hres, DM, args.dry ? 0.f : 1.0f, (float*)(ws + WS_BIG), RIN / 2, hres, hres + (size_t)MP * DM};
#endif
                        if (MK_STAGGER && ((blockIdx.x >> 3) & 3)) { const unsigned long long t0_ = wall_clock64(), d_ = (unsigned long long)(((blockIdx.x >> 3) & 3) * MK_STAGGER); while (wall_clock64() - t0_ < d_) __builtin_amdgcn_s_sleep(4); }
                pg8::gemm_phase<EpiRes, ResOrder, true, MK_SP2, RES_TQ>(F.lds + RING_OFF, g, S, E, F.tid); } PH_END
                    if (MK_NFOLD == 2 && !RES_TQ) { PH_BEGIN if (MK_HBF) tail_fix_phase_b(F, XN, nullptr, (const float*)(ws + WS_BIG), RIN / 2, nullptr, SSQH(2)); else tail_fix_phase(F, hres, XN, (const float*)(ws + WS_BIG), RIN / 2, nullptr, SSQH(2)); PH_END }
                } else {
#if MK_QLFUSE
                    PH_BEGIN {
                        pg8::Gemm g{XN, (const bf16*)(ws + WS_WDQ), MT, QLR, DM, DM, 0, 0}; SO S; S.init(MT, QLR, F.G, MK_CID); S.xt = MK_XTAIL && MK_DEFER == 2;
                        EpiQlat E{(bf16*)(ws + WS_QLN), QLR, (float*)(ws + WS_QSSQ), (LAS float*)(F.lds + LDSCTL_OFF + 1024), MK_NFOLD ? SSQH(4) : nullptr, F.lds + RING_OFF};
                        pg8::gemm_phase<EpiQlat, SO, true, MK_SP2>(F.lds + RING_OFF, g, S, E, F.tid);
                        conv_deferred(args, F, 4); } PH_END
#else
                    PH_BEGIN {
                        pg8::Gemm g{XN, (const bf16*)(ws + WS_WDQ), MT, QLR, DM, DM, 0, 0}; SO S; S.init(MT, QLR, F.G, MK_CID);
                        EpiF32 E{(float*)(ws + WS_SMALL), QLR};
                        pg8::gemm_phase<EpiF32, SO, true, MK_SP2>(F.lds + RING_OFF, g, S, E, F.tid); } PH_END
                    PH_BEGIN qlat_norm_phase(args, F); PH_END
#endif
                    PH_BEGIN {
                        if (MK_STAGKV && ((blockIdx.x >> 3) & 1)) { const unsigned long long t0_ = wall_clock64(); while (wall_clock64() - t0_ < (unsigned long long)MK_STAGKV) __builtin_amdgcn_s_sleep(4); }
                        { pg8::Gemm g{(const bf16*)(ws + WS_QLN), (const bf16*)(ws + WS_WUQ), MT, QW, QLR, QLR, 0, 0}; SO S; S.init(MT, QW, F.G, MK_CID);
#if MK_QLFUSE
                          EpiQraw E{(bf16*)(ws + WS_Q), QW, (const float*)(ws + WS_QSSQ)};
                          pg8::gemm_phase<EpiQraw, SO, true, MK_SP2>(F.lds + RING_OFF, g, S, E, F.tid); }
#else
                          EpiBf16 E{(bf16*)(ws + WS_Q), QW};
                          pg8::gemm_phase<EpiBf16, SO, true, MK_SP2>(F.lds + RING_OFF, g, S, E, F.tid); }
#endif
                        { pg8::Gemm g{(const bf16*)(ws + WS_CALL), (const bf16*)(ws + WS_WUKV), KVROWS, KVW, KVL, KVL, 0, 0}; SO S; S.init(KVROWS, KVW, F.G, (MK_CID + (F.G == 256 ? 160 : 0)) % F.G);
                          EpiKV E{(bf16*)(ws + WS_BIG), KVW, (float*)(ws + WS_RS), (const float*)(ws + WS_SSQKR), (LAS float*)(F.lds + LDSCTL_OFF + 1024)};
                          pg8::gemm_phase<EpiKV, SO, true, MK_SP2>(F.lds + RING_OFF, g, S, E, F.tid); } } PH_END
                    if (!MK_QFUSE) { PH_BEGIN qfin_phase(args, F); PH_END }
                    PH_BEGIN
#ifndef DIS_ATTN
 attn_phase(args, F);
#endif
 PH_END
                    PH_BEGIN {
                        pg8::Gemm g{(const bf16*)(ws + WS_O), (const bf16*)(ws + WS_WO), MT, DM, DM, DM, 0, 0}; ResOrder S;
#if MK_NFOLD == 2 && MK_HBF && MK_TQ
                        S.init(MT, DM, F.G, MK_CID);
#else
                        S.init(DM, F.G, MK_CID);
#endif
#if MK_NFOLD == 2 && MK_HBF
                        EpiResid3 E{nullptr, DM, 1.0f, (float*)(ws + WS_BIG), DM, nullptr, nullptr, XN, SSQH(5), (LAS float*)(F.lds + LDSCTL_OFF + 1024)};
#elif MK_NFOLD == 2
                        EpiResid2 E{hres, DM, 1.0f, (float*)(ws + WS_BIG), DM, hres, hres + (size_t)MP * DM, XN, SSQH(5), (unsigned*)(ws + WS_FIXCNT) + 5 * 64, (LAS float*)(F.lds + LDSCTL_OFF + 1024)};
#else
                        EpiResid E{hres, DM, args.dry ? 0.f : 1.0f, (float*)(ws + WS_BIG), DM, hres, hres + (size_t)MP * DM};
#endif
                        if (MK_STAGGER && ((blockIdx.x >> 3) & 3)) { const unsigned long long t0_ = wall_clock64(), d_ = (unsigned long long)(((blockIdx.x >> 3) & 3) * MK_STAGGER); while (wall_clock64() - t0_ < d_) __builtin_amdgcn_s_sleep(4); }
                pg8::gemm_phase<EpiRes, ResOrder, true, MK_SP2, RES_TQ>(F.lds + RING_OFF, g, S, E, F.tid); } PH_END
                    if (MK_NFOLD == 2 && !RES_TQ) { PH_BEGIN if (MK_HBF) tail_fix_phase_b(F, XN, nullptr, (const float*)(ws + WS_BIG), DM, nullptr, SSQH(5)); else tail_fix_phase(F, hres, XN, (const float*)(ws + WS_BIG), DM, nullptr, SSQH(5)); PH_END }
                }
            }
        }
        if (l == 0) {
            if (MK_NFOLD < 2) { PH_BEGIN norm_phase(F, hres, args.in[I_KVN], XN, (const float*)(ws + WS_PART), DM, args.dry, nullptr, MK_NFOLD ? SSQH(3) : nullptr); PH_END }
            PH_BEGIN {
                pg8::Gemm g{XN, (const bf16*)(ws + WS_WDKV), MT, DKVP, DM, DM, 0, 0}; SO S; S.init(MT, DKVP, F.G, MK_CID);
                EpiF32 E{(float*)(ws + WS_SMALL), DKVP};
                pg8::gemm_phase<EpiF32, SO, true, MK_SP2>(F.lds + RING_OFF, g, S, E, F.tid); } PH_END
            PH_BEGIN latent_phase(args, F); PH_END
        }
    }
    if (!RES_TQ) { PH_BEGIN if (MK_NFOLD == 2 && MK_HBF) tail_fix_phase_b(F, XN, hres, (const float*)(ws + WS_PART), DM, nullptr, nullptr); else fixup_phase(F, hres, (const float*)(ws + WS_PART), DM, args.dry); PH_END }
#undef PH_BEGIN
#undef PH_END
    if (MK_SPINEND && MK_SPINMASK && blockIdx.x == 0) { if (wave0 == 0 && lane_id_asm() == 0) { const unsigned long long d_ = *(volatile LAS unsigned long long*)(F0.lds + MISC_OFF + 120) * MK_SPINMUL, t1_ = wall_clock64(); while (wall_clock64() - t1_ < d_) __builtin_amdgcn_s_sleep(8); } __syncthreads(); }
    if (MK_BARWAIT && blockIdx.x == MK_BARWAIT_BLK) { if (threadIdx.x == 0) { const unsigned long long d_ = *(volatile LAS unsigned long long*)(F0.lds + MISC_OFF + 104) * MK_SPINMUL, t1_ = wall_clock64(); while (wall_clock64() - t1_ < d_) __builtin_amdgcn_s_sleep(8); } __syncthreads(); }
    if (MK_CLKPH >= 0 && blockIdx.x == 0 && threadIdx.x == 0) args.out[0] = *(volatile LAS float*)(F0.lds + MISC_OFF + 88);
}
constexpr int N_PHASES = 1 + (2 + 1 + 4 + 3 + 3) + (2 + 1 + 6 + 3) + 1 - (MK_QFUSE ? 1 : 0) - (MK_QLFUSE ? 1 : 0)  - ((MK_NFOLD == 2 && MK_HBF && MK_TQ) ? 6 : 0);

#if defined(MK_DEBUG)
constexpr size_t WS_DBG = 985 * MiB;
constexpr size_t WS_DBG_VS = WS_DBG, WS_DBG_VP = WS_DBG + 16 * MiB, WS_DBG_EY = WS_DBG + 20 * MiB, WS_DBG_H = WS_DBG + 21 * MiB, WS_DBG_Q = WS_DBG + 22 * MiB;
constexpr int DBG_ACC = 8192;
__device__ __forceinline__ float dbf(const bf16* p, size_t i) { return __uint_as_float((unsigned)p[i] << 16); }
__device__ __forceinline__ void dacc(unsigned char* ws, int k, float got, float exp) { float* a = (float*)(ws + WS_CTL) + DBG_ACC; atomicAdd(&a[2 * k], (got - exp) * (got - exp)); atomicAdd(&a[2 * k + 1], exp * exp); }
__device__ __forceinline__ unsigned dhash(unsigned x) { x ^= x >> 16; x *= 0x7feb352dU; x ^= x >> 15; x *= 0x846ca68bU; x ^= x >> 16; return x; }
__device__ __forceinline__ float dsilu(float a) { return a / (1.0f + __builtin_amdgcn_exp2f(-1.4426950408889634f * a)); }
__device__ __forceinline__ void dsincos(int pos, int j, int half, float& sn, float& cs) { const float inv = __builtin_amdgcn_exp2f(-(float)j / (float)half * 13.287712379549449f); sincos_d((double)pos * (double)inv, sn, cs); }
__device__ __forceinline__ int dpos(int tok) { return tok < MP ? (tok & (SEQ - 1)) : PAST + (tok & 63); }
__device__ __forceinline__ float dgamma_lg2(int h) { return lg2gamma(h); }

__global__ void dbg_k0(Args A) { const int s = blockIdx.x * blockDim.x + threadIdx.x; unsigned char* ws = A.ws;
    const int row = dhash(s) % MT, j = dhash(s + 77777) % DFF; const bf16* XN = (const bf16*)(ws + WS_XN); const float* W = A.in[I_F1IN];
    float a = 0.f, b = 0.f; for (int k = 0; k < DM; ++k) { const float x = dbf(XN, (size_t)row * DM + k); a += x * W[(size_t)k * 2 * DFF + j]; b += x * W[(size_t)k * 2 * DFF + DFF + j]; }
    dacc(ws, 0, dbf((const bf16*)(ws + WS_BIG), (size_t)row * DFF + j), dsilu(a) * b); }
__global__ void dbg_k1(Args A) { const int s = blockIdx.x * blockDim.x + threadIdx.x; unsigned char* ws = A.ws;
    const int row = dhash(s) % MT, c = dhash(s + 1234567) % DM; const bf16* HID = (const bf16*)(ws + WS_BIG); const float* W = A.in[I_F1OUT];
    float a = 0.f; for (int k = 0; k < DFF; ++k) a += dbf(HID, (size_t)row * DFF + k) * W[(size_t)k * DM + c];
    const float x = row < MP ? A.in[I_XP][(size_t)row * DM + c] : A.in[I_XS][(size_t)(row - MP) * DM + c];
    dacc(ws, 1, A.out[(size_t)row * DM + c] - x, 0.5f * a); }
__global__ void dbg_k2(Args A) { const int s = blockIdx.x * blockDim.x + threadIdx.x; unsigned char* ws = A.ws;
    const bf16* XN = (const bf16*)(ws + WS_XN); const bf16* QK = (const bf16*)(ws + WS_BIG); const float* W = A.in[I_RIN];
    const int row = dhash(s) % MT, col = dhash(s + 424242) % RIN; float exp;
    if (col < 4096) { const int h = (col >> 8) & 7, d = col & 255, j = d & 127, c1 = (col & ~255) + j, c2 = c1 + 128; float x1 = 0.f, x2 = 0.f;
        for (int k = 0; k < DM; ++k) { const float x = dbf(XN, (size_t)row * DM + k); x1 += x * W[(size_t)k * RIN + c1]; x2 += x * W[(size_t)k * RIN + c2]; }
        float sn, cs; dsincos(dpos(row), j, 128, sn, cs);
        const float r = d < 128 ? x1 * cs - x2 * sn : x1 * sn + x2 * cs; const float e = (float)((row & 63) + 1) * dgamma_lg2(h);
        exp = col < 2048 ? r * __builtin_amdgcn_exp2f(e) * 0.0625f : r * __builtin_amdgcn_exp2f(-e);
    } else { float a = 0.f; for (int k = 0; k < DM; ++k) a += dbf(XN, (size_t)row * DM + k) * W[(size_t)k * RIN + col]; exp = col < 8192 ? a : dsilu(a); }
    dacc(ws, 2, dbf(QK, (size_t)row * RIN + col), exp); }
__global__ void dbg_snapv(Args A) { unsigned char* ws = A.ws; const bf16* QK = (const bf16*)(ws + WS_BIG);
    for (size_t i = (size_t)blockIdx.x * blockDim.x + threadIdx.x; i < (size_t)MS * 4096; i += (size_t)gridDim.x * blockDim.x) { const size_t r = i >> 12, c = i & 4095; ((bf16*)(ws + WS_DBG_VS))[i] = QK[(MP + r) * RIN + 4096 + c]; }
    for (size_t i = (size_t)blockIdx.x * blockDim.x + threadIdx.x; i < (size_t)NBP * 64 * 4096; i += (size_t)gridDim.x * blockDim.x) { const size_t r = i >> 12, c = i & 4095, b = r >> 6, t = r & 63; ((bf16*)(ws + WS_DBG_VP))[i] = QK[(b * SEQ + t) * RIN + 4096 + c]; } }
__global__ void dbg_k3(Args A) { const int s = blockIdx.x * blockDim.x + threadIdx.x; unsigned char* ws = A.ws; const bf16* QK = (const bf16*)(ws + WS_BIG);
    const bool smp = (s & 1) != 0; const int h = dhash(s) & 7, dv = dhash(s + 999) & 511, t = dhash(s + 5555) & 63;
    const int b = smp ? (dhash(s + 31337) & 31) : (dhash(s + 31337) & 7); const size_t tok0 = smp ? (size_t)MP + b * 64 : (size_t)b * SEQ;
    const bf16* V = smp ? (const bf16*)(ws + WS_DBG_VS) + (size_t)b * 64 * 4096 : (const bf16*)(ws + WS_DBG_VP) + (size_t)b * 64 * 4096;
    float o = 0.f;
    for (int sidx = 0; sidx <= t; ++sidx) { float qk = 0.f; for (int d = 0; d < 256; ++d) qk += dbf(QK, (tok0 + t) * RIN + h * 256 + d) * dbf(QK, (tok0 + sidx) * RIN + 2048 + h * 256 + d);
        o += qk * dbf(V, (size_t)sidx * 4096 + h * 512 + dv); }
    if (smp) { const float* S = A.in[I_STATE] + (size_t)(b * RH + h) * RDK * RDV; for (int d = 0; d < 256; ++d) o += dbf(QK, (tok0 + t) * RIN + h * 256 + d) * S[(size_t)d * RDV + dv]; }
    dacc(ws, 3, dbf(QK, (tok0 + t) * RIN + 4096 + h * 512 + dv), o);
    if (smp) { const int dk = dhash(s + 2222) & 255; const float* S = A.in[I_STATE] + (size_t)(b * RH + h) * RDK * RDV; float u = S[(size_t)dk * RDV + dv];
        for (int sidx = 0; sidx < 64; ++sidx) u += dbf(QK, (tok0 + sidx) * RIN + 2048 + h * 256 + dk) * dbf(V, (size_t)sidx * 4096 + h * 512 + dv);
        u *= __builtin_amdgcn_exp2f(64.0f * dgamma_lg2(h)); dacc(ws, 3, A.out[OUT_RETS + (size_t)(b * RH + h) * RDK * RDV + (size_t)dk * RDV + dv], u); }
    { const int pidx = smp ? 64 + b * 8 + h : b * 8 + h; const int s2 = dhash(s + 4444) & 63; float qk = 0.f;
      for (int d = 0; d < 256; ++d) qk += dbf(QK, (tok0 + t) * RIN + h * 256 + d) * dbf(QK, (tok0 + s2) * RIN + 2048 + h * 256 + d);
      dacc(ws, 3, dbf((const bf16*)(ws + WS_DBG + 24 * MiB), (size_t)pidx * 4096 + t * 64 + s2), s2 <= t ? qk : 0.f); }
    { float mu = 0.f; for (int d = 0; d < 512; ++d) mu += dbf(QK, (tok0 + t) * RIN + 4096 + h * 512 + d); mu *= (1.0f / 512); float var = 0.f;
      for (int d = 0; d < 512; ++d) { const float x = dbf(QK, (tok0 + t) * RIN + 4096 + h * 512 + d) - mu; var += x * x; } var *= (1.0f / 512);
      const float y = dbf(QK, (tok0 + t) * RIN + 8192 + h * 512 + dv) * ((dbf(QK, (tok0 + t) * RIN + 4096 + h * 512 + dv) - mu) * __builtin_amdgcn_rsqf(var + EPS) * A.in[I_RGN][h * 512 + dv]);
      ((float*)(ws + WS_DBG_EY))[s] = y; } }
__global__ void dbg_k4(Args A) { const int s = blockIdx.x * blockDim.x + threadIdx.x; unsigned char* ws = A.ws; const bf16* QK = (const bf16*)(ws + WS_BIG);
    const bool smp = (s & 1) != 0; const int h = dhash(s) & 7, dv = dhash(s + 999) & 511, t = dhash(s + 5555) & 63;
    const int b = smp ? (dhash(s + 31337) & 31) : (dhash(s + 31337) & 7); const size_t tok0 = smp ? (size_t)MP + b * 64 : (size_t)b * SEQ;
    dacc(ws, 4, dbf(QK, (tok0 + t) * RIN + 4096 + h * 512 + dv), ((const float*)(ws + WS_DBG_EY))[s]);
    const int row = dhash(s + 10101) % MT, c = dhash(s + 20202) % DM; ((float*)(ws + WS_DBG_H))[s] = A.out[(size_t)row * DM + c]; }
__global__ void dbg_k5(Args A) { const int s = blockIdx.x * blockDim.x + threadIdx.x; unsigned char* ws = A.ws; const bf16* QK = (const bf16*)(ws + WS_BIG);
    const int row = dhash(s + 10101) % MT, c = dhash(s + 20202) % DM; const float* W = A.in[I_ROUT]; float a = 0.f;
    for (int k = 0; k < RHV; ++k) a += dbf(QK, (size_t)row * RIN + 4096 + k) * W[(size_t)k * DM + c];
    dacc(ws, 5, A.out[(size_t)row * DM + c] - ((const float*)(ws + WS_DBG_H))[s], a); }
__global__ void dbg_k6a(Args A) { const int s = blockIdx.x * blockDim.x + threadIdx.x; unsigned char* ws = A.ws; const bf16* XN = (const bf16*)(ws + WS_XN);
    const float* CKR = (const float*)(ws + WS_SMALL); const int row = dhash(s) % MT, c = dhash(s + 4321) % (KVL + ROPE); const float* W = A.in[I_WDKV];
    float a = 0.f; for (int k = 0; k < DM; ++k) a += dbf(XN, (size_t)row * DM + k) * W[(size_t)k * (KVL + ROPE) + c];
    dacc(ws, 6, CKR[(size_t)row * DKVP + c], a); }
__global__ void dbg_k6(Args A) { const int s = blockIdx.x * blockDim.x + threadIdx.x; unsigned char* ws = A.ws;
    const float* CKR = (const float*)(ws + WS_SMALL); const int row = dhash(s) % MT, c = dhash(s + 4321) % (KVL + ROPE);
    const float* r = CKR + (size_t)row * DKVP; float got, exp;
    if (c < KVL) { float ss = 0.f; for (int k = 0; k < KVL; ++k) ss += r[k] * r[k]; exp = r[c] * __builtin_amdgcn_rsqf(ss / KVL + EPS) * A.in[I_KVLN][c];
        got = row < MP ? A.out[OUT_CKVP + (size_t)row * KVL + c] : A.out[OUT_CKVS + (size_t)(row - MP) * KVL + c];
        const int kvrow = row < MP ? row : MP + ((row - MP) >> 6) * KVT + PAST + (row & 63); dacc(ws, 6, dbf((const bf16*)(ws + WS_CALL), (size_t)kvrow * KVL + c), exp);
    } else { const int j = (c - KVL) & 31; const float x1 = r[KVL + j], x2 = r[KVL + 32 + j]; float sn, cs; dsincos(dpos(row), j, 32, sn, cs);
        exp = (c - KVL) < 32 ? x1 * cs - x2 * sn : x1 * sn + x2 * cs; got = row < MP ? A.out[OUT_KRP + (size_t)row * ROPE + (c - KVL)] : A.out[OUT_KRS + (size_t)(row - MP) * ROPE + (c - KVL)]; }
    dacc(ws, 6, got, exp); }
__global__ void dbg_k7(Args A) { const int s = blockIdx.x * blockDim.x + threadIdx.x; unsigned char* ws = A.ws;
    { const bf16* QLN = (const bf16*)(ws + WS_QLN); const int row = dhash(s) % MT, c = dhash(s + 8888) % QW; const float* W = A.in[I_WUQ]; float a = 0.f;
      for (int k = 0; k < QLR; ++k) a += dbf(QLN, (size_t)row * QLR + k) * W[(size_t)k * QW + c];
      dacc(ws, 7, dbf((const bf16*)(ws + WS_Q), (size_t)row * QW + c), a); }
    { const bf16* CA = (const bf16*)(ws + WS_CALL); const int row = dhash(s + 99) % KVROWS, c = dhash(s + 7777) % KVW; const float* W = A.in[I_WUKV]; float a = 0.f;
      for (int k = 0; k < KVL; ++k) a += dbf(CA, (size_t)row * KVL + k) * W[(size_t)k * KVW + c];
      dacc(ws, 7, dbf((const bf16*)(ws + WS_BIG), (size_t)row * KVW + c), a); }
    { const int row = dhash(s + 606) % MT, hd = dhash(s + 707) & 15; for (int d = 0; d < QKH; ++d) ((bf16*)(ws + WS_DBG_Q))[(size_t)s * QKH + d] = ((const bf16*)(ws + WS_Q))[(size_t)row * QW + hd * QKH + d]; } }
__global__ void dbg_k8(Args A) { const int s = blockIdx.x * blockDim.x + threadIdx.x; unsigned char* ws = A.ws;
    { const int row = dhash(s + 606) % MT, hd = dhash(s + 707) & 15; const bf16* q = (const bf16*)(ws + WS_DBG_Q) + (size_t)s * QKH;
      float ss = 0.f; for (int d = 0; d < QKH; ++d) { float x;
          if (d < NOPE) x = dbf(q, d); else { const int j = (d - NOPE) & 31; const float x1 = dbf(q, NOPE + j), x2 = dbf(q, NOPE + 32 + j); float sn, cs; dsincos(dpos(row), j, 32, sn, cs);
              x = (d - NOPE) < 32 ? x1 * cs - x2 * sn : x1 * sn + x2 * cs; }
          ss += x * x; }
      const float rs = __builtin_amdgcn_rsqf(ss / QKH + EPS); const int d = dhash(s + 808) % QKH; float x;
      if (d < NOPE) x = dbf(q, d); else { const int j = (d - NOPE) & 31; const float x1 = dbf(q, NOPE + j), x2 = dbf(q, NOPE + 32 + j); float sn, cs; dsincos(dpos(row), j, 32, sn, cs);
          x = (d - NOPE) < 32 ? x1 * cs - x2 * sn : x1 * sn + x2 * cs; }
      dacc(ws, 8, dbf((const bf16*)(ws + WS_Q), (size_t)row * QW + hd * QKH + d), x * rs * A.in[I_QN][d] * A.in[I_KN][d] * 0.07216878364870322f * 1.4426950408889634f); }
    { const int row = dhash(s + 99) % KVROWS, hd = dhash(s + 555) & 15; const bf16* KVb = (const bf16*)(ws + WS_BIG); const bf16* KRb = (const bf16*)(ws + WS_KRALL); float ss = 0.f;
      for (int d = 0; d < NOPE; ++d) { const float x = dbf(KVb, (size_t)row * KVW + hd * 256 + d); ss += x * x; } for (int d = 0; d < ROPE; ++d) { const float x = dbf(KRb, (size_t)row * ROPE + d); ss += x * x; }
      dacc(ws, 8, ((const float*)(ws + WS_RS))[(size_t)row * MH + hd], __builtin_amdgcn_rsqf(ss / QKH + EPS)); } }
__global__ void dbg_k9(Args A) { const int s = blockIdx.x * blockDim.x + threadIdx.x; unsigned char* ws = A.ws;
    const bf16* Q = (const bf16*)(ws + WS_Q); const bf16* KVb = (const bf16*)(ws + WS_BIG); const bf16* KRb = (const bf16*)(ws + WS_KRALL); const float* RSs = (const float*)(ws + WS_RS);
    const int row = (s & 1) ? MP + (int)(dhash(s) % MS) : (int)(dhash(s) % MP); const int hd = dhash(s + 1111) & 15, d = dhash(s + 3333) & 127;
    int kv0, nk; if (row < MP) { const int b = row >> 11, t = row & 2047; kv0 = b * SEQ; nk = ((t >> 6) + 1) * 64; } else { const int b = (row - MP) >> 6; kv0 = MP + b * KVT; nk = KVT; }
    float m = -1e30f, l = 0.f, o = 0.f;
    for (int k = 0; k < nk; ++k) { float sc = 0.f; for (int e = 0; e < NOPE; ++e) sc += dbf(Q, (size_t)row * QW + hd * QKH + e) * dbf(KVb, (size_t)(kv0 + k) * KVW + hd * 256 + e);
        for (int e = 0; e < ROPE; ++e) sc += dbf(Q, (size_t)row * QW + hd * QKH + NOPE + e) * dbf(KRb, (size_t)(kv0 + k) * ROPE + e);
        sc *= RSs[(size_t)(kv0 + k) * MH + hd]; const float mn = fmaxf(m, sc), al = __builtin_amdgcn_exp2f(m - mn), p = __builtin_amdgcn_exp2f(sc - mn); l = l * al + p; o = o * al + p * dbf(KVb, (size_t)(kv0 + k) * KVW + hd * 256 + NOPE + d); m = mn; }
    dacc(ws, 9, dbf((const bf16*)(ws + WS_O), (size_t)row * DM + hd * VHD + d), o / l); }
__global__ void dbg_final(Args A) { if (threadIdx.x == 0 && blockIdx.x == 0) { const float* a = (const float*)(A.ws + WS_CTL) + DBG_ACC; unsigned bits = 0;
        for (int k = 0; k < 10; ++k) { const float e = a[2 * k], r = a[2 * k + 1]; if (!(e <= 2e-3f * r) || !(r > 0.f)) bits |= 1u << k; }
        float v = (float)(10 + (bits & 63)); for (unsigned i = 0; i < 2 + (bits >> 6); ++i) v *= 10.f; A.out[0] = v; } }
__global__ void dbg_stamp(Args A, int which) { if (threadIdx.x == 0 && blockIdx.x == 0) { ((unsigned long long*)(A.ws + WS_CTL))[4200 + which] = wall_clock64(); ((unsigned long long*)(A.ws + WS_CTL))[4210 + which] = clock64(); } }
__global__ void dbg_final_time(Args A) { if (threadIdx.x == 0 && blockIdx.x == 0) { const unsigned long long* t = (const unsigned long long*)(A.ws + WS_CTL) + 4200; const unsigned long long* c = t + 10; const float mhz = (float)(c[1] - c[0]) / (float)(t[1] - t[0]) * 100.0f; A.out[0] = 1000.0f * __builtin_floorf(mhz * (1.0f / 300.0f)); } }
#endif

extern "C" void kernel_launch(void* const* d_in, const int* in_sizes, int n_in, void* d_out, int out_size, void* d_ws, size_t ws_size, hipStream_t stream) {
    static int grid = 0;
    if (grid == 0) {
        if (n_in != 25 || out_size != (int)OUT_END || ws_size < WS_END) { fprintf(stderr, "kernel_launch: shape mismatch: n_in %d out %d ws %zu (need %zu)\n", n_in, out_size, ws_size, (size_t)WS_END); grid = -1; return; }
        int dev = 0, cus = 0, per_cu = 0;
        if (hipGetDevice(&dev) != hipSuccess || hipDeviceGetAttribute(&cus, hipDeviceAttributeMultiprocessorCount, dev) != hipSuccess) { grid = -1; return; }
        if (hipFuncSetAttribute((const void*)yoco_fwd, hipFuncAttributeMaxDynamicSharedMemorySize, LDS_BYTES) != hipSuccess) { fprintf(stderr, "kernel_launch: hipFuncSetAttribute failed\n"); grid = -1; return; }
        if (hipOccupancyMaxActiveBlocksPerMultiprocessor(&per_cu, (const void*)yoco_fwd, NWAVES * 64, LDS_BYTES) != hipSuccess || per_cu < 1) { fprintf(stderr, "kernel_launch: occupancy query says %d blocks per CU\n", per_cu); (void)hipGetLastError(); grid = -1; return; }
        grid = cus;
    }
    if (grid < 0) return;
    (void)hipMemsetAsync((char*)d_ws + WS_CTL, 0, CTL_ZERO_BYTES, stream);
    Args a{};
    for (int i = 0; i < 25; ++i) a.in[i] = (const float*)d_in[i];
    a.out = (float*)d_out; a.ws = (unsigned char*)d_ws;
    const int last = N_PHASES < MK_LAST_PHASE ? N_PHASES : MK_LAST_PHASE;
#if MK_ONE_LAUNCH
    a.ph_lo = 0; a.ph_hi = last;
    hipLaunchKernelGGL(yoco_fwd, dim3(grid), dim3(NWAVES * 64), LDS_BYTES, stream, a);
#if defined(MK_TWOPASS)
    (void)hipMemsetAsync((char*)d_ws + WS_CTL, 0, CTL_ZERO_BYTES, stream);
    a.dry = 1; hipLaunchKernelGGL(yoco_fwd, dim3(grid), dim3(NWAVES * 64), LDS_BYTES, stream, a);
#endif
#else
    for (int p = 0; p < last; ++p) { a.ph_lo = p; a.ph_hi = p + 1;
#if defined(MK_DEBUG) && defined(MK_TIMEP)
        if (p == MK_TIMEP) hipLaunchKernelGGL(dbg_stamp, dim3(1), dim3(64), 0, stream, a, 0);
#endif
        for (int rep = ((p == MK_REP || ((MK_REPMASK >> p) & 1u)) ? MK_REPN : 1); rep > 0; --rep) { a.dry = rep > 1 ? 1 : 0; hipLaunchKernelGGL(yoco_fwd, dim3(grid), dim3(NWAVES * 64), LDS_BYTES, stream, a); }
#if defined(MK_DEBUG) && defined(MK_TIMEP)
        if (p == MK_TIMEP) hipLaunchKernelGGL(dbg_stamp, dim3(1), dim3(64), 0, stream, a, 1);
        if (p == last - 1) hipLaunchKernelGGL(dbg_final_time, dim3(1), dim3(64), 0, stream, a);
        continue;
#endif
#if defined(MK_DEBUG)
        constexpr int NSB = 16;
        if (p == 1) hipLaunchKernelGGL(dbg_k0, dim3(NSB), dim3(256), 0, stream, a);
        if (p == 3) hipLaunchKernelGGL(dbg_k1, dim3(NSB), dim3(256), 0, stream, a);
        if (p == 4) { hipLaunchKernelGGL(dbg_k2, dim3(NSB), dim3(256), 0, stream, a); hipLaunchKernelGGL(dbg_snapv, dim3(1024), dim3(256), 0, stream, a); }
        if (p == 5) hipLaunchKernelGGL(dbg_k3, dim3(NSB), dim3(256), 0, stream, a);
        if (p == 6) hipLaunchKernelGGL(dbg_k4, dim3(NSB), dim3(256), 0, stream, a);
        if (p == 8) hipLaunchKernelGGL(dbg_k5, dim3(NSB), dim3(256), 0, stream, a);
        if (p == 12) hipLaunchKernelGGL(dbg_k6a, dim3(NSB), dim3(256), 0, stream, a);
        if (p == 13) hipLaunchKernelGGL(dbg_k6, dim3(NSB), dim3(256), 0, stream, a);
        if (p == 19) hipLaunchKernelGGL(dbg_k7, dim3(NSB), dim3(256), 0, stream, a);
        if (p == 20) hipLaunchKernelGGL(dbg_k8, dim3(NSB), dim3(256), 0, stream, a);
        if (p == 21) hipLaunchKernelGGL(dbg_k9, dim3(NSB), dim3(256), 0, stream, a);
        if (p == last - 1) hipLaunchKernelGGL(dbg_final, dim3(1), dim3(64), 0, stream, a);
#endif
    }
#endif
    const hipError_t le = hipPeekAtLastError();
    if (le != hipSuccess) fprintf(stderr, "kernel_launch: launch failed: %s\n", hipGetErrorName(le));
}
```

```cpp
#include <hip/hip_runtime.h>
#include <cstdio>
#include <cstdint>

#define MK_BLK 0
#ifndef MK_ONE_LAUNCH
#define MK_ONE_LAUNCH 1
#endif
#ifndef MK_REP
#define MK_REP (-1)
#endif
#ifndef MK_DBLBAR
#define MK_DBLBAR 0
#endif
#ifndef MK_ALIGN_SWIGLU
#define MK_ALIGN_SWIGLU true
#endif
#ifndef MK_WARMMFMA
#define MK_WARMMFMA 0
#endif
#ifndef MK_BLK
#define MK_BLK 1
#endif
#ifndef MK_STAGGER
#define MK_STAGGER 0
#endif
#ifndef MK_ATTN_LC
#define MK_ATTN_LC 1
#endif
#ifndef MK_ATTN_SB
#define MK_ATTN_SB 1
#endif
#ifndef MK_ATTN_HOIST
#define MK_ATTN_HOIST 0
#endif
#ifndef MK_SCAN_XCD
#define MK_SCAN_XCD 1
#endif
#ifndef MK_DEFCACHE
#define MK_DEFCACHE 1
#endif
#ifndef MK_XTAIL
#define MK_XTAIL 1
#endif
#ifndef MK_ATTN_LAZY
#define MK_ATTN_LAZY 1
#endif
#ifndef MK_ATTN_DELAY
#define MK_ATTN_DELAY 0
#endif
#ifndef MK_SCAN_PF
#define MK_SCAN_PF 0
#endif
#ifndef MK_SCAN_IL
#define MK_SCAN_IL 0
#endif
#ifndef MK_STAGKV
#define MK_STAGKV 0
#endif
#ifndef MK_NFOLD
#define MK_NFOLD 2
#endif
#ifndef MK_CONVUNROLL
#define MK_CONVUNROLL 16
#endif
#ifndef MK_DEFSPLIT0
#define MK_DEFSPLIT0 1000
#define MK_DEFSPLIT1 1000
#define MK_DEFSPLIT2 1000
#define MK_DEFSPLIT3 1000
#define MK_DEFSPLIT4 1000
#endif
#ifndef MK_DEFNT
#define MK_DEFNT 1
#endif
#ifndef MK_DEFUNROLL
#define MK_DEFUNROLL 64
#endif
#ifndef MK_DEFER
#define MK_DEFER 2
#endif
#ifndef MK_TQ
#define MK_TQ 2
#endif
#ifndef MK_HBF
#define MK_HBF 1
#endif
#ifndef MK_SPINEND
#define MK_SPINEND 0
#endif
#ifndef MK_SPINCLK
#define MK_SPINCLK 0
#endif
#ifndef MK_QLFUSE
#define MK_QLFUSE 1
#endif
#ifndef MK_HALFTAIL
#define MK_HALFTAIL 0
#endif
#ifndef MK_QFUSE
#define MK_QFUSE 1
#endif
#ifndef MK_BARWAIT
#define MK_BARWAIT 0
#endif
#ifndef MK_BARMASK
#define MK_BARMASK 0xffffffffu
#endif
#ifndef MK_BARWAIT_BLK
#define MK_BARWAIT_BLK 0
#endif
#ifndef MK_ATTN_PRIO
#define MK_ATTN_PRIO 0
#endif
#ifndef MK_ATTN_DRYMODE
#define MK_ATTN_DRYMODE 0
#endif
#ifndef MK_ATTN_IL
#define MK_ATTN_IL 0
#endif
#ifndef MK_SCRAMBLE
#define MK_SCRAMBLE 0
#endif
#ifndef MK_PRETOUCH
#define MK_PRETOUCH 0
#endif
#ifndef MK_SP2
#define MK_SP2 true
#endif
#ifndef MK_CLKPH
#define MK_CLKPH (-1)
#endif
#ifndef MK_CLKMODE
#define MK_CLKMODE 0
#endif
#ifndef MK_SPINMUL
#define MK_SPINMUL 1
#endif
#ifndef MK_NORM2
#define MK_NORM2 1
#endif
#ifndef MK_SPINMASK
#define MK_SPINMASK 0u
#endif
#ifndef MK_REPMASK
#define MK_REPMASK 0u
#endif
#ifndef MK_REPN
#define MK_REPN 2
#endif
#ifndef MK_LAST_PHASE
#define MK_LAST_PHASE 1000
#endif

namespace pg8 {
#define PG8_LAS __attribute__((address_space(3)))
typedef unsigned short bf16_t;
typedef short bf16x8 __attribute__((ext_vector_type(8)));
typedef float f32x4 __attribute__((ext_vector_type(4)));
typedef unsigned u32x4 __attribute__((ext_vector_type(4)));
constexpr int BM = 256, BK = 64, HALF = 128, HTB = HALF * BK * 2  , STAGE_BYTES = 8 * HTB, NXCD = 8, WGM = 8;

__host__ __device__ __forceinline__ int lds_byte(int r, int c) { const int st = (r >> 4) * 2 + (c >> 5), rr = r & 15, cc = c & 31, ob = rr * 64 + cc * 2; return st * 1024 + (ob ^ (((ob >> 9) & 1) << 5)); }
__host__ __device__ __forceinline__ void stage_rc(int b, int& R, int& C) { const int st = b / 1024, sb = b % 1024, swz = sb ^ (((sb >> 9) & 1) << 5); R = (st >> 1) * 16 + swz / 64; C = (st & 1) * 32 + (swz % 64) / 2; }
__host__ __device__ __forceinline__ int perm32(int rho) { const int n = rho >> 4, i = rho & 15; return 8 * (i >> 2) + 4 * n + (i & 3); }

struct Unit { int pm, pn, k0, nkt, part, half, par; };
struct Gemm { const bf16_t* A; const bf16_t* Bt; int M, N, K, lda, blkA, blkB; };

struct StaticOrder {
    static constexpr bool HAS_HALF = false;
    int nM, nN, nwg, G, c; bool xt;
    __host__ __device__ void init(int M, int N, int G_, int c_) { nM = M / BM; nN = N / BM; nwg = nM * nN; G = G_; c = c_; xt = false; }
    __host__ __device__ bool next(int i, Unit& u) const {
        int wgid;
        const int R = nwg / G, rem = nwg - R * G;
        if (xt && i == R && rem > 0 && G % NXCD == 0 && rem % NXCD == 0 && nwg % NXCD == 0) {
            const int v = (c % NXCD) * (G / NXCD) + c / NXCD; if (v >= rem) return false;
            const int per = rem / NXCD, q = nwg / NXCD; wgid = (v / per) * q + (q - per) + (v % per);
        } else {
        const long L = (long)i * G + c; if (L >= nwg) return false;
        wgid = (int)L; { const int q = nwg / NXCD, r = nwg % NXCD, xcd = wgid % NXCD, off = wgid / NXCD; wgid = (xcd < r ? xcd * (q + 1) : r * (q + 1) + (xcd - r) * q) + off; }
        }
        const int nig = WGM * nN, gid = wgid / nig, fm = gid * WGM, gsz = (nM - fm) < WGM ? (nM - fm) : WGM;
        u.pm = fm + ((wgid % nig) % gsz); u.pn = (wgid % nig) / gsz; u.k0 = 0; u.nkt = 0; u.part = 0; u.half = 0; return true;
    }
    __device__ __forceinline__ void a_ready(const Unit&) const {}
    __device__ __forceinline__ void done(const Unit&) const {}
};
struct TqOrder {
    static constexpr bool HAS_HALF = false;
    StaticOrder so;
    __host__ __device__ void init(int M, int N, int G_, int c_) { so.nM = M / 192; so.nN = N / BM; so.nwg = so.nM * so.nN; so.G = G_; so.c = c_; so.xt = false; }
    __host__ __device__ bool next(int i, Unit& u) const { return so.next(i, u); }
    __device__ __forceinline__ void a_ready(const Unit&) const {}
    __device__ __forceinline__ void done(const Unit&) const {}
};
struct SplitTailOrder {
    static constexpr bool HAS_HALF = false;
    StaticOrder so; int nt; bool split;
    __host__ __device__ void init(int K, int G_, int c_) { nt = K / BK; split = (G_ == 256); so.init(split ? 64 * BM : 72 * BM, 8 * BM, G_, c_); }
    __host__ __device__ bool next(int i, Unit& u) const {
        if (!split) return so.next(i, u);
        if (i < 2) return so.next(i, u);
        if (i > 2) return false;
        const int t = so.c >> 2, kq = so.c & 3; u.pm = 64 + (t >> 3); u.pn = t & 7; u.nkt = nt >> 2; u.k0 = kq * u.nkt; u.part = kq + 1; u.half = 0; return true;
    }
    __device__ __forceinline__ void a_ready(const Unit&) const {}
    __device__ __forceinline__ void done(const Unit&) const {}
};

struct HalfTailOrder {
    static constexpr bool HAS_HALF = true;
    StaticOrder so; int R, r; bool cut;
    __host__ __device__ void init(int M, int N, int G_, int c_) { so.init(M, N, G_, c_); R = so.nwg / G_; r = so.nwg - R * G_; cut = (r > 0 && 2 * r <= G_); }
    __host__ __device__ bool next(int i, Unit& u) const {
        if (!cut || i < R) return so.next(i, u);
        if (i > R || so.c >= 2 * r) return false;
        StaticOrder t = so; t.c = so.c >> 1; if (!t.next(R, u)) return false;
        u.half = 1 + (so.c & 1); return true;
    }
    __device__ __forceinline__ void a_ready(const Unit&) const {}
    __device__ __forceinline__ void done(const Unit&) const {}
};


template <class Epi, class Sched, bool ALIGN_EPI = false, bool SP2 = false, int TQ = 0>
__device__ __forceinline__ void gemm_phase(PG8_LAS unsigned char* lds, const Gemm g, const Sched& S, const Epi& E, int tid_) {
    const int tid = tid_, wid = __builtin_amdgcn_readfirstlane(tid >> 6), lane = tid & 63, wr = wid >> 2, wc = wid & 3, fr = lane & 15, fq = lane >> 4;
    const int K = g.K, nt = K / BK, lda = g.lda;
    unsigned voffA[2], voffB[2];
#pragma unroll
    for (int i = 0; i < 2; ++i) { int R, C; stage_rc(tid * 16 + i * 8192, R, C); const int Rb = Epi::PERM ? ((R & ~31) + perm32(R & 31)) : R;
        voffA[i] = (unsigned)(R * (g.blkA ? BK : lda) + C) * 2u; voffB[i] = (unsigned)(Rb * (g.blkB ? BK : K) + C) * 2u; }
    const size_t kstepA = g.blkA ? (size_t)BM * BK * 2 : (size_t)(BK * 2), kstepB = g.blkB ? (size_t)BM * BK * 2 : (size_t)(BK * 2);
    const size_t hstepA = (size_t)(TQ == 2 ? 64 : HALF) * (g.blkA ? BK : lda) * 2, hstepB = (size_t)HALF * (g.blkB ? BK : K) * 2;
    static_assert(!TQ || SP2, "TQ units need the SP2 loop");
    const size_t tstepA = TQ ? (size_t)192 * lda * 2 : g.blkA ? (size_t)nt * BM * BK * 2 : (size_t)BM * lda * 2, tstepB = g.blkB ? (size_t)nt * BM * BK * 2 : 2 * hstepB;
    const unsigned ldsw = (unsigned)wid * 1024u;
    const int aoff = lds_byte(TQ == 2 ? wr * 48 + fr : wr * 64 + fr, fq * 8), boff = lds_byte(wc * 32 + fr, fq * 8);
    const int aoff1 = TQ == 2 ? lds_byte(32 + wr * 48 + fr, fq * 8) : TQ == 1 ? lds_byte(wr * 32 + fr, fq * 8) : aoff;
#define PG8_SA(b, h) (((b) * 2 + (h)) * HTB)
#define PG8_SB(b, h) ((4 + (b) * 2 + (h)) * HTB)
#define PG8_STAGE(bufoff, gbase, voff) do { _Pragma("unroll") for (int _i = 0; _i < 2; ++_i) \
        __builtin_amdgcn_global_load_lds((const unsigned*)((const char*)(gbase) + (voff)[_i]), (PG8_LAS unsigned*)(lds + (bufoff) + ldsw + _i * 8192), 16, 0, 0); } while (0)
#define PG8_LDA(dst, b, h) do { _Pragma("unroll") for (int m = 0; m < (TQ == 2 ? 3 : 4); ++m) _Pragma("unroll") for (int k = 0; k < 2; ++k) dst[m][k] = *(const PG8_LAS bf16x8*)(lds + PG8_SA(b, h) + aoff + m * 2048 + k * 1024); } while (0)
#define PG8_LDB(dst, b, h) do { _Pragma("unroll") for (int n = 0; n < 2; ++n) _Pragma("unroll") for (int k = 0; k < 2; ++k) dst[n][k] = *(const PG8_LAS bf16x8*)(lds + PG8_SB(b, h) + boff + n * 2048 + k * 1024); } while (0)
#define PG8_MMA(ai, bj, At, Bt) do { __builtin_amdgcn_s_setprio(1); _Pragma("unroll") for (int m = 0; m < (TQ == 2 ? 3 : 4); ++m) _Pragma("unroll") for (int n = 0; n < 2; ++n) _Pragma("unroll") for (int k = 0; k < 2; ++k) \
        acc[ai][bj][m][n] = __builtin_amdgcn_mfma_f32_16x16x32_bf16(Bt[n][k], At[m][k], acc[ai][bj][m][n], 0, 0, 0); __builtin_amdgcn_s_setprio(0); } while (0)
#define PG8_STAGE_A1(bufoff, gbase) do { if constexpr (TQ == 1) { _Pragma("unroll") for (int _i = 0; _i < 2; ++_i)   \
        __builtin_amdgcn_global_load_lds((const unsigned*)((const char*)(gbase) + voffA[0]), (PG8_LAS unsigned*)(lds + (bufoff) + ldsw + _i * 8192), 16, 0, 0); } else PG8_STAGE(bufoff, gbase, voffA); } while (0)
#define PG8_LDA1(dst, b) do { _Pragma("unroll") for (int m = 0; m < (TQ == 2 ? 3 : TQ == 1 ? 2 : 4); ++m) _Pragma("unroll") for (int k = 0; k < 2; ++k) dst[m][k] = *(const PG8_LAS bf16x8*)(lds + PG8_SA(b, 1) + aoff1 + m * 2048 + k * 1024); } while (0)
#define PG8_MMA1(bj, At, Bt) do { __builtin_amdgcn_s_setprio(1); _Pragma("unroll") for (int m = 0; m < (TQ == 2 ? 3 : TQ == 1 ? 2 : 4); ++m) _Pragma("unroll") for (int n = 0; n < 2; ++n) _Pragma("unroll") for (int k = 0; k < 2; ++k) \
        acc[1][bj][m][n] = __builtin_amdgcn_mfma_f32_16x16x32_bf16(Bt[n][k], At[m][k], acc[1][bj][m][n], 0, 0, 0); __builtin_amdgcn_s_setprio(0); } while (0)
#define PG8_WAIT_V(n) asm volatile("s_waitcnt vmcnt(" #n ")" ::: "memory")
#define PG8_WAIT_L(n) asm volatile("s_waitcnt lgkmcnt(" #n ")" ::: "memory")
#define PG8_BAR __builtin_amdgcn_s_barrier()
#define PG8_SCHED __builtin_amdgcn_sched_barrier(0)
    Unit cur, nxt; int ui = 0;
    if (!S.next(0, cur)) return;
    f32x4 acc[2][2][4][2];
#pragma unroll
    for (int a = 0; a < 2; ++a)
#pragma unroll
        for (int b = 0; b < 2; ++b)
#pragma unroll
            for (int m = 0; m < 4; ++m)
#pragma unroll
                for (int n = 0; n < 2; ++n) acc[a][b][m][n] = (f32x4){0.f, 0.f, 0.f, 0.f};
    bf16x8 At[4][2], B0[2][2], B1[2][2];
    const char* cA = (const char*)g.A + (size_t)cur.pm * tstepA + (size_t)cur.k0 * kstepA; const char* cB = (const char*)g.Bt + (size_t)cur.pn * tstepB + (size_t)cur.k0 * kstepB;
    S.a_ready(cur);
    if constexpr (SP2) {
        PG8_STAGE(PG8_SB(0, 0), cB, voffB); PG8_STAGE(PG8_SB(0, 1), cB + hstepB, voffB); PG8_STAGE(PG8_SA(0, 0), cA, voffA); PG8_STAGE_A1(PG8_SA(0, 1), cA + hstepA);
        if (wr == 1) PG8_BAR;
        PG8_WAIT_V(2); PG8_BAR;
        PG8_STAGE(PG8_SB(1, 0), cB + kstepB, voffB); PG8_STAGE(PG8_SA(1, 0), cA + kstepA, voffA); PG8_STAGE(PG8_SB(1, 1), cB + hstepB + kstepB, voffB);
        PG8_WAIT_V(6); PG8_BAR;
    } else {
        PG8_STAGE(PG8_SB(0, 0), cB, voffB); PG8_STAGE(PG8_SA(0, 0), cA, voffA); PG8_STAGE(PG8_SB(0, 1), cB + hstepB, voffB); PG8_STAGE(PG8_SA(0, 1), cA + hstepA, voffA);
        if (wr == 1) PG8_BAR;
        PG8_WAIT_V(4); PG8_BAR;
        PG8_STAGE(PG8_SB(1, 0), cB + kstepB, voffB); PG8_STAGE(PG8_SA(1, 0), cA + kstepA, voffA); PG8_STAGE(PG8_SB(1, 1), cB + hstepB + kstepB, voffB);
        PG8_WAIT_V(6); PG8_BAR;
    }
    for (;;) {
        const bool has_next = S.next(ui + 1, nxt);
        const char* nA = has_next ? (const char*)g.A + (size_t)nxt.pm * tstepA + (size_t)nxt.k0 * kstepA : cA; const char* nB = has_next ? (const char*)g.Bt + (size_t)nxt.pn * tstepB + (size_t)nxt.k0 * kstepB : cB;
        const int ntc = cur.nkt ? cur.nkt : nt;
        cur.par = ui & 1;
        if constexpr (Epi::PRE) E.prefetch(lds, cur, tid);
#define PG8_SP2_BODY(DO0, DO1) do { \
            PG8_LDB(B0, 0, 0); PG8_LDB(B1, 0, 1); PG8_SCHED; if (DO0) PG8_LDA(At, 0, 0); PG8_STAGE_A1(PG8_SA(1, 1), a1 + hstepA); \
            PG8_WAIT_V(8); PG8_WAIT_L(0); PG8_BAR; if (DO0) { PG8_MMA(0, 0, At, B0); PG8_MMA(0, 1, At, B1); } PG8_BAR; PG8_SCHED; \
            if (DO1) PG8_LDA1(At, 0); PG8_STAGE(PG8_SB(0, 0), b2, voffB); PG8_STAGE(PG8_SB(0, 1), b2 + hstepB, voffB); PG8_STAGE(PG8_SA(0, 0), a2, voffA); \
            PG8_WAIT_V(8); PG8_WAIT_L(0); PG8_BAR; if (DO1) { PG8_MMA1(0, At, B0); PG8_MMA1(1, At, B1); } PG8_BAR; PG8_SCHED; \
            PG8_LDB(B0, 1, 0); PG8_LDB(B1, 1, 1); PG8_SCHED; if (DO0) PG8_LDA(At, 1, 0); PG8_STAGE_A1(PG8_SA(0, 1), a2 + hstepA); \
            PG8_WAIT_V(8); PG8_WAIT_L(0); PG8_BAR; if (DO0) { PG8_MMA(0, 0, At, B0); PG8_MMA(0, 1, At, B1); } PG8_BAR; PG8_SCHED; \
            if (DO1) PG8_LDA1(At, 1); PG8_STAGE(PG8_SB(1, 0), b3, voffB); PG8_STAGE(PG8_SB(1, 1), b3 + hstepB, voffB); PG8_STAGE(PG8_SA(1, 0), a3, voffA); \
            PG8_WAIT_V(8); PG8_WAIT_L(0); PG8_BAR; if (DO1) { PG8_MMA1(0, At, B0); PG8_MMA1(1, At, B1); } PG8_BAR; PG8_SCHED; } while (0)
#define PG8_TLOOP(DO0, DO1) do { for (int t = 0; t < ntc; t += 2) { \
            const bool last = (t == ntc - 2); \
            const char* a1 = cA + (size_t)(t + 1) * kstepA; \
            const char* a2 = last ? nA : cA + (size_t)(t + 2) * kstepA; const char* b2 = last ? nB : cB + (size_t)(t + 2) * kstepB; \
            const char* a3 = a2 + kstepA; const char* b3 = b2 + kstepB; \
            if (last && has_next) S.a_ready(nxt); \
            PG8_SP2_BODY(DO0, DO1); } } while (0)
        if constexpr (SP2) {
            if constexpr (Sched::HAS_HALF) { if (cur.half == 0) PG8_TLOOP(true, true); else if (cur.half == 1) PG8_TLOOP(true, false); else PG8_TLOOP(false, true); }
            else PG8_TLOOP(true, true);
        } else {
        static_assert(SP2 || !Sched::HAS_HALF, "half units need the SP2 loop");
        for (int t = 0; t < ntc; t += 2) {
            const bool last = (t == ntc - 2);
            const char* a1 = cA + (size_t)(t + 1) * kstepA;
            const char* a2 = last ? nA : cA + (size_t)(t + 2) * kstepA; const char* b2 = last ? nB : cB + (size_t)(t + 2) * kstepB;
            const char* a3 = a2 + kstepA; const char* b3 = b2 + kstepB;
            if (last && has_next) S.a_ready(nxt);
            PG8_LDB(B0, 0, 0); PG8_SCHED; PG8_LDA(At, 0, 0); PG8_STAGE(PG8_SA(1, 1), a1 + hstepA, voffA);
            PG8_WAIT_L(8); PG8_BAR; PG8_WAIT_L(0); PG8_MMA(0, 0, At, B0); PG8_BAR; PG8_SCHED;
            PG8_LDB(B1, 0, 1); PG8_STAGE(PG8_SB(0, 0), b2, voffB);
            PG8_BAR; PG8_WAIT_L(0); PG8_MMA(0, 1, At, B1); PG8_BAR;
            PG8_LDA(At, 0, 1); PG8_STAGE(PG8_SA(0, 0), a2, voffA);
            PG8_BAR; PG8_WAIT_L(0); PG8_MMA(1, 0, At, B0); PG8_BAR; PG8_SCHED;
            PG8_STAGE(PG8_SB(0, 1), b2 + hstepB, voffB);
            PG8_WAIT_V(6); PG8_BAR; PG8_MMA(1, 1, At, B1); PG8_BAR;
            PG8_LDB(B0, 1, 0); PG8_SCHED; PG8_LDA(At, 1, 0); PG8_STAGE(PG8_SA(0, 1), a2 + hstepA, voffA);
            PG8_WAIT_L(8); PG8_BAR; PG8_WAIT_L(0); PG8_MMA(0, 0, At, B0); PG8_BAR; PG8_SCHED;
            PG8_LDB(B1, 1, 1); PG8_STAGE(PG8_SB(1, 0), b3, voffB);
            PG8_BAR; PG8_WAIT_L(0); PG8_MMA(0, 1, At, B1); PG8_BAR;
            PG8_LDA(At, 1, 1); PG8_STAGE(PG8_SA(1, 0), a3, voffA);
            PG8_BAR; PG8_WAIT_L(0); PG8_MMA(1, 0, At, B0); PG8_BAR; PG8_SCHED;
            PG8_STAGE(PG8_SB(1, 1), b3 + hstepB, voffB);
            PG8_WAIT_V(6); PG8_BAR; PG8_MMA(1, 1, At, B1); PG8_BAR;
        }
        }
#undef PG8_TLOOP
#undef PG8_SP2_BODY
        if constexpr (ALIGN_EPI) { if (wr == 0) PG8_BAR; }
        E(acc, cur, wr, wc, fr, fq);
        if (!has_next) break;
#pragma unroll
        for (int a = 0; a < 2; ++a)
#pragma unroll
            for (int b = 0; b < 2; ++b)
#pragma unroll
                for (int m = 0; m < 4; ++m)
#pragma unroll
                    for (int n = 0; n < 2; ++n) acc[a][b][m][n] = (f32x4){0.f, 0.f, 0.f, 0.f};
        cur = nxt; cA = nA; cB = nB; ++ui;
        if constexpr (ALIGN_EPI) { if (wr == 1) PG8_BAR; }
    }
    PG8_WAIT_V(0);
    if constexpr (!ALIGN_EPI) { if (wr == 0) PG8_BAR; }
    PG8_BAR;
#undef PG8_SA
#undef PG8_SB
#undef PG8_STAGE
#undef PG8_LDA
#undef PG8_LDB
#undef PG8_MMA
#undef PG8_STAGE_A1
#undef PG8_LDA1
#undef PG8_MMA1
#undef PG8_WAIT_V
#undef PG8_WAIT_L
#undef PG8_BAR
#undef PG8_SCHED
}
}
constexpr int DM = 2048, NBP = 8, SEQ = 2048, NBS = 32, DSEQ = 64, PAST = 1024, DFF = 5632;
constexpr int MP = NBP * SEQ, MS = NBS * DSEQ, MT = MP + MS;
constexpr int RH = 8, RDK = 256, RDV = 512, RIN = 2 * RH * RDK + 2 * RH * RDV, RHV = RH * RDV;
constexpr int MH = 16, NOPE = 128, ROPE = 64, QKH = 192, VHD = 128, KVL = 512, QLR = 512, QW = MH * QKH;
constexpr int KVT = PAST + DSEQ, KVROWS = MP + NBS * KVT;
constexpr int DKVP = 768, KVW = MH * (NOPE + VHD);
constexpr float EPS = 1e-6f;

constexpr size_t OUT_YP = 0, OUT_YS = (size_t)MP * DM, OUT_RETP = OUT_YS + (size_t)MS * DM, OUT_CKVP = OUT_RETP + (size_t)NBP * RH * RDK * RDV,
                 OUT_KRP = OUT_CKVP + (size_t)MP * KVL, OUT_RETS = OUT_KRP + (size_t)MP * ROPE, OUT_CKVS = OUT_RETS + (size_t)NBS * RH * RDK * RDV,
                 OUT_KRS = OUT_CKVS + (size_t)MS * KVL, OUT_END = OUT_KRS + (size_t)MS * ROPE;
static_assert(OUT_END == 90308608, "output size");

constexpr size_t MiB = 1u << 20;
constexpr size_t WS_CTL = 0, CTL_ZERO_BYTES = 1 * MiB;
constexpr size_t WS_COSR = 1 * MiB, WS_SINR = 2 * MiB;
constexpr size_t WS_COSM = 3 * MiB, WS_SINM = 3 * MiB + 256 * 1024;
constexpr size_t WS_SSQKR = 3 * MiB + 512 * 1024;
constexpr size_t WS_GQK = 3 * MiB + 768 * 1024;
constexpr size_t WS_RS = 4 * MiB;
constexpr size_t WS_KRALL = 21 * MiB;
constexpr size_t WS_CALL = 28 * MiB;
constexpr size_t WS_XN = 78 * MiB;
constexpr size_t WS_SMALL = 150 * MiB;
constexpr size_t WS_QLN = WS_SMALL + 36 * MiB;
constexpr size_t WS_QSSQ = WS_SMALL;
constexpr size_t WS_WL1 = 204 * MiB;
constexpr size_t SZ_WIN = (size_t)2 * DFF * DM * 2, SZ_WOUT = (size_t)DM * DFF * 2;
constexpr size_t WS_WIN10 = WS_WL1, WS_WOUT10 = WS_WIN10 + SZ_WIN, WS_WIN11 = WS_WOUT10 + SZ_WOUT, WS_WOUT11 = WS_WIN11 + SZ_WIN;
constexpr size_t WS_WDQ = WS_WOUT11 + SZ_WOUT, WS_WUQ = WS_WDQ + 2 * MiB, WS_WO = WS_WUQ + 3 * MiB, WS_WUKV = WS_WO + 8 * MiB;
constexpr size_t WS_WL0 = WS_WUKV + 4 * MiB;
static_assert(WS_WL0 == 353 * MiB, "ws map");
constexpr size_t WS_WIN00 = WS_WL0, WS_WOUT00 = WS_WIN00 + SZ_WIN, WS_WIN01 = WS_WOUT00 + SZ_WOUT, WS_WOUT01 = WS_WIN01 + SZ_WIN;
constexpr size_t WS_WRIN = WS_WOUT01 + SZ_WOUT, WS_WROUT = WS_WRIN + 48 * MiB, WS_WDKV = WS_WROUT + 16 * MiB;
constexpr size_t WS_Q = WS_WL0, WS_O = WS_WL0 + 108 * MiB;
constexpr size_t WS_BIG = WS_WDKV + 3 * MiB;
static_assert(WS_BIG == 552 * MiB && WS_O + (size_t)MT * DM * 2 <= WS_BIG, "ws map");
constexpr size_t WS_PART = WS_BIG + 200 * MiB;
constexpr size_t WS_END = WS_BIG + (size_t)MT * RIN * 2;
static_assert(WS_END == 984 * MiB, "ws map");
constexpr size_t WS_FIXCNT = 32 * 1024;
constexpr size_t WS_SSQH = 8 * MiB, SSQH_STRIDE = (size_t)MT * 32;
static_assert(WS_RS + (size_t)KVROWS * 16 * 4 <= WS_SSQH && WS_SSQH + 6 * SSQH_STRIDE <= WS_KRALL, "ws map");
constexpr int CW_BAR = 4096;

constexpr int RING_OFF = 0, RING_BYTES = 144 * 1024;
constexpr int LDSCTL_OFF = RING_BYTES, MISC_OFF = LDSCTL_OFF + 320;
constexpr int LDS_BYTES = 155648;
constexpr int NWAVES = 8;

#define GAS __attribute__((address_space(1)))
#define LAS __attribute__((address_space(3)))
typedef unsigned short bf16;
typedef unsigned v4u __attribute__((ext_vector_type(4)));
typedef unsigned v2u __attribute__((ext_vector_type(2)));
typedef float f32x4 __attribute__((ext_vector_type(4)));
typedef float f32x16 __attribute__((ext_vector_type(16)));
typedef short bf16x8 __attribute__((ext_vector_type(8)));
typedef short s16x4 __attribute__((ext_vector_type(4)));
typedef GAS unsigned gu32;
#define RLX_AGENT __ATOMIC_RELAXED, __HIP_MEMORY_SCOPE_AGENT
#define LDS_WAIT() asm volatile("s_waitcnt lgkmcnt(0)" ::: "memory")
#define VM_WAIT() asm volatile("s_waitcnt vmcnt(0)" ::: "memory")
typedef float f32x2_t __attribute__((ext_vector_type(2)));
typedef __bf16 bf16x2_t __attribute__((ext_vector_type(2)));
__device__ __forceinline__ unsigned cvtpk(float lo, float hi) { const f32x2_t v = {lo, hi}; const bf16x2_t b = __builtin_convertvector(v, bf16x2_t); return __builtin_bit_cast(unsigned, b); }
__device__ __forceinline__ float bflo(unsigned w) { return __uint_as_float(w << 16); }
__device__ __forceinline__ float bfhi(unsigned w) { return __uint_as_float(w & 0xffff0000u); }
__device__ __forceinline__ int lane_id_asm() { int l; asm volatile("v_mbcnt_lo_u32_b32 %0, -1, 0\n\tv_mbcnt_hi_u32_b32 %0, -1, %0" : "=v"(l)); return l; }
__device__ __forceinline__ float shfl_xor_l(float v, int o, int lane) { return __int_as_float(__builtin_amdgcn_ds_bpermute((lane ^ o) << 2, __float_as_int(v))); }
__device__ __forceinline__ float wave_sum(float v, int lane) {
#pragma unroll
    for (int o = 1; o < 64; o <<= 1) v += shfl_xor_l(v, o, lane);
    return v;
}
__device__ __forceinline__ float silu_f(float a) { return a * __builtin_amdgcn_rcpf(1.0f + __builtin_amdgcn_exp2f(-1.4426950408889634f * a)); }
__device__ __forceinline__ float lg2gamma(int h) {
    return h == 0 ? -0.04580368961312479f : h == 1 ? -0.02272007650008353f : h == 2 ? -0.011315313227834146f : h == 3 ? -0.005646563141142063f :
           h == 4 ? -0.0028205190623786626f : h == 5 ? -0.0014095702546713536f : h == 6 ? -0.0007046129765893727f : -0.0003522634716290214f;
}

#define XB_TMO      128
#define XB_XCNT(j)  (256  + 64 * (j))
#define XB_XSUB(j)  (1280 + 64 * (j))
#define XB_XGEN(j)  (2304 + 64 * (j))
#define XB_TOP      3328
#define XB_TOPGEN   3392
#define XCD_BAR_WORDS 3456
#define XB_SPIN_CAP (1u << 18)

__device__ __forceinline__ unsigned xb_ld(unsigned* p)              { return __hip_atomic_load(p, __ATOMIC_RELAXED, __HIP_MEMORY_SCOPE_AGENT); }
__device__ __forceinline__ unsigned xb_add(unsigned* p, unsigned v) { return __hip_atomic_fetch_add(p, v, __ATOMIC_RELAXED, __HIP_MEMORY_SCOPE_AGENT); }
__device__ __forceinline__ unsigned xb_xcc_id() { return (unsigned)__builtin_amdgcn_s_getreg((3 << 11) | 20) & 0xFu; }
#define XB_SPIN(cond, bar) do { unsigned _sp = 0; while (cond) { __builtin_amdgcn_s_sleep(1); \
    if ((++_sp & 255u) == 0u) { if (xb_ld(&(bar)[XB_TMO])) break; if (_sp > XB_SPIN_CAP) { atomicAdd(&(bar)[XB_TMO], 1u); break; } } } } while (0)

struct XcdBarrier {
    unsigned* bar; unsigned x;
    volatile LAS unsigned* st;
};
__device__ __forceinline__ XcdBarrier xcd_barrier_post(unsigned* bar, volatile LAS unsigned* st) {
    XcdBarrier b; b.bar = bar; b.x = xb_xcc_id(); b.st = st;
    if (threadIdx.x == 0) (void)xb_add(&bar[XB_XCNT(b.x)], 1u);
    return b;
}
__device__ __forceinline__ void xcd_barrier_complete(unsigned* bar, unsigned x, unsigned& nloc, unsigned& nx) {
    const unsigned G = gridDim.x * gridDim.y * gridDim.z;
    unsigned sum, cnt, mine, sp = 0u;
    for (;;) {
        sum = 0u; cnt = 0u; mine = 0u;
#pragma unroll
        for (unsigned j = 0; j < 16; ++j) { const unsigned c = xb_ld(&bar[XB_XCNT(j)]); sum += c; cnt += (c > 0u) ? 1u : 0u; mine = (j == x) ? c : mine; }
        if (sum == G) break;
        __builtin_amdgcn_s_sleep(1);
        if ((++sp & 255u) == 0u) { if (xb_ld(&bar[XB_TMO])) break; if (sp > XB_SPIN_CAP) { atomicAdd(&bar[XB_TMO], 1u); break; } }
    }
    nloc = mine > 0u ? mine : 1u; nx = cnt > 0u ? cnt : 1u;
}
__device__ __forceinline__ void xcd_barrier(const XcdBarrier& b, int wave_id) {
    asm volatile("s_waitcnt vmcnt(0)" ::: "memory");
    __syncthreads();
    if (wave_id == 0 && lane_id_asm() == 0) {
        unsigned* bar = b.bar;
        __builtin_amdgcn_s_waitcnt(0);
        unsigned nloc = b.st[0], nx = b.st[1];
        if (nloc == 0u) { xcd_barrier_complete(bar, b.x, nloc, nx); b.st[0] = nloc; b.st[1] = nx; }
        const unsigned old = xb_add(&bar[XB_XSUB(b.x)], 1u);
        const unsigned gen = old / nloc;
        if (old + 1u == (gen + 1u) * nloc) {
            __builtin_amdgcn_fence(__ATOMIC_RELEASE, "agent");
            asm volatile("s_waitcnt vmcnt(0)" ::: "memory");
            const unsigned og = xb_add(&bar[XB_TOP], 1u);
            const unsigned tg = og / nx;
            if (og + 1u == (tg + 1u) * nx) xb_add(&bar[XB_TOPGEN], 1u);
            else XB_SPIN(xb_ld(&bar[XB_TOPGEN]) == tg, bar);
            __builtin_amdgcn_fence(__ATOMIC_ACQUIRE, "agent");
            xb_add(&bar[XB_XGEN(b.x)], 1u);
            asm volatile("s_waitcnt vmcnt(0)" ::: "memory");
        } else {
            XB_SPIN(xb_ld(&bar[XB_XGEN(b.x)]) == gen, bar);
            __builtin_amdgcn_fence(__ATOMIC_ACQUIRE, "agent");
            asm volatile("s_waitcnt vmcnt(0)" ::: "memory");
        }
    }
    __syncthreads();
}

using pg8::Unit; using pg8::HALF; using pg8::BM;
constexpr int RSBUF_OFF = 128 * 1024;
__device__ __forceinline__ float rs_of8(const f32x4 a, const f32x4 b) { return 1.0f / sqrtf((((a[0] + a[1]) + (a[2] + a[3])) + ((b[0] + b[1]) + (b[2] + b[3]))) * (1.0f / (float)DM) + EPS); }
__device__ __forceinline__ void ssq_row_store(float* p, float tot) { float z = 0.f; asm volatile("" : "+v"(z)); *(GAS f32x4*)p = (f32x4){tot, z, z, z}; *(GAS f32x4*)(p + 4) = (f32x4){z, z, z, z}; }
__device__ __forceinline__ void rs_prefetch(LAS unsigned char* ring, const float* ssq, const Unit& u, int tid) {
    const int wid = __builtin_amdgcn_readfirstlane(tid >> 6);
    __builtin_amdgcn_global_load_lds((const unsigned*)(ssq + (size_t)u.pm * (BM * 8) + tid * 4), (LAS unsigned*)(ring + RSBUF_OFF + u.par * 8192 + wid * 1024), 16, 0, 0);
}
__device__ __forceinline__ void rs_load8(LAS unsigned char* ring, const Unit& u, int wr, int fr, float (&rs)[2][4]) {
#pragma unroll
    for (int ai = 0; ai < 2; ++ai)
#pragma unroll
        for (int m = 0; m < 4; ++m) { const LAS f32x4* p = (const LAS f32x4*)(ring + RSBUF_OFF + u.par * 8192 + (wr * 64 + fr + ai * HALF + m * 16) * 32); rs[ai][m] = rs_of8(p[0], p[1]); }
}
struct EpiSwiGLU {
    static constexpr bool PRE = (MK_NFOLD != 0); static constexpr bool PERM = true;
    bf16* O; int ldc; const float* ssq; LAS unsigned char* ring;
    __device__ __forceinline__ void prefetch(LAS unsigned char* lds, const Unit& u, int tid) const { if (ssq) rs_prefetch(lds, ssq, u, tid); }
    __device__ __forceinline__ void operator()(const f32x4 (&acc)[2][2][4][2], const Unit& u, int wr, int wc, int fr, int fq) const {
        const int row0 = u.pm * BM + wr * 64 + fr, col0 = u.pn * HALF + wc * 32 + 8 * fq;
        float rs[2][4];
        if (ssq) rs_load8(ring, u, wr, fr, rs); else {
#pragma unroll
            for (int i = 0; i < 8; ++i) rs[i >> 2][i & 3] = 1.0f; }
#pragma unroll
        for (int ai = 0; ai < 2; ++ai) { if (u.half && ai != u.half - 1) continue;
#pragma unroll
            for (int m = 0; m < 4; ++m) {
                const int row = row0 + ai * HALF + m * 16;
                bf16* rowp = MK_BLK ? O + ((size_t)(row >> 8) * (DFF / 64) + (col0 >> 6)) * (256 * 64) + (row & 255) * 64 + (col0 & 63) : O + (size_t)row * ldc + col0;
                const f32x4 a0 = acc[ai][0][m][0] * rs[ai][m], a1 = acc[ai][0][m][1] * rs[ai][m], b0 = acc[ai][1][m][0] * rs[ai][m], b1 = acc[ai][1][m][1] * rs[ai][m];
                v4u w;
                w.x = cvtpk(silu_f(a0[0]) * b0[0], silu_f(a0[1]) * b0[1]); w.y = cvtpk(silu_f(a0[2]) * b0[2], silu_f(a0[3]) * b0[3]);
                w.z = cvtpk(silu_f(a1[0]) * b1[0], silu_f(a1[1]) * b1[1]); w.w = cvtpk(silu_f(a1[2]) * b1[2], silu_f(a1[3]) * b1[3]);
                *(GAS v4u*)rowp = w; } }
    }
};
struct EpiResid {
    static constexpr bool PRE = false; static constexpr bool PERM = false;
    float* H; int ldc; float scale; float* P; int pstride; const float* Hin; const float* Hin2;
    __device__ __forceinline__ void operator()(const f32x4 (&acc)[2][2][4][2], const Unit& u, int wr, int wc, int fr, int fq) const {
        const int row0 = u.pm * BM + wr * 64 + fr, col0 = u.pn * BM + wc * 32 + 4 * fq;
        if (u.part) {
#pragma unroll
            for (int ai = 0; ai < 2; ++ai)
#pragma unroll
                for (int m = 0; m < 4; ++m) { float* rowp = P + (size_t)((u.part - 1) * MS + (row0 + ai * HALF + m * 16 - MP)) * pstride + col0;
#pragma unroll
                    for (int bj = 0; bj < 2; ++bj)
#pragma unroll
                        for (int n = 0; n < 2; ++n) *(GAS f32x4*)(rowp + bj * HALF + n * 16) = scale * acc[ai][bj][m][n]; }
            return;
        }
#pragma unroll
        for (int ai = 0; ai < 2; ++ai) {
            f32x4 h[4][2][2];
#pragma unroll
            for (int m = 0; m < 4; ++m) { const int row = row0 + ai * HALF + m * 16; const float* rowp = (row < MP ? Hin + (size_t)row * ldc : Hin2 + (size_t)(row - MP) * ldc) + col0;
#pragma unroll
                for (int bj = 0; bj < 2; ++bj)
#pragma unroll
                    for (int n = 0; n < 2; ++n) h[m][bj][n] = *(const GAS f32x4*)(rowp + bj * HALF + n * 16); }
#pragma unroll
            for (int m = 0; m < 4; ++m) { float* rowp = H + (size_t)(row0 + ai * HALF + m * 16) * ldc + col0;
#pragma unroll
                for (int bj = 0; bj < 2; ++bj)
#pragma unroll
                    for (int n = 0; n < 2; ++n) *(GAS f32x4*)(rowp + bj * HALF + n * 16) = h[m][bj][n] + scale * acc[ai][bj][m][n]; }
            asm volatile("" ::: "memory"); }
    }
};
struct EpiResid2 {
    static constexpr bool PRE = false; static constexpr bool PERM = false;
    float* H; int ldc; float scale; float* P; int pstride; const float* Hin; const float* Hin2;
    bf16* HB; float* ssq; unsigned* cnt; LAS float* part;
    __device__ __forceinline__ void operator()(const f32x4 (&acc_)[2][2][4][2], const Unit& u, int wr, int wc, int fr_, int fq_) const {
        f32x4 (&acc)[2][2][4][2] = const_cast<f32x4 (&)[2][2][4][2]>(acc_);
        int fr = fr_, fq = fq_; asm volatile("" : "+v"(fr), "+v"(fq));
        const int row0 = u.pm * BM + wr * 64 + fr, col0 = u.pn * BM + wc * 32 + 4 * fq;
        const bool lead = (wr == 0 && wc == 0 && (fq * 16 + fr) == 0);
        if (u.part) {
#pragma unroll
            for (int ai = 0; ai < 2; ++ai)
#pragma unroll
                for (int m = 0; m < 4; ++m) { float* rowp = P + ((size_t)(u.part - 1) * MS + (row0 + ai * HALF + m * 16 - MP)) * pstride + col0;
#pragma unroll
                    for (int bj = 0; bj < 2; ++bj)
#pragma unroll
                        for (int n = 0; n < 2; ++n) *(GAS f32x4*)(rowp + bj * HALF + n * 16) = scale * acc[ai][bj][m][n]; }
            return;
        }
#pragma unroll
        for (int ai = 0; ai < 2; ++ai) {
            f32x4 h[4][2][2];
#pragma unroll
            for (int m = 0; m < 4; ++m) { const int row = row0 + ai * HALF + m * 16; const float* rowp = (row < MP ? Hin + (size_t)row * ldc : Hin2 + (size_t)(row - MP) * ldc) + col0;
#pragma unroll
                for (int bj = 0; bj < 2; ++bj)
#pragma unroll
                    for (int n = 0; n < 2; ++n) h[m][bj][n] = *(const GAS f32x4*)(rowp + bj * HALF + n * 16); }
#pragma unroll
            for (int m = 0; m < 4; ++m) { const int row = row0 + ai * HALF + m * 16; float* rowp = H + (size_t)row * ldc + col0; float s = 0.f;
#pragma unroll
                for (int bj = 0; bj < 2; ++bj) { const f32x4 v0 = h[m][bj][0] + scale * acc[ai][bj][m][0], v1 = h[m][bj][1] + scale * acc[ai][bj][m][1];
                    *(GAS f32x4*)(rowp + bj * HALF) = v0; *(GAS f32x4*)(rowp + bj * HALF + 16) = v1;
                    if (HB) { bf16* hb = HB + (size_t)row * ldc + col0 + bj * HALF; v2u w; w.x = cvtpk(v0[0], v0[1]); w.y = cvtpk(v0[2], v0[3]); *(GAS v2u*)hb = w; w.x = cvtpk(v1[0], v1[1]); w.y = cvtpk(v1[2], v1[3]); *(GAS v2u*)(hb + 16) = w; }
                    s += (v0[0] * v0[0] + v0[1] * v0[1]) + (v0[2] * v0[2] + v0[3] * v0[3]) + (v1[0] * v1[0] + v1[1] * v1[1]) + (v1[2] * v1[2] + v1[3] * v1[3]); }
                if (ssq) { const int ln_ = fq * 16 + fr; s += shfl_xor_l(s, 16, ln_); s += shfl_xor_l(s, 32, ln_);
                    if (fq == 0) part[(ai * HALF + wr * 64 + m * 16 + fr) * 4 + wc] = s; } }
            asm volatile("" ::: "memory"); }
        if (ssq) {
            asm volatile("s_waitcnt lgkmcnt(0)" ::: "memory"); __builtin_amdgcn_s_barrier(); asm volatile("" ::: "memory");
            const int t = (wr * 4 + wc) * 64 + fq * 16 + fr;
            if (t < 256) { const f32x4 p = *(const LAS f32x4*)(part + t * 4);
                ((GAS float*)ssq)[((size_t)u.pm * BM + t) * 8 + u.pn] = (p[0] + p[1]) + (p[2] + p[3]); }
        }
    }
};
struct EpiResid3 {
    static constexpr bool PRE = false; static constexpr bool PERM = true;
    float* Y; int ldc; float scale; float* P; int pstride; const float* Xin; const float* Xin2;
    bf16* HB; float* ssq; LAS float* part;
    __device__ __forceinline__ void operator()(const f32x4 (&acc)[2][2][4][2], const Unit& u, int wr, int wc, int fr_, int fq_) const {
        int fr = fr_, fq = fq_; asm volatile("" : "+v"(fr), "+v"(fq));
        constexpr bool TQE = (MK_TQ != 0);
        const int rbase = u.pm * (TQE ? 192 : BM), row0 = rbase + wr * 64 + fr, col0 = u.pn * BM + wc * 32 + 8 * fq;
#define ER3_MM(ai) (MK_TQ == 2 ? 3 : (TQE && (ai)) ? 2 : 4)
#define ER3_RT(ai, m) (MK_TQ == 2 ? (ai) * 96 + wr * 48 + (m) * 16 + fr : (ai) == 0 ? wr * 64 + (m) * 16 + fr : HALF + (TQE ? wr * 32 : wr * 64) + (m) * 16 + fr)
        if (u.part) {
#pragma unroll
            for (int ai = 0; ai < 2; ++ai)
#pragma unroll
                for (int m = 0; m < 4; ++m) { float* rowp = P + ((size_t)(u.part - 1) * MS + (row0 + ai * HALF + m * 16 - MP)) * pstride + col0;
#pragma unroll
                    for (int bj = 0; bj < 2; ++bj)
#pragma unroll
                        for (int n = 0; n < 2; ++n) *(GAS f32x4*)(rowp + bj * HALF + n * 4) = scale * acc[ai][bj][m][n]; }
            return;
        }
#pragma unroll
        for (int ai = 0; ai < 2; ++ai) {
            f32x4 r[4][2][2];
            if (Xin) {
#pragma unroll
                for (int m = 0; m < ER3_MM(ai); ++m) { const int row = rbase + ER3_RT(ai, m); const float* rowp = (row < MP ? Xin + (size_t)row * ldc : Xin2 + (size_t)(row - MP) * ldc) + col0;
#pragma unroll
                    for (int bj = 0; bj < 2; ++bj)
#pragma unroll
                        for (int n = 0; n < 2; ++n) r[m][bj][n] = *(const GAS f32x4*)(rowp + bj * HALF + n * 4); }
            } else { v4u hb[4][2];
#pragma unroll
                for (int m = 0; m < ER3_MM(ai); ++m)
#pragma unroll
                    for (int bj = 0; bj < 2; ++bj) hb[m][bj] = *(const GAS v4u*)(HB + (size_t)(rbase + ER3_RT(ai, m)) * ldc + col0 + bj * HALF);
#pragma unroll
                for (int m = 0; m < ER3_MM(ai); ++m)
#pragma unroll
                    for (int bj = 0; bj < 2; ++bj) { r[m][bj][0] = (f32x4){bflo(hb[m][bj].x), bfhi(hb[m][bj].x), bflo(hb[m][bj].y), bfhi(hb[m][bj].y)}; r[m][bj][1] = (f32x4){bflo(hb[m][bj].z), bfhi(hb[m][bj].z), bflo(hb[m][bj].w), bfhi(hb[m][bj].w)}; }
            }
#pragma unroll
            for (int m = 0; m < ER3_MM(ai); ++m) { const int row = rbase + ER3_RT(ai, m); float s = 0.f;
#pragma unroll
                for (int bj = 0; bj < 2; ++bj) { const f32x4 v0 = r[m][bj][0] + scale * acc[ai][bj][m][0], v1 = r[m][bj][1] + scale * acc[ai][bj][m][1];
                    if (Y) { float* yp = Y + (size_t)row * ldc + col0 + bj * HALF; *(GAS f32x4*)yp = v0; *(GAS f32x4*)(yp + 4) = v1; }
                    else { v4u w; w.x = cvtpk(v0[0], v0[1]); w.y = cvtpk(v0[2], v0[3]); w.z = cvtpk(v1[0], v1[1]); w.w = cvtpk(v1[2], v1[3]);
                        *(GAS v4u*)(HB + (size_t)row * ldc + col0 + bj * HALF) = w; }
                    s += (v0[0] * v0[0] + v0[1] * v0[1]) + (v0[2] * v0[2] + v0[3] * v0[3]) + (v1[0] * v1[0] + v1[1] * v1[1]) + (v1[2] * v1[2] + v1[3] * v1[3]); }
                if (ssq) { const int ln_ = fq * 16 + fr; s += shfl_xor_l(s, 16, ln_); s += shfl_xor_l(s, 32, ln_);
                    if (fq == 0) part[ER3_RT(ai, m) * 4 + wc] = s; } }
            asm volatile("" ::: "memory"); }
        if (ssq) {
            asm volatile("s_waitcnt lgkmcnt(0)" ::: "memory"); __builtin_amdgcn_s_barrier(); asm volatile("" ::: "memory");
            const int t = (wr * 4 + wc) * 64 + fq * 16 + fr;
            if (t < (TQE ? 192 : 256)) { const f32x4 p = *(const LAS f32x4*)(part + t * 4);
                ((GAS float*)ssq)[((size_t)rbase + t) * 8 + u.pn] = (p[0] + p[1]) + (p[2] + p[3]); }
        }
#undef ER3_MM
#undef ER3_RT
    }
};
struct EpiF32 {
    static constexpr bool PRE = false; static constexpr bool PERM = false;
    float* C; int ldc;
    __device__ __forceinline__ void operator()(const f32x4 (&acc)[2][2][4][2], const Unit& u, int wr, int wc, int fr, int fq) const {
        const int row0 = u.pm * BM + wr * 64 + fr, col0 = u.pn * BM + wc * 32 + 4 * fq;
#pragma unroll
        for (int ai = 0; ai < 2; ++ai)
#pragma unroll
            for (int m = 0; m < 4; ++m) { float* rowp = C + (size_t)(row0 + ai * HALF + m * 16) * ldc + col0;
#pragma unroll
                for (int bj = 0; bj < 2; ++bj)
#pragma unroll
                    for (int n = 0; n < 2; ++n) *(GAS f32x4*)(rowp + bj * HALF + n * 16) = acc[ai][bj][m][n]; }
    }
};
struct EpiBf16 {
    static constexpr bool PRE = false; static constexpr bool PERM = true;
    bf16* O; int ldc;
    __device__ __forceinline__ void operator()(const f32x4 (&acc)[2][2][4][2], const Unit& u, int wr, int wc, int fr, int fq) const {
        const int row0 = u.pm * BM + wr * 64 + fr, col0 = u.pn * BM + wc * 32 + 8 * fq;
#pragma unroll
        for (int ai = 0; ai < 2; ++ai)
#pragma unroll
            for (int m = 0; m < 4; ++m) { bf16* rowp = O + (size_t)(row0 + ai * HALF + m * 16) * ldc + col0;
#pragma unroll
                for (int bj = 0; bj < 2; ++bj) { const f32x4 v0 = acc[ai][bj][m][0], v1 = acc[ai][bj][m][1];
                    v4u w; w.x = cvtpk(v0[0], v0[1]); w.y = cvtpk(v0[2], v0[3]); w.z = cvtpk(v1[0], v1[1]); w.w = cvtpk(v1[2], v1[3]);
                    *(GAS v4u*)(rowp + bj * HALF) = w; } }
    }
};
struct EpiQlat {
    static constexpr bool PRE = (MK_NFOLD != 0); static constexpr bool PERM = true;
    bf16* O; int ldc; float* ssq; LAS float* part;
    const float* hssq; LAS unsigned char* ring;
    __device__ __forceinline__ void prefetch(LAS unsigned char* lds, const Unit& u, int tid) const { if (hssq) rs_prefetch(lds, hssq, u, tid); }
    __device__ __forceinline__ void operator()(const f32x4 (&acc)[2][2][4][2], const Unit& u, int wr, int wc, int fr, int fq) const {
        const int row0 = u.pm * BM + wr * 64 + fr, col0 = u.pn * BM + wc * 32 + 8 * fq;
        float rs[2][4];
        if (hssq) rs_load8(ring, u, wr, fr, rs); else {
#pragma unroll
            for (int i = 0; i < 8; ++i) rs[i >> 2][i & 3] = 1.0f; }
#pragma unroll
        for (int ai = 0; ai < 2; ++ai)
#pragma unroll
            for (int m = 0; m < 4; ++m) { const int row = row0 + ai * HALF + m * 16; bf16* rowp = O + (size_t)row * ldc + col0; float s = 0.f;
#pragma unroll
                for (int bj = 0; bj < 2; ++bj) { const f32x4 v0 = acc[ai][bj][m][0] * rs[ai][m], v1 = acc[ai][bj][m][1] * rs[ai][m];
                    v4u w; w.x = cvtpk(v0[0], v0[1]); w.y = cvtpk(v0[2], v0[3]); w.z = cvtpk(v1[0], v1[1]); w.w = cvtpk(v1[2], v1[3]);
                    *(GAS v4u*)(rowp + bj * HALF) = w;
                    s += (v0[0] * v0[0] + v0[1] * v0[1]) + (v0[2] * v0[2] + v0[3] * v0[3]) + (v1[0] * v1[0] + v1[1] * v1[1]) + (v1[2] * v1[2] + v1[3] * v1[3]); }
                { const int ln_ = fq * 16 + fr; s += shfl_xor_l(s, 16, ln_); s += shfl_xor_l(s, 32, ln_); }
                if (fq == 0) part[(ai * HALF + wr * 64 + m * 16 + fr) * 4 + wc] = s; }
        asm volatile("s_waitcnt lgkmcnt(0)" ::: "memory"); __builtin_amdgcn_s_barrier(); asm volatile("" ::: "memory");
        const int t = (wr * 4 + wc) * 64 + fq * 16 + fr;
        if (t < 256) { const f32x4 p = *(const LAS f32x4*)(part + t * 4); ssq[(size_t)(u.pm * BM + t) * 2 + u.pn] = (p[0] + p[1]) + (p[2] + p[3]); }
    }
};
struct EpiQraw {
    static constexpr bool PRE = false; static constexpr bool PERM = true;
    bf16* O; int ldc; const float* ssq;
    __device__ __forceinline__ void operator()(const f32x4 (&acc)[2][2][4][2], const Unit& u, int wr, int wc, int fr, int fq) const {
        const int row0 = u.pm * BM + wr * 64 + fr, col0 = u.pn * BM + wc * 32 + 8 * fq;
#pragma unroll
        for (int ai = 0; ai < 2; ++ai) { float rs[4];
#pragma unroll
            for (int m = 0; m < 4; ++m) { const int row = row0 + ai * HALF + m * 16; const GAS float* sp = (const GAS float*)ssq + (size_t)row * 2; rs[m] = 1.0f / sqrtf((sp[0] + sp[1]) * (1.0f / QLR) + EPS); }
#pragma unroll
            for (int m = 0; m < 4; ++m) { bf16* rowp = O + (size_t)(row0 + ai * HALF + m * 16) * ldc + col0;
#pragma unroll
                for (int bj = 0; bj < 2; ++bj) { const f32x4 v0 = acc[ai][bj][m][0] * rs[m], v1 = acc[ai][bj][m][1] * rs[m];
                    v4u w; w.x = cvtpk(v0[0], v0[1]); w.y = cvtpk(v0[2], v0[3]); w.z = cvtpk(v1[0], v1[1]); w.w = cvtpk(v1[2], v1[3]);
                    *(GAS v4u*)(rowp + bj * HALF) = w; } } }
    }
};
struct EpiKV {
    static constexpr bool PRE = false; static constexpr bool PERM = true;
    bf16* O; int ldc; float* rs; const float* ssqkr; LAS float* part;
    __device__ __forceinline__ void operator()(const f32x4 (&acc)[2][2][4][2], const Unit& u, int wr, int wc, int fr, int fq) const {
        const int row0 = u.pm * BM + wr * 64 + fr, col0 = u.pn * BM + wc * 32 + 8 * fq;
#pragma unroll
        for (int ai = 0; ai < 2; ++ai)
#pragma unroll
            for (int m = 0; m < 4; ++m) { const int row = row0 + ai * HALF + m * 16; bf16* rowp = O + (size_t)row * ldc + col0;
#pragma unroll
                for (int bj = 0; bj < 2; ++bj) { const f32x4 v0 = acc[ai][bj][m][0], v1 = acc[ai][bj][m][1];
                    v4u w; w.x = cvtpk(v0[0], v0[1]); w.y = cvtpk(v0[2], v0[3]); w.z = cvtpk(v1[0], v1[1]); w.w = cvtpk(v1[2], v1[3]);
                    *(GAS v4u*)(rowp + bj * HALF) = w; }
                const f32x4 k0 = acc[ai][0][m][0], k1 = acc[ai][0][m][1];
                float s = (k0[0] * k0[0] + k0[1] * k0[1]) + (k0[2] * k0[2] + k0[3] * k0[3]) + (k1[0] * k1[0] + k1[1] * k1[1]) + (k1[2] * k1[2] + k1[3] * k1[3]);
                { const int ln_ = fq * 16 + fr; s += shfl_xor_l(s, 16, ln_); s += shfl_xor_l(s, 32, ln_); }
                if (fq == 0) part[(ai * HALF + wr * 64 + m * 16 + fr) * 4 + wc] = s; }
        asm volatile("s_waitcnt lgkmcnt(0)" ::: "memory"); __builtin_amdgcn_s_barrier(); asm volatile("" ::: "memory");
        const int t = (wr * 4 + wc) * 64 + fq * 16 + fr;
        if (t < 256) { const f32x4 p = *(const LAS f32x4*)(part + t * 4); const int row = u.pm * BM + t;
            rs[(size_t)row * 16 + u.pn] = 1.0f / sqrtf(((p[0] + p[1]) + (p[2] + p[3]) + ((const GAS float*)ssqkr)[row]) * (1.0f / QKH) + EPS); }
    }
};
struct EpiRet {
    static constexpr bool PRE = (MK_NFOLD != 0); static constexpr bool PERM = true;
    bf16* O; int ldc; const float* cosT; const float* sinT;
    const float* ssq; LAS unsigned char* ring;
    __device__ __forceinline__ void prefetch(LAS unsigned char* lds, const Unit& u, int tid) const { if (ssq) rs_prefetch(lds, ssq, u, tid); }
    __device__ __forceinline__ void operator()(const f32x4 (&acc)[2][2][4][2], const Unit& u, int wr, int wc, int fr_, int fq_) const {
        int fr = fr_, fq = fq_; asm volatile("" : "+v"(fr), "+v"(fq));
        const int row0 = u.pm * BM + wr * 64 + fr, col0 = u.pn * BM + wc * 32 + 8 * fq, j0 = wc * 32 + 8 * fq;
        float rs[2][4];
        if (ssq) rs_load8(ring, u, wr, fr, rs); else {
#pragma unroll
            for (int i = 0; i < 8; ++i) rs[i >> 2][i & 3] = 1.0f; }
        if (u.pn < 16) {
            const int h = u.pn & 7; const bool isq = u.pn < 8; const float lg = lg2gamma(h);
#pragma unroll
            for (int ai = 0; ai < 2; ++ai) { if (u.half && ai != u.half - 1) continue;
                f32x4 c0[4], c1[4], s0[4], s1[4];
#pragma unroll
                for (int m = 0; m < 4; ++m) { const int row = row0 + ai * HALF + m * 16; const int pos = row < MP ? (row & (SEQ - 1)) : PAST + (row & (DSEQ - 1));
                    c0[m] = *(const GAS f32x4*)(cosT + pos * 128 + j0); c1[m] = *(const GAS f32x4*)(cosT + pos * 128 + j0 + 4);
                    s0[m] = *(const GAS f32x4*)(sinT + pos * 128 + j0); s1[m] = *(const GAS f32x4*)(sinT + pos * 128 + j0 + 4); }
#pragma unroll
                for (int m = 0; m < 4; ++m) { const int row = row0 + ai * HALF + m * 16; bf16* rowp = O + (size_t)row * ldc + col0;
                    const float e = (float)((row & 63) + 1) * lg;
                    const float fac = (isq ? __builtin_amdgcn_exp2f(e) * 0.0625f : __builtin_amdgcn_exp2f(-e)) * rs[ai][m];
                    const f32x4 x10 = acc[ai][0][m][0], x11 = acc[ai][0][m][1], x20 = acc[ai][1][m][0], x21 = acc[ai][1][m][1];
                    const f32x4 a0 = (x10 * c0[m] - x20 * s0[m]) * fac, a1 = (x11 * c1[m] - x21 * s1[m]) * fac, b0 = (x10 * s0[m] + x20 * c0[m]) * fac, b1 = (x11 * s1[m] + x21 * c1[m]) * fac;
                    v4u w; w.x = cvtpk(a0[0], a0[1]); w.y = cvtpk(a0[2], a0[3]); w.z = cvtpk(a1[0], a1[1]); w.w = cvtpk(a1[2], a1[3]);
                    *(GAS v4u*)rowp = w;
                    w.x = cvtpk(b0[0], b0[1]); w.y = cvtpk(b0[2], b0[3]); w.z = cvtpk(b1[0], b1[1]); w.w = cvtpk(b1[2], b1[3]);
                    *(GAS v4u*)(rowp + HALF) = w; }
                asm volatile("" ::: "memory"); }
        } else {
            const bool isg = u.pn >= 32;
#pragma unroll
            for (int ai = 0; ai < 2; ++ai) { if (u.half && ai != u.half - 1) continue;
#pragma unroll
                for (int m = 0; m < 4; ++m) { bf16* rowp = O + (size_t)(row0 + ai * HALF + m * 16) * ldc + col0;
#pragma unroll
                    for (int bj = 0; bj < 2; ++bj) { f32x4 v0 = acc[ai][bj][m][0] * rs[ai][m], v1 = acc[ai][bj][m][1] * rs[ai][m];
                        if (isg) {
#pragma unroll
                            for (int i = 0; i < 4; ++i) { v0[i] = silu_f(v0[i]); v1[i] = silu_f(v1[i]); } }
                        v4u w; w.x = cvtpk(v0[0], v0[1]); w.y = cvtpk(v0[2], v0[3]); w.z = cvtpk(v1[0], v1[1]); w.w = cvtpk(v1[2], v1[3]);
                        *(GAS v4u*)(rowp + bj * HALF) = w; } } }
        }
    }
};
struct Args { const float* in[25]; float* out; unsigned char* ws; int ph_lo, ph_hi, dry, pad; };
enum { I_XP = 0, I_XS, I_STATE, I_CCKV, I_CKR, I_F1N, I_F1IN, I_F1OUT, I_MIXN, I_F2N, I_F2IN, I_F2OUT, I_RIN, I_RGN, I_ROUT, I_KVN, I_WDKV, I_KVLN, I_WUKV, I_KN,
       I_WDQ, I_QLN, I_WUQ, I_QN, I_WO };
struct Frame { LAS unsigned char* lds; int tid, lane, wave, vcu, G; };

__device__ __forceinline__ int dst_row_map(int mode, int n) {
    if (mode == 1) { const int hf = n >= DFF ? 1 : 0; const int nn = n - hf * DFF; return (nn >> 7) * 256 + hf * 128 + (nn & 127); }
    return n;
}
template <int UNR = MK_CONVUNROLL>
__device__ __forceinline__ void conv_item(const float* W, int K, int N, bf16* WT, int mode, LAS float* scr, int item, int lane, int blocked = 0, const float* kgain = nullptr) {
    const int nblk = N >> 6, kb = item / nblk, nb = item - kb * nblk, k0 = 64 * kb, n0 = 64 * nb;
    const GAS float* src = (const GAS float*)W + (size_t)k0 * N + n0 + lane;
    f32x4 kg0 = {1.f, 1.f, 1.f, 1.f}, kg1 = kg0;
    if (kgain) { const GAS f32x4* gp = (const GAS f32x4*)(kgain + k0 + 8 * (lane & 7)); kg0 = gp[0]; kg1 = gp[1]; }
    if constexpr (UNR >= 64) { float t_[64];
#pragma unroll
        for (int i = 0; i < 64; ++i) t_[i] = src[(size_t)i * N];
#pragma unroll
        for (int i = 0; i < 64; ++i) scr[i * 65 + lane] = t_[i]; }
    else {
#pragma unroll UNR
        for (int i = 0; i < 64; ++i) scr[i * 65 + lane] = src[(size_t)i * N]; }
    LDS_WAIT(); asm volatile("" ::: "memory");
#if MK_WARMMFMA
    { f32x4 d_ = {0.f, 0.f, 0.f, 0.f}; bf16x8 z_ = {1, 2, 3, 4, 5, 6, 7, 8};
#pragma unroll
      for (int i = 0; i < MK_WARMMFMA; ++i) d_ = __builtin_amdgcn_mfma_f32_16x16x32_bf16(z_, z_, d_, 0, 0, 0);
      asm volatile("" :: "v"(d_)); }
#endif
    const int c = lane & 7;
#pragma unroll
    for (int j = 0; j < 8; ++j) { const int n = (lane >> 3) + 8 * j; const LAS float* s = scr + (8 * c) * 65 + n;
        v4u o; o.x = cvtpk(s[0 * 65] * kg0.x, s[1 * 65] * kg0.y); o.y = cvtpk(s[2 * 65] * kg0.z, s[3 * 65] * kg0.w); o.z = cvtpk(s[4 * 65] * kg1.x, s[5 * 65] * kg1.y); o.w = cvtpk(s[6 * 65] * kg1.z, s[7 * 65] * kg1.w);
        const int dr = dst_row_map(mode, n0 + n);
        *(GAS v4u*)(blocked ? WT + ((size_t)(dr >> 8) * (K >> 6) + kb) * (256 * 64) + (dr & 255) * 64 + 8 * c : WT + (size_t)dr * K + k0 + 8 * c) = o; }
    LDS_WAIT(); asm volatile("" ::: "memory");
}
template <int U>
__device__ __forceinline__ void cache_rows(const Args& A, const Frame& F, int w, int nw) {
    unsigned char* ws = A.ws;
    for (int r0 = w; r0 < NBS * PAST; r0 += U * nw) {
        f32x4 a[U], bb[U]; float kr[U], q2[U]; int kvrow[U];
#pragma unroll
        for (int q = 0; q < U; ++q) { const int r = (r0 + q * nw < NBS * PAST) ? r0 + q * nw : r0; const int b = r >> 10, s = r & (PAST - 1); kvrow[q] = MP + b * KVT + s;
            const GAS f32x4* src = (const GAS f32x4*)(A.in[I_CCKV] + (size_t)r * KVL) + 2 * F.lane; a[q] = src[0]; bb[q] = src[1];
            kr[q] = ((const GAS float*)A.in[I_CKR])[(size_t)r * ROPE + F.lane]; }
#pragma unroll
        for (int q = 0; q < U; ++q) q2[q] = kr[q] * kr[q];
#pragma unroll
        for (int o = 1; o < 64; o <<= 1) {
#pragma unroll
            for (int q = 0; q < U; ++q) q2[q] += shfl_xor_l(q2[q], o, F.lane); }
#pragma unroll
        for (int q = 0; q < U; ++q) { v4u wv; wv.x = cvtpk(a[q].x, a[q].y); wv.y = cvtpk(a[q].z, a[q].w); wv.z = cvtpk(bb[q].x, bb[q].y); wv.w = cvtpk(bb[q].z, bb[q].w);
            *((GAS v4u*)(ws + WS_CALL + (size_t)kvrow[q] * KVL * 2) + F.lane) = wv;
            ((GAS bf16*)(ws + WS_KRALL))[(size_t)kvrow[q] * ROPE + F.lane] = (bf16)(cvtpk(kr[q], 0.f) & 0xffffu);
            if (F.lane == 0) ((GAS float*)(ws + WS_SSQKR))[kvrow[q]] = q2[q]; } }
}
__device__ __forceinline__ void sincos_d(double a, float& s, float& c) {
    const double q = __builtin_rint(a * 0.63661977236758134308);
    double r = __builtin_fma(-q, 1.57079632679489655800e+00, a); r = __builtin_fma(-q, 6.12323399573676603587e-17, r);
    const double r2 = r * r;
    const double sp = r * (1.0 + r2 * (-1.0 / 6 + r2 * (1.0 / 120 + r2 * (-1.0 / 5040 + r2 * (1.0 / 362880 + r2 * (-1.0 / 39916800 + r2 * (1.0 / 6227020800.0)))))));
    const double cp = 1.0 + r2 * (-0.5 + r2 * (1.0 / 24 + r2 * (-1.0 / 720 + r2 * (1.0 / 40320 + r2 * (-1.0 / 3628800 + r2 * (1.0 / 479001600.0))))));
    const int qi = (int)q & 3;
    s = (float)(qi == 0 ? sp : qi == 1 ? cp : qi == 2 ? -sp : -cp);
    c = (float)(qi == 0 ? cp : qi == 1 ? -sp : qi == 2 ? -cp : sp);
}
__device__ __forceinline__ double powi_d(double r, int j) { double o = 1.0, b = r; for (int k = 0; k < 8; ++k) { if (j & (1 << k)) o *= b; b *= b; } return o; }

__device__ __forceinline__ void rms_row_2048(const float* xrow, const float* g, bf16* orow, float* hrow, int lane, const float* prow = nullptr, size_t pq = 0, float* ssqp = nullptr) {
    const GAS f32x4* xr = (const GAS f32x4*)xrow + lane;
    f32x4 v[8]; float s = 0.f;
#pragma unroll
    for (int j = 0; j < 8; ++j) v[j] = xr[64 * j];
    if (prow) {
#pragma unroll
        for (int q = 0; q < 4; ++q) { const GAS f32x4* pr = (const GAS f32x4*)(prow + q * pq) + lane;
#pragma unroll
            for (int j = 0; j < 8; ++j) v[j] += pr[64 * j]; }
    }
#pragma unroll
    for (int j = 0; j < 8; ++j) s += (v[j].x * v[j].x + v[j].y * v[j].y) + (v[j].z * v[j].z + v[j].w * v[j].w);
    if (ssqp) { const float tot = wave_sum(s, lane); GAS v2u* o8 = (GAS v2u*)orow + lane;
#pragma unroll
        for (int j = 0; j < 8; ++j) { v2u w; w.x = cvtpk(v[j].x, v[j].y); w.y = cvtpk(v[j].z, v[j].w); o8[64 * j] = w; }
        if (lane == 0) ssq_row_store(ssqp, tot); }
    else if (g) { const GAS f32x4* gr = (const GAS f32x4*)g + lane;
        const float rs = 1.0f / sqrtf(wave_sum(s, lane) * (1.0f / DM) + EPS);
        GAS v2u* o8 = (GAS v2u*)orow + lane;
#pragma unroll
        for (int j = 0; j < 8; ++j) { const f32x4 gg = gr[64 * j]; v2u w; w.x = cvtpk(v[j].x * rs * gg.x, v[j].y * rs * gg.y); w.y = cvtpk(v[j].z * rs * gg.z, v[j].w * rs * gg.w); o8[64 * j] = w; } }
    if (hrow) { GAS f32x4* hr = (GAS f32x4*)hrow + lane;
#pragma unroll
        for (int j = 0; j < 8; ++j) hr[64 * j] = v[j]; }
}
__device__ __forceinline__ void rms_row2_2048(const float* xa, const float* xb, const float* g, bf16* oa, bf16* ob, int lane, float* qa = nullptr, float* qb = nullptr) {
    const GAS f32x4* ra = (const GAS f32x4*)xa + lane; const GAS f32x4* rb = (const GAS f32x4*)xb + lane; const GAS f32x4* gr = (const GAS f32x4*)g + lane;
    f32x4 va[8], vb[8]; float sa = 0.f, sb = 0.f;
#pragma unroll
    for (int j = 0; j < 8; ++j) va[j] = ra[64 * j];
#pragma unroll
    for (int j = 0; j < 8; ++j) vb[j] = rb[64 * j];
#pragma unroll
    for (int j = 0; j < 8; ++j) { sa += (va[j].x * va[j].x + va[j].y * va[j].y) + (va[j].z * va[j].z + va[j].w * va[j].w); sb += (vb[j].x * vb[j].x + vb[j].y * vb[j].y) + (vb[j].z * vb[j].z + vb[j].w * vb[j].w); }
    GAS v2u* pa = (GAS v2u*)oa + lane; GAS v2u* pb = (GAS v2u*)ob + lane;
    if (qa) { const float ta = wave_sum(sa, lane), tb = wave_sum(sb, lane);
#pragma unroll
        for (int j = 0; j < 8; ++j) { v2u w; w.x = cvtpk(va[j].x, va[j].y); w.y = cvtpk(va[j].z, va[j].w); pa[64 * j] = w; w.x = cvtpk(vb[j].x, vb[j].y); w.y = cvtpk(vb[j].z, vb[j].w); pb[64 * j] = w; }
        if (lane == 0) { ssq_row_store(qa, ta); ssq_row_store(qb, tb); }
        return; }
    const float rsa = 1.0f / sqrtf(wave_sum(sa, lane) * (1.0f / DM) + EPS), rsb = 1.0f / sqrtf(wave_sum(sb, lane) * (1.0f / DM) + EPS);
#pragma unroll
    for (int j = 0; j < 8; ++j) { const f32x4 gg = gr[64 * j]; v2u w;
        w.x = cvtpk(va[j].x * rsa * gg.x, va[j].y * rsa * gg.y); w.y = cvtpk(va[j].z * rsa * gg.z, va[j].w * rsa * gg.w); pa[64 * j] = w;
        w.x = cvtpk(vb[j].x * rsb * gg.x, vb[j].y * rsb * gg.y); w.y = cvtpk(vb[j].z * rsb * gg.z, vb[j].w * rsb * gg.w); pb[64 * j] = w; }
}
__device__ __forceinline__ void norm_phase(const Frame& F, float* h, const float* g, bf16* xn, const float* P, int pstride, int dry, const float* hin_s = nullptr, float* ssq = nullptr) {
    const int gw = F.vcu * NWAVES + F.wave, NGW = F.G * NWAVES;
    int m0 = gw;
    if (MK_NORM2) for (; m0 + NGW < MP; m0 += 2 * NGW) rms_row2_2048(h + (size_t)m0 * DM, h + (size_t)(m0 + NGW) * DM, g, xn + (size_t)m0 * DM, xn + (size_t)(m0 + NGW) * DM, F.lane, ssq ? ssq + (size_t)m0 * 8 : nullptr, ssq ? ssq + (size_t)(m0 + NGW) * 8 : nullptr);
    for (int m = m0; m < MT; m += NGW) { const bool fix = P != nullptr && m >= MP && F.G == 256;
        rms_row_2048((fix && hin_s) ? hin_s + (size_t)(m - MP) * DM : h + (size_t)m * DM, g, xn + (size_t)m * DM, (fix && !dry) ? h + (size_t)m * DM : nullptr, F.lane, fix ? P + (size_t)(m - MP) * pstride : nullptr, (size_t)MS * pstride, ssq ? ssq + (size_t)m * 8 : nullptr); }
}
__device__ __forceinline__ void tail_fix_phase(const Frame& F, float* h, bf16* xn, const float* P, int pstride, const float* hin_s, float* ssq) {
    const int gw = F.vcu * NWAVES + F.wave, NGW = F.G * NWAVES;
    if (F.G != 256) return;
    for (int m = MP + gw; m < MT; m += NGW)
        rms_row_2048(hin_s ? hin_s + (size_t)(m - MP) * DM : h + (size_t)m * DM, nullptr, xn + (size_t)m * DM, h + (size_t)m * DM, F.lane, P + (size_t)(m - MP) * pstride, (size_t)MS * pstride, ssq + (size_t)m * 8);
}
__device__ __forceinline__ void tail_row_b(const float* xrow, bf16* hb, float* yrow, const float* prow, size_t pq, float* ssqp, int lane) {
    f32x4 v[8];
    if (xrow) { const GAS f32x4* xr = (const GAS f32x4*)xrow + lane;
#pragma unroll
        for (int j = 0; j < 8; ++j) v[j] = xr[64 * j]; }
    else { const GAS v2u* hr = (const GAS v2u*)hb + lane; v2u w[8];
#pragma unroll
        for (int j = 0; j < 8; ++j) w[j] = hr[64 * j];
#pragma unroll
        for (int j = 0; j < 8; ++j) v[j] = (f32x4){bflo(w[j].x), bfhi(w[j].x), bflo(w[j].y), bfhi(w[j].y)}; }
#pragma unroll
    for (int q = 0; q < 4; ++q) { const GAS f32x4* pr = (const GAS f32x4*)(prow + q * pq) + lane;
#pragma unroll
        for (int j = 0; j < 8; ++j) v[j] += pr[64 * j]; }
    if (yrow) { GAS f32x4* yr = (GAS f32x4*)yrow + lane;
#pragma unroll
        for (int j = 0; j < 8; ++j) yr[64 * j] = v[j];
        return; }
    float s = 0.f;
#pragma unroll
    for (int j = 0; j < 8; ++j) s += (v[j].x * v[j].x + v[j].y * v[j].y) + (v[j].z * v[j].z + v[j].w * v[j].w);
    const float tot = wave_sum(s, lane); GAS v2u* o8 = (GAS v2u*)hb + lane;
#pragma unroll
    for (int j = 0; j < 8; ++j) { v2u w; w.x = cvtpk(v[j].x, v[j].y); w.y = cvtpk(v[j].z, v[j].w); o8[64 * j] = w; }
    if (lane == 0) ssq_row_store(ssqp, tot);
}
__device__ __forceinline__ void tail_fix_phase_b(const Frame& F, bf16* xn, float* yout, const float* P, int pstride, const float* xin_s, float* ssq) {
    const int gw = F.vcu * NWAVES + F.wave, NGW = F.G * NWAVES;
    if (F.G != 256) return;
    for (int m = MP + gw; m < MT; m += NGW)
        tail_row_b(xin_s ? xin_s + (size_t)(m - MP) * DM : nullptr, xn + (size_t)m * DM, yout ? yout + (size_t)m * DM : nullptr, P + (size_t)(m - MP) * pstride, (size_t)MS * pstride, ssq ? ssq + (size_t)m * 8 : nullptr, F.lane);
}
__device__ __forceinline__ void fixup_phase(const Frame& F, float* h, const float* P, int pstride, int dry) {
    const int gw = F.vcu * NWAVES + F.wave, NGW = F.G * NWAVES;
    if (F.G != 256) return;
    for (int m = MP + gw; m < MT; m += NGW) rms_row_2048(h + (size_t)m * DM, nullptr, nullptr, dry ? nullptr : h + (size_t)m * DM, F.lane, P + (size_t)(m - MP) * pstride, (size_t)MS * pstride);
}
__device__ __forceinline__ int kv_row_of_token(int tok) { return tok < MP ? tok : MP + ((tok - MP) >> 6) * KVT + PAST + (tok & 63); }
__device__ __forceinline__ int pos_of_token(int tok) { return tok < MP ? (tok & (SEQ - 1)) : PAST + (tok & (DSEQ - 1)); }

__device__ __forceinline__ void p0_prologue(const Args& A, const Frame& F) {
    unsigned char* ws = A.ws;
    const int gw = F.vcu * NWAVES + F.wave, NGW = F.G * NWAVES;
    LAS float* scr = (LAS float*)(F.lds + RING_OFF + F.wave * 16640);
    int base = 0;
#if MK_PRETOUCH
    {
        const size_t gt_ = (size_t)(gw * 64 + F.lane), NGT_ = (size_t)NGW * 64; unsigned acc_ = 0;
#define TOUCH(ptr, bytes) do { const GAS unsigned char* p_ = (const GAS unsigned char*)(ptr); for (size_t o_ = gt_ * 4096; o_ < (size_t)(bytes); o_ += NGT_ * 4096) acc_ += *(const GAS unsigned*)(p_ + o_); } while (0)
        TOUCH(ws, WS_END); TOUCH(A.out, OUT_END * 4);
        TOUCH(A.in[I_XP], (size_t)MP * DM * 4); TOUCH(A.in[I_XS], (size_t)MS * DM * 4); TOUCH(A.in[I_STATE], (size_t)NBS * RH * RDK * RDV * 4); TOUCH(A.in[I_CCKV], (size_t)NBS * PAST * KVL * 4); TOUCH(A.in[I_CKR], (size_t)NBS * PAST * ROPE * 4);
        TOUCH(A.in[I_F1IN], (size_t)2 * DM * 2 * DFF * 4); TOUCH(A.in[I_F2IN], (size_t)2 * DM * 2 * DFF * 4); TOUCH(A.in[I_F1OUT], (size_t)2 * DFF * DM * 4); TOUCH(A.in[I_F2OUT], (size_t)2 * DFF * DM * 4);
        TOUCH(A.in[I_RIN], (size_t)DM * RIN * 4); TOUCH(A.in[I_ROUT], (size_t)RHV * DM * 4); TOUCH(A.in[I_WO], (size_t)DM * DM * 4); TOUCH(A.in[I_WUKV], (size_t)KVL * KVW * 4);
#undef TOUCH
        if (acc_ == 0x9e3779b9u && gt_ == 0x7ffffffful) ((GAS unsigned*)ws)[1] = acc_;
    }
#endif
#define CONV(Wp, Kk, Nn, dst, mode) CONVG(Wp, Kk, Nn, dst, mode, 0, nullptr)
#define CONVB(Wp, Kk, Nn, dst, mode, blk) CONVG(Wp, Kk, Nn, dst, mode, blk, nullptr)
#define CONVG(Wp, Kk, Nn, dst, mode, blk, kg) do { const int nitems = ((Kk) >> 6) * ((Nn) >> 6); \
        for (int it = ((gw - base) % NGW + NGW) % NGW; it < nitems; it += NGW) conv_item((Wp), (Kk), (Nn), (bf16*)(ws + (dst)), (mode), scr, it, F.lane, (blk), (kg)); base = (base + nitems) % NGW; } while (0)
    CONVG(A.in[I_F1IN], DM, 2 * DFF, WS_WIN00, 1, 0, MK_NFOLD ? A.in[I_F1N] : nullptr);
    const bool defer = MK_DEFER && F.G == 256, defer2 = MK_DEFER == 2 && F.G == 256;
    if (!defer) CONVG(A.in[I_F1IN] + (size_t)DM * 2 * DFF, DM, 2 * DFF, WS_WIN10, 1, 0, MK_NFOLD ? A.in[I_F1N] + DM : nullptr);
    if (!defer2) CONVG(A.in[I_F2IN], DM, 2 * DFF, WS_WIN01, 1, 0, MK_NFOLD ? A.in[I_F2N] : nullptr);
    if (!defer) CONVG(A.in[I_F2IN] + (size_t)DM * 2 * DFF, DM, 2 * DFF, WS_WIN11, 1, 0, MK_NFOLD ? A.in[I_F2N] + DM : nullptr);
    if (!defer2) CONVB(A.in[I_F1OUT], DFF, DM, WS_WOUT00, 0, MK_BLK);
    if (!defer) CONVB(A.in[I_F1OUT] + (size_t)DFF * DM, DFF, DM, WS_WOUT10, 0, MK_BLK);
    if (!defer2) CONVB(A.in[I_F2OUT], DFF, DM, WS_WOUT01, 0, MK_BLK);
    if (!defer) CONVB(A.in[I_F2OUT] + (size_t)DFF * DM, DFF, DM, WS_WOUT11, 0, MK_BLK);
    if (!defer2) CONVG(A.in[I_RIN], DM, RIN, WS_WRIN, 0, 0, MK_NFOLD ? A.in[I_MIXN] : nullptr);
    if (!defer2) CONV(A.in[I_ROUT], RHV, DM, WS_WROUT, 0);
    if (!defer2) CONVG(A.in[I_WDKV], DM, KVL + ROPE, WS_WDKV, 0, 0, MK_NFOLD ? A.in[I_KVN] : nullptr);
    if (!defer2) CONV(A.in[I_WUKV], KVL, KVW, WS_WUKV, 0);
    if (!defer2) CONVG(A.in[I_WDQ], DM, QLR, WS_WDQ, 0, 0, MK_NFOLD ? A.in[I_MIXN] + DM : nullptr);
    if (!defer2) CONVG(A.in[I_WUQ], QLR, QW, WS_WUQ, 0, 0, MK_QLFUSE ? A.in[I_QLN] : nullptr);
    if (!defer2) CONV(A.in[I_WO], DM, DM, WS_WO, 0);
#undef CONV
#undef CONVB
#undef CONVG
    const int gt = gw * 64 + F.lane, NGT = NGW * 64;
    for (int i = gt; i < (DKVP - KVL - ROPE) * DM / 8; i += NGT) *((GAS v4u*)(ws + WS_WDKV + (size_t)(KVL + ROPE) * DM * 2) + i) = (v4u){0u, 0u, 0u, 0u};
    for (int i = gt; i < 2048 * 128; i += NGT) { const int pos = i >> 7, j = i & 127; float s, c; sincos_d((double)pos * powi_d(0.930572040929699, j), s, c);
        ((GAS float*)(ws + WS_COSR))[i] = c; ((GAS float*)(ws + WS_SINR))[i] = s; }
    for (int i = gt; i < 2048 * 32; i += NGT) { const int pos = i >> 5, j = i & 31; float s, c; sincos_d((double)pos * powi_d(0.7498942093324559, j), s, c);
        ((GAS float*)(ws + WS_COSM))[i] = c; ((GAS float*)(ws + WS_SINM))[i] = s; }
    if (gt < QKH) ((GAS float*)(ws + WS_GQK))[gt] = A.in[I_QN][gt] * A.in[I_KN][gt] * 0.10411754627697264f;
    if (!(MK_DEFCACHE && F.G == 256)) cache_rows<2>(A, F, gw, NGW);
    { int m0 = gw;
      float* q0 = MK_NFOLD ? (float*)(ws + WS_SSQH) : nullptr;
      for (; m0 + NGW < MP; m0 += 2 * NGW) rms_row2_2048(A.in[I_XP] + (size_t)m0 * DM, A.in[I_XP] + (size_t)(m0 + NGW) * DM, A.in[I_F1N], (bf16*)(ws + WS_XN) + (size_t)m0 * DM, (bf16*)(ws + WS_XN) + (size_t)(m0 + NGW) * DM, F.lane, q0 ? q0 + (size_t)m0 * 8 : nullptr, q0 ? q0 + (size_t)(m0 + NGW) * 8 : nullptr);
      for (int m = m0; m < MT; m += NGW) { const float* xrow = m < MP ? A.in[I_XP] + (size_t)m * DM : A.in[I_XS] + (size_t)(m - MP) * DM;
        rms_row_2048(xrow, A.in[I_F1N], (bf16*)(ws + WS_XN) + (size_t)m * DM, nullptr, F.lane, nullptr, 0, q0 ? q0 + (size_t)m * 8 : nullptr); } }
}

struct DefD { const float* W; int K, N; bf16* WT; int mode, blocked; const float* kg; int item; };
__device__ __forceinline__ void conv_load64(const DefD& d, int lane, float (&t)[64], f32x4 (&kg)[2]) {
    const int nblk = d.N >> 6, kb = d.item / nblk, nb = d.item - kb * nblk, k0 = 64 * kb, n0 = 64 * nb;
    const GAS float* src = (const GAS float*)d.W + (size_t)k0 * d.N + n0 + lane;
#pragma unroll
    for (int i = 0; i < 64; ++i) t[i] = MK_DEFNT ? __builtin_nontemporal_load(src + (size_t)i * d.N) : src[(size_t)i * d.N];
    kg[0] = (f32x4){1.f, 1.f, 1.f, 1.f}; kg[1] = kg[0];
    if (d.kg) { const GAS f32x4* gp = (const GAS f32x4*)(d.kg + k0 + 8 * (lane & 7)); kg[0] = gp[0]; kg[1] = gp[1]; }
}
__device__ __forceinline__ void conv_finish64(const DefD& d, LAS float* scr, int lane, const float (&t)[64], const f32x4 (&kg)[2]) {
    const int nblk = d.N >> 6, kb = d.item / nblk, nb = d.item - kb * nblk, k0 = 64 * kb, n0 = 64 * nb;
#pragma unroll
    for (int i = 0; i < 64; ++i) scr[i * 65 + lane] = t[i];
    LDS_WAIT(); asm volatile("" ::: "memory");
    const int c = lane & 7;
#pragma unroll
    for (int j = 0; j < 8; ++j) { const int n = (lane >> 3) + 8 * j; const LAS float* s = scr + (8 * c) * 65 + n;
        v4u o; o.x = cvtpk(s[0 * 65] * kg[0].x, s[1 * 65] * kg[0].y); o.y = cvtpk(s[2 * 65] * kg[0].z, s[3 * 65] * kg[0].w); o.z = cvtpk(s[4 * 65] * kg[1].x, s[5 * 65] * kg[1].y); o.w = cvtpk(s[6 * 65] * kg[1].z, s[7 * 65] * kg[1].w);
        const int dr = dst_row_map(d.mode, n0 + n);
        GAS v4u* op = (GAS v4u*)(d.blocked ? d.WT + ((size_t)(dr >> 8) * (d.K >> 6) + kb) * (256 * 64) + (dr & 255) * 64 + 8 * c : d.WT + (size_t)dr * d.K + k0 + 8 * c);
        if (MK_DEFNT) __builtin_nontemporal_store(o, op); else *op = o; }
    LDS_WAIT(); asm volatile("" ::: "memory");
}
__device__ __forceinline__ void conv_deferred(const Args& A, const Frame& F, int slot) {
    if (!(MK_DEFER && F.G == 256)) return;
    unsigned char* ws = A.ws; LAS float* scr = (LAS float*)(F.lds + RING_OFF + F.wave * 16640);
#if MK_DEFER == 2
    if (slot > 5) return;
    const int first = slot == 1 ? 128 : slot == 4 ? 144 : 96;
    const int q0 = slot == 0 ? 0 : slot == 1 ? 8960 : slot == 2 ? 16640 : slot == 3 ? 25376 : slot == 4 ? 30368 : 36000, q1 = slot == 0 ? 8960 : slot == 1 ? 16640 : slot == 2 ? 25376 : slot == 3 ? 30368 : slot == 4 ? 36000 : 38816;
    const int qm = q0 + (int)((long)(q1 - q0) * (slot == 0 ? MK_DEFSPLIT0 : slot == 1 ? MK_DEFSPLIT1 : slot == 2 ? MK_DEFSPLIT2 : slot == 3 ? MK_DEFSPLIT3 : MK_DEFSPLIT4) / 1000);
    const int vrank = MK_XTAIL ? ((int)blockIdx.x % 8) * 32 + (int)blockIdx.x / 8 : (int)blockIdx.x;
    const bool idle = vrank >= first;
    const int nidle = idle ? 256 - first : first, r = idle ? vrank - first : vrank, s0 = idle ? q0 : qm, s1 = idle ? qm : q1;
    auto desc = [&](int it) -> DefD {
        if (it < 2816) return DefD{A.in[I_F1OUT], DFF, DM, (bf16*)(ws + WS_WOUT00), 0, MK_BLK, nullptr, it};
        if (it < 8960) return DefD{A.in[I_RIN], DM, RIN, (bf16*)(ws + WS_WRIN), 0, 0, MK_NFOLD ? A.in[I_MIXN] : nullptr, it - 2816};
        if (it < 11008) return DefD{A.in[I_ROUT], RHV, DM, (bf16*)(ws + WS_WROUT), 0, 0, nullptr, it - 8960};
        if (it < 16640) return DefD{A.in[I_F2IN], DM, 2 * DFF, (bf16*)(ws + WS_WIN01), 1, 0, MK_NFOLD ? A.in[I_F2N] : nullptr, it - 11008};
        if (it < 19456) return DefD{A.in[I_F2OUT], DFF, DM, (bf16*)(ws + WS_WOUT01), 0, MK_BLK, nullptr, it - 16640};
        if (it < 19744) return DefD{A.in[I_WDKV], DM, KVL + ROPE, (bf16*)(ws + WS_WDKV), 0, 0, MK_NFOLD ? A.in[I_KVN] : nullptr, it - 19456};
        if (it < 25376) return DefD{A.in[I_F1IN] + (size_t)DM * 2 * DFF, DM, 2 * DFF, (bf16*)(ws + WS_WIN10), 1, 0, MK_NFOLD ? A.in[I_F1N] + DM : nullptr, it - 19744};
        if (it < 28192) return DefD{A.in[I_F1OUT] + (size_t)DFF * DM, DFF, DM, (bf16*)(ws + WS_WOUT10), 0, MK_BLK, nullptr, it - 25376};
        if (it < 28448) return DefD{A.in[I_WDQ], DM, QLR, (bf16*)(ws + WS_WDQ), 0, 0, MK_NFOLD ? A.in[I_MIXN] + DM : nullptr, it - 28192};
        if (it < 28832) return DefD{A.in[I_WUQ], QLR, QW, (bf16*)(ws + WS_WUQ), 0, 0, MK_QLFUSE ? A.in[I_QLN] : nullptr, it - 28448};
        if (it < 29344) return DefD{A.in[I_WUKV], KVL, KVW, (bf16*)(ws + WS_WUKV), 0, 0, nullptr, it - 28832};
        if (it < 30368) return DefD{A.in[I_WO], DM, DM, (bf16*)(ws + WS_WO), 0, 0, nullptr, it - 29344};
        if (it < 36000) return DefD{A.in[I_F2IN] + (size_t)DM * 2 * DFF, DM, 2 * DFF, (bf16*)(ws + WS_WIN11), 1, 0, MK_NFOLD ? A.in[I_F2N] + DM : nullptr, it - 30368};
        return DefD{A.in[I_F2OUT] + (size_t)DFF * DM, DFF, DM, (bf16*)(ws + WS_WOUT11), 0, MK_BLK, nullptr, it - 36000}; };
    int it = s0 + r * NWAVES + F.wave; const int st = nidle * NWAVES;
    if (it >= s1) return;
    float ta[64]; f32x4 ka[2]; DefD d = desc(it); conv_load64(d, F.lane, ta, ka);
    for (;;) { const int itn = it + st; const bool more = itn < s1; DefD dn = d; float tb[64]; f32x4 kb[2];
        if (more) { dn = desc(itn); conv_load64(dn, F.lane, tb, kb); }
        conv_finish64(d, scr, F.lane, ta, ka);
        if (!more) break;
#pragma unroll
        for (int i = 0; i < 64; ++i) ta[i] = tb[i];
        ka[0] = kb[0]; ka[1] = kb[1]; d = dn; it = itn; }
#else
    if (slot > 3) return;
    const int first = slot == 1 ? 128 : 96, nidle = 256 - first, r = (int)blockIdx.x - first;
    if (r < 0) return;
    const int s0 = slot == 0 ? 0 : slot == 1 ? 5120 : slot == 2 ? 9216 : 14336, s1 = slot == 0 ? 5120 : slot == 1 ? 9216 : slot == 2 ? 14336 : 16896;
    for (int it = s0 + r * NWAVES + F.wave; it < s1; it += nidle * NWAVES) {
        if (it < 5632) conv_item<MK_DEFUNROLL>(A.in[I_F1IN] + (size_t)DM * 2 * DFF, DM, 2 * DFF, (bf16*)(ws + WS_WIN10), 1, scr, it, F.lane, 0, MK_NFOLD ? A.in[I_F1N] + DM : nullptr);
        else if (it < 8448) conv_item<MK_DEFUNROLL>(A.in[I_F1OUT] + (size_t)DFF * DM, DFF, DM, (bf16*)(ws + WS_WOUT10), 0, scr, it - 5632, F.lane, MK_BLK, nullptr);
        else if (it < 14080) conv_item<MK_DEFUNROLL>(A.in[I_F2IN] + (size_t)DM * 2 * DFF, DM, 2 * DFF, (bf16*)(ws + WS_WIN11), 1, scr, it - 8448, F.lane, 0, MK_NFOLD ? A.in[I_F2N] + DM : nullptr);
        else conv_item<MK_DEFUNROLL>(A.in[I_F2OUT] + (size_t)DFF * DM, DFF, DM, (bf16*)(ws + WS_WOUT11), 0, scr, it - 14080, F.lane, MK_BLK, nullptr);
    }
#endif
}
static_assert((DM / 64) * (2 * DFF / 64) == 5632 && (DFF / 64) * (DM / 64) == 2816 && (DM / 64) * (RIN / 64) == 6144 && (RHV / 64) * (DM / 64) == 2048 && (DM / 64) * ((KVL + ROPE) / 64) == 288
              && (DM / 64) * (QLR / 64) == 256 && (QLR / 64) * (QW / 64) == 384 && (KVL / 64) * (KVW / 64) == 512 && (DM / 64) * (DM / 64) == 1024, "deferred item counts");

__device__ __forceinline__ void gn_gate_phase(const Args& A, const Frame& F) {
    const int gw = F.vcu * NWAVES + F.wave, NGW = F.G * NWAVES; bf16* QKVG = (bf16*)(A.ws + WS_BIG);
    for (int it = gw; it < MT * 2; it += NGW) { const int tok = it >> 1, h0 = (it & 1) * 4;
        bf16* op = QKVG + (size_t)tok * RIN + 4096 + h0 * RDV + 8 * F.lane;
        v4u ow[4], gv[4];
#pragma unroll
        for (int q = 0; q < 4; ++q) { ow[q] = *(const GAS v4u*)(op + q * RDV); gv[q] = *(const GAS v4u*)(op + q * RDV + 4096); }
        float x[4][8], s[4];
#pragma unroll
        for (int q = 0; q < 4; ++q) { x[q][0] = bflo(ow[q].x); x[q][1] = bfhi(ow[q].x); x[q][2] = bflo(ow[q].y); x[q][3] = bfhi(ow[q].y); x[q][4] = bflo(ow[q].z); x[q][5] = bfhi(ow[q].z); x[q][6] = bflo(ow[q].w); x[q][7] = bfhi(ow[q].w);
            s[q] = ((x[q][0] + x[q][1]) + (x[q][2] + x[q][3])) + ((x[q][4] + x[q][5]) + (x[q][6] + x[q][7])); }
#pragma unroll
        for (int o = 1; o < 64; o <<= 1) {
#pragma unroll
            for (int q = 0; q < 4; ++q) s[q] += shfl_xor_l(s[q], o, F.lane); }
        float v[4];
#pragma unroll
        for (int q = 0; q < 4; ++q) { const float mu = s[q] * (1.0f / RDV); v[q] = 0.f;
#pragma unroll
            for (int i = 0; i < 8; ++i) { x[q][i] -= mu; v[q] += x[q][i] * x[q][i]; } }
#pragma unroll
        for (int o = 1; o < 64; o <<= 1) {
#pragma unroll
            for (int q = 0; q < 4; ++q) v[q] += shfl_xor_l(v[q], o, F.lane); }
#pragma unroll
        for (int q = 0; q < 4; ++q) { const float rstd = 1.0f / sqrtf(v[q] * (1.0f / RDV) + EPS);
            const GAS f32x4* gp = (const GAS f32x4*)(A.in[I_RGN] + (h0 + q) * RDV + 8 * F.lane); const f32x4 g0 = gp[0], g1 = gp[1];
            const float gg[8] = {g0.x, g0.y, g0.z, g0.w, g1.x, g1.y, g1.z, g1.w};
            const float sg[8] = {bflo(gv[q].x), bfhi(gv[q].x), bflo(gv[q].y), bfhi(gv[q].y), bflo(gv[q].z), bfhi(gv[q].z), bflo(gv[q].w), bfhi(gv[q].w)};
            float y[8];
#pragma unroll
            for (int i = 0; i < 8; ++i) y[i] = sg[i] * (x[q][i] * rstd * gg[i]);
            v4u w; w.x = cvtpk(y[0], y[1]); w.y = cvtpk(y[2], y[3]); w.z = cvtpk(y[4], y[5]); w.w = cvtpk(y[6], y[7]);
            if (!A.dry) *(GAS v4u*)(op + q * RDV) = w; }
    }
}

__device__ __forceinline__ void latent_phase(const Args& A, const Frame& F) {
    const int gw = F.vcu * NWAVES + F.wave, NGW = F.G * NWAVES; unsigned char* ws = A.ws;
    constexpr int U = MK_NFOLD ? 3 : 1;
    const f32x4 ga = ((const GAS f32x4*)A.in[I_KVLN])[F.lane], gb = ((const GAS f32x4*)A.in[I_KVLN])[64 + F.lane];
    const int j = F.lane & 31;
    for (int tok0 = gw; tok0 < MT; tok0 += U * NGW) {
        f32x4 a[U], b[U], q0[U], q1[U]; float x1[U], x2[U], cs[U], sn[U]; int tokq[U];
#pragma unroll
        for (int q = 0; q < U; ++q) { const int tok = (tok0 + q * NGW < MT) ? tok0 + q * NGW : tok0; tokq[q] = tok;
            const GAS float* row = (const GAS float*)(ws + WS_SMALL) + (size_t)tok * DKVP;
            a[q] = ((const GAS f32x4*)row)[F.lane]; b[q] = ((const GAS f32x4*)row)[64 + F.lane];
            q0[q] = (f32x4){0.f, 0.f, 0.f, 0.f}; q1[q] = q0[q];
            if (MK_NFOLD) { const GAS f32x4* qp = (const GAS f32x4*)(ws + WS_SSQH + 3 * SSQH_STRIDE) + (size_t)tok * 2; q0[q] = qp[0]; q1[q] = qp[1]; }
            x1[q] = row[KVL + j]; x2[q] = row[KVL + 32 + j];
            const int pos = pos_of_token(tok);
            cs[q] = ((const GAS float*)(ws + WS_COSM))[pos * 32 + j]; sn[q] = ((const GAS float*)(ws + WS_SINM))[pos * 32 + j]; }
#pragma unroll
        for (int q = 0; q < U; ++q) { const int tok = tokq[q];
            float rsh = 1.0f;
            if (MK_NFOLD) { rsh = rs_of8(q0[q], q1[q]); a[q] *= rsh; b[q] *= rsh; }
            const f32x4 av = a[q], bv = b[q];
            const float ss = wave_sum((av.x * av.x + av.y * av.y) + (av.z * av.z + av.w * av.w) + (bv.x * bv.x + bv.y * bv.y) + (bv.z * bv.z + bv.w * bv.w), F.lane);
            const float rs = 1.0f / sqrtf(ss * (1.0f / KVL) + EPS);
            const f32x4 ca = av * rs * ga, cb = bv * rs * gb;
            float* cout = tok < MP ? A.out + OUT_CKVP + (size_t)tok * KVL : A.out + OUT_CKVS + (size_t)(tok - MP) * KVL;
            if (!A.dry) { ((GAS f32x4*)cout)[F.lane] = ca; ((GAS f32x4*)cout)[64 + F.lane] = cb; }
            const int kvrow = kv_row_of_token(tok);
            GAS v2u* cb16 = (GAS v2u*)(ws + WS_CALL + (size_t)kvrow * KVL * 2);
            v2u w; w.x = cvtpk(ca.x, ca.y); w.y = cvtpk(ca.z, ca.w); cb16[F.lane] = w; w.x = cvtpk(cb.x, cb.y); w.y = cvtpk(cb.z, cb.w); cb16[64 + F.lane] = w;
            const float y1 = x1[q] * rsh, y2 = x2[q] * rsh;
            const float o1 = y1 * cs[q] - y2 * sn[q], o2 = y1 * sn[q] + y2 * cs[q];
            float* kout = tok < MP ? A.out + OUT_KRP + (size_t)tok * ROPE : A.out + OUT_KRS + (size_t)(tok - MP) * ROPE;
            GAS bf16* kb = (GAS bf16*)(ws + WS_KRALL) + (size_t)kvrow * ROPE;
            if (F.lane < 32 && !A.dry) { ((GAS float*)kout)[j] = o1; ((GAS float*)kout)[32 + j] = o2; kb[j] = (bf16)(cvtpk(o1, 0.f) & 0xffffu); kb[32 + j] = (bf16)(cvtpk(o2, 0.f) & 0xffffu); }
            const float qq = wave_sum(F.lane < 32 ? (o1 * o1 + o2 * o2) : 0.f, F.lane);
            if (F.lane == 0) ((GAS float*)(ws + WS_SSQKR))[kvrow] = qq;
            if (!MK_NFOLD) rms_row_2048(A.out + (size_t)tok * DM, A.in[I_F1N] + DM, (bf16*)(ws + WS_XN) + (size_t)tok * DM, nullptr, F.lane); }
    }
}
__device__ __forceinline__ void qlat_norm_phase(const Args& A, const Frame& F) {
    const int gw = F.vcu * NWAVES + F.wave, NGW = F.G * NWAVES; unsigned char* ws = A.ws;
    for (int tok = gw; tok < MT; tok += NGW) {
        const GAS f32x4* row = (const GAS f32x4*)(ws + WS_SMALL) + (size_t)tok * (QLR / 4);
        const f32x4 a = row[F.lane], b = row[64 + F.lane];
        const float ss = wave_sum((a.x * a.x + a.y * a.y) + (a.z * a.z + a.w * a.w) + (b.x * b.x + b.y * b.y) + (b.z * b.z + b.w * b.w), F.lane);
        const float rs = 1.0f / sqrtf(ss * (1.0f / QLR) + EPS);
        const f32x4 ga = ((const GAS f32x4*)A.in[I_QLN])[F.lane], gb = ((const GAS f32x4*)A.in[I_QLN])[64 + F.lane];
        const f32x4 ca = a * rs * ga, cb = b * rs * gb;
        GAS v2u* o = (GAS v2u*)(ws + WS_QLN + (size_t)tok * QLR * 2);
        v2u w; w.x = cvtpk(ca.x, ca.y); w.y = cvtpk(ca.z, ca.w); o[F.lane] = w; w.x = cvtpk(cb.x, cb.y); w.y = cvtpk(cb.z, cb.w); o[64 + F.lane] = w;
    }
}
__device__ __forceinline__ void qfin_phase(const Args& A, const Frame& F) {
    const int gw = F.vcu * NWAVES + F.wave, NGW = F.G * NWAVES; unsigned char* ws = A.ws;
    const int head = F.lane >> 2, sub = F.lane & 3;
    const GAS float* gqk = (const GAS float*)(ws + WS_GQK);
    float gn[32], ga[8], gb[8];
#pragma unroll
    for (int i = 0; i < 32; ++i) gn[i] = gqk[32 * sub + i];
#pragma unroll
    for (int i = 0; i < 8; ++i) { ga[i] = gqk[NOPE + 8 * sub + i]; gb[i] = gqk[NOPE + 32 + 8 * sub + i]; }
    struct Row { v4u nw[4], r1, r2; f32x4 c0, c1, s0, s1; };
#define QF_LOAD(R, tok) do { const bf16* b_ = (const bf16*)(ws + WS_Q) + (size_t)(tok) * QW + head * QKH; \
        _Pragma("unroll") for (int i = 0; i < 4; ++i) R.nw[i] = *(const GAS v4u*)(b_ + 32 * sub + 8 * i); \
        R.r1 = *(const GAS v4u*)(b_ + NOPE + 8 * sub); R.r2 = *(const GAS v4u*)(b_ + NOPE + 32 + 8 * sub); const int pos_ = pos_of_token(tok); \
        const GAS f32x4* cp_ = (const GAS f32x4*)((const GAS float*)(ws + WS_COSM) + pos_ * 32 + 8 * sub); const GAS f32x4* sp_ = (const GAS f32x4*)((const GAS float*)(ws + WS_SINM) + pos_ * 32 + 8 * sub); \
        R.c0 = cp_[0]; R.c1 = cp_[1]; R.s0 = sp_[0]; R.s1 = sp_[1]; } while (0)
    Row cur, nxt;
    if (gw < MT) QF_LOAD(cur, gw);
    for (int tok = gw; tok < MT; tok += NGW) {
        const bool more = tok + NGW < MT;
        if (more) QF_LOAD(nxt, tok + NGW);
        bf16* base = (bf16*)(ws + WS_Q) + (size_t)tok * QW + head * QKH;
        const float cc[8] = {cur.c0.x, cur.c0.y, cur.c0.z, cur.c0.w, cur.c1.x, cur.c1.y, cur.c1.z, cur.c1.w}, sn[8] = {cur.s0.x, cur.s0.y, cur.s0.z, cur.s0.w, cur.s1.x, cur.s1.y, cur.s1.z, cur.s1.w};
        const float a[8] = {bflo(cur.r1.x), bfhi(cur.r1.x), bflo(cur.r1.y), bfhi(cur.r1.y), bflo(cur.r1.z), bfhi(cur.r1.z), bflo(cur.r1.w), bfhi(cur.r1.w)};
        const float b[8] = {bflo(cur.r2.x), bfhi(cur.r2.x), bflo(cur.r2.y), bfhi(cur.r2.y), bflo(cur.r2.z), bfhi(cur.r2.z), bflo(cur.r2.w), bfhi(cur.r2.w)};
        float ra[8], rb[8], ss = 0.f;
#pragma unroll
        for (int i = 0; i < 8; ++i) { ra[i] = a[i] * cc[i] - b[i] * sn[i]; rb[i] = a[i] * sn[i] + b[i] * cc[i]; ss += ra[i] * ra[i] + rb[i] * rb[i]; }
        float nf[32];
#pragma unroll
        for (int i = 0; i < 4; ++i) { nf[8 * i + 0] = bflo(cur.nw[i].x); nf[8 * i + 1] = bfhi(cur.nw[i].x); nf[8 * i + 2] = bflo(cur.nw[i].y); nf[8 * i + 3] = bfhi(cur.nw[i].y);
            nf[8 * i + 4] = bflo(cur.nw[i].z); nf[8 * i + 5] = bfhi(cur.nw[i].z); nf[8 * i + 6] = bflo(cur.nw[i].w); nf[8 * i + 7] = bfhi(cur.nw[i].w); }
#pragma unroll
        for (int i = 0; i < 32; ++i) ss += nf[i] * nf[i];
        ss += shfl_xor_l(ss, 1, F.lane); ss += shfl_xor_l(ss, 2, F.lane);
        const float rs = 1.0f / sqrtf(ss * (1.0f / QKH) + EPS);
#pragma unroll
        for (int i = 0; i < 4; ++i) { float o[8];
#pragma unroll
            for (int e = 0; e < 8; ++e) o[e] = nf[8 * i + e] * rs * gn[8 * i + e];
            v4u w; w.x = cvtpk(o[0], o[1]); w.y = cvtpk(o[2], o[3]); w.z = cvtpk(o[4], o[5]); w.w = cvtpk(o[6], o[7]);
            if (!A.dry) *(GAS v4u*)(base + 32 * sub + 8 * i) = w; }
        { float o[8], p[8];
#pragma unroll
            for (int e = 0; e < 8; ++e) { o[e] = ra[e] * rs * ga[e]; p[e] = rb[e] * rs * gb[e]; }
            v4u w; w.x = cvtpk(o[0], o[1]); w.y = cvtpk(o[2], o[3]); w.z = cvtpk(o[4], o[5]); w.w = cvtpk(o[6], o[7]);
            if (!A.dry) *(GAS v4u*)(base + NOPE + 8 * sub) = w;
            w.x = cvtpk(p[0], p[1]); w.y = cvtpk(p[2], p[3]); w.z = cvtpk(p[4], p[5]); w.w = cvtpk(p[6], p[7]);
            if (!A.dry) *(GAS v4u*)(base + NOPE + 32 + 8 * sub) = w; }
        if (more) cur = nxt;
    }
#undef QF_LOAD
}
constexpr int SC_QS = 264, SC_KS = 264, SC_VS = 136, SC_PS = 72;
constexpr int SC_Q = 0, SC_K = SC_Q + 64 * SC_QS * 2, SC_V = SC_K + 64 * SC_KS * 2, SC_P = SC_V + 64 * SC_VS * 2, SC_END = SC_P + 64 * SC_PS * 2;
static_assert(SC_END <= RING_BYTES, "scan LDS");
__device__ __forceinline__ s16x4 tr16(const LAS unsigned char* p) {
    typedef short v4i16_t __attribute__((ext_vector_type(4)));
    return __builtin_bit_cast(s16x4, __builtin_amdgcn_ds_read_tr16_b64_v4i16((LAS v4i16_t*)p)); }
__device__ __forceinline__ bf16x8 cat4(s16x4 l, s16x4 h) { return (bf16x8){l[0], l[1], l[2], l[3], h[0], h[1], h[2], h[3]}; }

__device__ __forceinline__ void scan_unit(LAS unsigned char* lds, bf16* QKVG, size_t tok0, int nch, int h, int jv, const float* Sin, float* Sout, int tid, int dry) {
    const int wid = __builtin_amdgcn_readfirstlane(tid >> 6), lane = tid & 63, fr = lane & 15, fq = lane >> 4;
    f32x4 S[16];
    const int dvcol = jv * 128 + wid * 16 + fr;
    if (Sin) {
#pragma unroll
        for (int T = 0; T < 16; ++T)
#pragma unroll
            for (int i = 0; i < 4; ++i) S[T][i] = ((const GAS float*)Sin)[(size_t)(16 * T + 4 * fq + i) * RDV + dvcol];
    } else {
#pragma unroll
        for (int T = 0; T < 16; ++T) S[T] = (f32x4){0.f, 0.f, 0.f, 0.f};
    }
    const float g64 = __builtin_amdgcn_exp2f(64.0f * lg2gamma(h));
    const GAS bf16* gq = (const GAS bf16*)QKVG + tok0 * RIN + h * RDK;
    const GAS bf16* gk = gq + 2048;
    GAS bf16* gv = (GAS bf16*)QKVG + tok0 * RIN + 4096 + h * RDV + jv * 128;
    bf16x8 pq[4], pk[4], pv[2];
#define SC_LOAD(cc) do { _Pragma("unroll") for (int i = 0; i < 4; ++i) { const int idx = tid + 512 * i, r = idx >> 5, c = idx & 31; \
            pq[i] = *(const GAS bf16x8*)(gq + (size_t)((cc) * 64 + r) * RIN + 8 * c); pk[i] = *(const GAS bf16x8*)(gk + (size_t)((cc) * 64 + r) * RIN + 8 * c); } \
        _Pragma("unroll") for (int i = 0; i < 2; ++i) { const int idx = tid + 512 * i, r = idx >> 4, c = idx & 15; pv[i] = *(const GAS bf16x8*)(gv + (size_t)((cc) * 64 + r) * RIN + 8 * c); } } while (0)
#define SC_WRITE() do { _Pragma("unroll") for (int i = 0; i < 4; ++i) { const int idx = tid + 512 * i, r = idx >> 5, c = idx & 31; \
            *(LAS bf16x8*)(lds + SC_Q + (r * SC_QS + 8 * c) * 2) = pq[i]; *(LAS bf16x8*)(lds + SC_K + (r * SC_KS + 8 * c) * 2) = pk[i]; } \
        _Pragma("unroll") for (int i = 0; i < 2; ++i) { const int idx = tid + 512 * i, r = idx >> 4, c = idx & 15; *(LAS bf16x8*)(lds + SC_V + (r * SC_VS + 8 * c) * 2) = pv[i]; } } while (0)
    SC_LOAD(0);
    const int tq = fr >> 2, tp = fr & 3;
#define SC_TOUCH(cc_, x0, x1) do { const int ct_ = (cc_) < nch ? (cc_) : nch - 1; int t_ = tid; asm volatile("" : "+v"(t_)); \
        x0 = *(const GAS unsigned*)(gq + (size_t)(ct_ * 64 + (t_ >> 3)) * RIN + (t_ & 3) * 64 + ((t_ >> 2) & 1) * 2048); \
        x1 = *(const GAS unsigned*)(gv + (size_t)(ct_ * 64 + ((t_ >> 1) & 63)) * RIN + (t_ & 1) * 64); } while (0)
    unsigned dA0 = 0u, dA1 = 0u, dB0 = 0u, dB1 = 0u;
    if (MK_SCAN_PF && nch > 1) SC_TOUCH(1, dB0, dB1);
    auto step = [&](const int cc, unsigned& i0, unsigned& i1, const unsigned c0, const unsigned c1) __attribute__((always_inline)) {
        SC_WRITE();
        if (cc + 1 < nch) SC_LOAD(cc + 1);
        if (MK_SCAN_PF && nch > 1) SC_TOUCH(cc + 2, i0, i1);
        __syncthreads();
#pragma unroll
        for (int e = 0; e < 2; ++e) { const int idx = 2 * wid + e, ts = idx >> 2, tt = idx & 3;
            f32x4 a = (f32x4){0.f, 0.f, 0.f, 0.f};
            if (ts <= tt) {
#pragma unroll
                for (int ks = 0; ks < 8; ++ks) { const bf16x8 ak = *(const LAS bf16x8*)(lds + SC_K + ((16 * ts + fr) * SC_KS + 32 * ks + 8 * fq) * 2);
                    const bf16x8 bq = *(const LAS bf16x8*)(lds + SC_Q + ((16 * tt + fr) * SC_QS + 32 * ks + 8 * fq) * 2);
                    a = __builtin_amdgcn_mfma_f32_16x16x32_bf16(ak, bq, a, 0, 0, 0); }
            }
            float v[4];
#pragma unroll
            for (int i = 0; i < 4; ++i) v[i] = (ts < tt || (ts == tt && fr >= 4 * fq + i)) ? a[i] : 0.f;
            v2u w; w.x = cvtpk(v[0], v[1]); w.y = cvtpk(v[2], v[3]);
            *(LAS v2u*)(lds + SC_P + ((16 * tt + fr) * SC_PS + 16 * ts + 4 * fq) * 2) = w; }
        __syncthreads();
#if defined(MK_DEBUG)
        if (cc == 0 && jv == 0) { const int pidx = Sin ? 64 + (int)((tok0 - MP) >> 6) * 8 + h : (int)(tok0 >> 11) * 8 + h;
            *(GAS v4u*)((GAS unsigned char*)QKVG + (size_t)(985 + 24) * 1048576 - (size_t)552 * 1048576 + (size_t)pidx * 8192 + (tid >> 3) * 128 + (tid & 7) * 16) = *(const LAS v4u*)(lds + SC_P + ((tid >> 3) * SC_PS + 8 * (tid & 7)) * 2); }
#endif
        f32x4 O[4];
#pragma unroll
        for (int tt = 0; tt < 4; ++tt) O[tt] = (f32x4){0.f, 0.f, 0.f, 0.f};
#pragma unroll
        for (int ks = 0; ks < 8; ++ks) {
            v4u aw; aw.x = cvtpk(S[2 * ks][0], S[2 * ks][1]); aw.y = cvtpk(S[2 * ks][2], S[2 * ks][3]); aw.z = cvtpk(S[2 * ks + 1][0], S[2 * ks + 1][1]); aw.w = cvtpk(S[2 * ks + 1][2], S[2 * ks + 1][3]);
            const bf16x8 av = __builtin_bit_cast(bf16x8, aw);
#pragma unroll
            for (int tt = 0; tt < 4; ++tt) { const LAS unsigned char* qp = lds + SC_Q + ((16 * tt + fr) * SC_QS + 32 * ks + 4 * fq) * 2;
                const v2u lo = *(const LAS v2u*)qp, hi = *(const LAS v2u*)(qp + 32);
                v4u bw; bw.x = lo.x; bw.y = lo.y; bw.z = hi.x; bw.w = hi.y;
                O[tt] = __builtin_amdgcn_mfma_f32_16x16x32_bf16(av, __builtin_bit_cast(bf16x8, bw), O[tt], 0, 0, 0); } }
        bf16x8 vA[2];
#pragma unroll
        for (int k2 = 0; k2 < 2; ++k2) { const LAS unsigned char* vp = lds + SC_V + ((32 * k2 + 8 * fq + tq) * SC_VS + 16 * wid + 4 * tp) * 2;
            vA[k2] = cat4(tr16(vp), tr16(vp + 4 * SC_VS * 2)); }
#pragma unroll
        for (int tt = 0; tt < 4; ++tt)
#pragma unroll
            for (int k2 = 0; k2 < 2; ++k2) { if (k2 == 1 && tt < 2) continue;
                const bf16x8 bp = *(const LAS bf16x8*)(lds + SC_P + ((16 * tt + fr) * SC_PS + 32 * k2 + 8 * fq) * 2);
                O[tt] = __builtin_amdgcn_mfma_f32_16x16x32_bf16(vA[k2], bp, O[tt], 0, 0, 0); }
#pragma unroll
        for (int tt = 0; tt < 4; ++tt) { v2u w; w.x = cvtpk(O[tt][0], O[tt][1]); w.y = cvtpk(O[tt][2], O[tt][3]);
            if (!dry) *(GAS v2u*)(gv + (size_t)(cc * 64 + 16 * tt + fr) * RIN + 16 * wid + 4 * fq) = w; }
#pragma unroll
        for (int T = 0; T < 16; ++T)
#pragma unroll
            for (int k2 = 0; k2 < 2; ++k2) { const LAS unsigned char* kp = lds + SC_K + ((32 * k2 + 8 * fq + tq) * SC_KS + 16 * T + 4 * tp) * 2;
                const bf16x8 ak = cat4(tr16(kp), tr16(kp + 4 * SC_KS * 2));
                S[T] = __builtin_amdgcn_mfma_f32_16x16x32_bf16(ak, vA[k2], S[T], 0, 0, 0); }
#pragma unroll
        for (int T = 0; T < 16; ++T) S[T] = S[T] * g64;
        if (MK_SCAN_PF && nch > 1) asm volatile("" :: "v"(c0), "v"(c1));
        __syncthreads();
    };
    for (int cc = 0; cc < nch; cc += 2) { step(cc, dA0, dA1, dB0, dB1); if (cc + 1 < nch) step(cc + 1, dB0, dB1, dA0, dA1); }
#undef SC_LOAD
#undef SC_WRITE
#undef SC_TOUCH
#pragma unroll
    for (int T = 0; T < 16; ++T)
#pragma unroll
        for (int i = 0; i < 4; ++i) if (!dry) ((GAS float*)Sout)[(size_t)(16 * T + 4 * fq + i) * RDV + dvcol] = S[T][i];
}
constexpr int AT_VB = 64 * VHD * 2, AT_KNB = 64 * NOPE * 2, AT_KRB = 64 * ROPE * 2;
constexpr int AT_V = 0, AT_KN = AT_V + 2 * AT_VB, AT_KR = AT_KN + 2 * AT_KNB, AT_RS = AT_KR + 2 * AT_KRB, AT_SCR = AT_RS + 2 * 256, AT_END = AT_SCR + NWAVES * 256;
static_assert(AT_END <= RING_BYTES, "attention LDS");
__device__ __forceinline__ int crow(int r, int hi) { return (r & 3) + 8 * (r >> 2) + 4 * hi; }
__device__ __forceinline__ int v_rd_base(int lane) { return ((lane & 3) << 3) | (((lane >> 2) & 3) << 6) | (((lane >> 4) & 1) << 5) | (((lane >> 5) & 1) << 8); }
constexpr int v_rd_off(int d0, int ks, int half) { return d0 * 512 + ks * 4096 + half * 2048; }
template <int OFF> __device__ __forceinline__ s16x4 tr_read(int vb) {
    s16x4 r; asm volatile("ds_read_b64_tr_b16 %0, %1 offset:%2" : "=&v"(r) : "v"(vb), "i"(OFF) : "memory"); return r;
}
template <int D0, int HF> __device__ __forceinline__ void pv_half(f32x16& od, int vb, bf16x8 pa0, bf16x8 pa1) {
    const s16x4 l0 = tr_read<v_rd_off(D0, 2 * HF, 0)>(vb), h0 = tr_read<v_rd_off(D0, 2 * HF, 1)>(vb), l1 = tr_read<v_rd_off(D0, 2 * HF + 1, 0)>(vb), h1 = tr_read<v_rd_off(D0, 2 * HF + 1, 1)>(vb);
    asm volatile("s_waitcnt lgkmcnt(0)" ::: "memory"); __builtin_amdgcn_sched_barrier(0);
    od = __builtin_amdgcn_mfma_f32_32x32x16_bf16(pa0, cat4(l0, h0), od, 0, 0, 0);
    od = __builtin_amdgcn_mfma_f32_32x32x16_bf16(pa1, cat4(l1, h1), od, 0, 0, 0);
}
template <int D0, int HF> __device__ __forceinline__ void pv_pair(f32x16& oa, f32x16& ob, int vb, bf16x8 pa0, bf16x8 pa1) {
    const s16x4 l0 = tr_read<v_rd_off(D0, 2 * HF, 0)>(vb), h0 = tr_read<v_rd_off(D0, 2 * HF, 1)>(vb), l1 = tr_read<v_rd_off(D0, 2 * HF + 1, 0)>(vb), h1 = tr_read<v_rd_off(D0, 2 * HF + 1, 1)>(vb);
    const s16x4 m0 = tr_read<v_rd_off(D0 + 1, 2 * HF, 0)>(vb), n0 = tr_read<v_rd_off(D0 + 1, 2 * HF, 1)>(vb), m1 = tr_read<v_rd_off(D0 + 1, 2 * HF + 1, 0)>(vb), n1 = tr_read<v_rd_off(D0 + 1, 2 * HF + 1, 1)>(vb);
    asm volatile("s_waitcnt lgkmcnt(4)" ::: "memory"); __builtin_amdgcn_sched_barrier(0);
    if (MK_ATTN_PRIO) __builtin_amdgcn_s_setprio(1);
    oa = __builtin_amdgcn_mfma_f32_32x32x16_bf16(pa0, cat4(l0, h0), oa, 0, 0, 0);
    oa = __builtin_amdgcn_mfma_f32_32x32x16_bf16(pa1, cat4(l1, h1), oa, 0, 0, 0);
    asm volatile("s_waitcnt lgkmcnt(0)" ::: "memory"); __builtin_amdgcn_sched_barrier(0);
    ob = __builtin_amdgcn_mfma_f32_32x32x16_bf16(pa0, cat4(m0, n0), ob, 0, 0, 0);
    ob = __builtin_amdgcn_mfma_f32_32x32x16_bf16(pa1, cat4(m1, n1), ob, 0, 0, 0);
    if (MK_ATTN_PRIO) __builtin_amdgcn_s_setprio(0);
}
struct VFrag2 { s16x4 l0, h0, l1, h1, m0, n0, m1, n1; };
template <int D0, int HF> __device__ __forceinline__ void v_fetch2(VFrag2& f, int vb) {
    f.l0 = tr_read<v_rd_off(D0, 2 * HF, 0)>(vb); f.h0 = tr_read<v_rd_off(D0, 2 * HF, 1)>(vb); f.l1 = tr_read<v_rd_off(D0, 2 * HF + 1, 0)>(vb); f.h1 = tr_read<v_rd_off(D0, 2 * HF + 1, 1)>(vb);
    f.m0 = tr_read<v_rd_off(D0 + 1, 2 * HF, 0)>(vb); f.n0 = tr_read<v_rd_off(D0 + 1, 2 * HF, 1)>(vb); f.m1 = tr_read<v_rd_off(D0 + 1, 2 * HF + 1, 0)>(vb); f.n1 = tr_read<v_rd_off(D0 + 1, 2 * HF + 1, 1)>(vb);
}
__device__ __forceinline__ void pv_mma2(f32x16& oa, f32x16& ob, const VFrag2& f, bf16x8 pa0, bf16x8 pa1) {
    oa = __builtin_amdgcn_mfma_f32_32x32x16_bf16(pa0, cat4(f.l0, f.h0), oa, 0, 0, 0);
    oa = __builtin_amdgcn_mfma_f32_32x32x16_bf16(pa1, cat4(f.l1, f.h1), oa, 0, 0, 0);
    ob = __builtin_amdgcn_mfma_f32_32x32x16_bf16(pa0, cat4(f.m0, f.n0), ob, 0, 0, 0);
    ob = __builtin_amdgcn_mfma_f32_32x32x16_bf16(pa1, cat4(f.m1, f.n1), ob, 0, 0, 0);
}
__device__ __forceinline__ void attn_unit(LAS unsigned char* lds, const bf16* Q, const bf16* KV, const bf16* KR, const float* RSs, const float* cosM, const float* sinM, const LAS float* gqk, bf16* Ob,
                                          int qrow0, int kvrow0, int NT, int h, int nact, int lim0, bool prompt, int tid, int dry) {
    const int wid = __builtin_amdgcn_readfirstlane(tid >> 6), lane = tid & 63, r32 = lane & 31, hi = lane >> 5;
    const bool active = wid < nact; const int limit = prompt ? lim0 + (wid >> 1) : lim0;
    const int rb = prompt ? wid : (wid & 1);
    LAS float* scrw = (LAS float*)(lds + AT_SCR + wid * 256); LAS float* li_l = scrw; LAS float* al_l = scrw + 32;
    float m_reg = -1e30f, l_reg = 0.f;
    bf16x8 qr[12];
    { const int qrow = qrow0 + (active ? rb * 32 + r32 : 0);
      const GAS bf16* Qw = (const GAS bf16*)Q + (size_t)qrow * QW + h * QKH + hi * 8;
#pragma unroll
      for (int d0 = 0; d0 < 12; ++d0) qr[d0] = *(const GAS bf16x8*)(Qw + d0 * 16);
#if MK_QFUSE
      const int pos = pos_of_token(qrow);
      int hi_q = hi; asm volatile("" : "+v"(hi_q));
      float ra[2][8], rb[2][8], ss = 0.f;
#pragma unroll
      for (int p = 0; p < 2; ++p) { const int j0 = p * 16 + hi_q * 8;
          const f32x4 c0 = *(const GAS f32x4*)(cosM + pos * 32 + j0), c1 = *(const GAS f32x4*)(cosM + pos * 32 + j0 + 4), s0 = *(const GAS f32x4*)(sinM + pos * 32 + j0), s1 = *(const GAS f32x4*)(sinM + pos * 32 + j0 + 4);
          const float cc[8] = {c0.x, c0.y, c0.z, c0.w, c1.x, c1.y, c1.z, c1.w}, sn[8] = {s0.x, s0.y, s0.z, s0.w, s1.x, s1.y, s1.z, s1.w};
          const v4u x1 = __builtin_bit_cast(v4u, qr[8 + p]), x2 = __builtin_bit_cast(v4u, qr[10 + p]);
          const float a[8] = {bflo(x1.x), bfhi(x1.x), bflo(x1.y), bfhi(x1.y), bflo(x1.z), bfhi(x1.z), bflo(x1.w), bfhi(x1.w)};
          const float b[8] = {bflo(x2.x), bfhi(x2.x), bflo(x2.y), bfhi(x2.y), bflo(x2.z), bfhi(x2.z), bflo(x2.w), bfhi(x2.w)};
#pragma unroll
          for (int e = 0; e < 8; ++e) { ra[p][e] = a[e] * cc[e] - b[e] * sn[e]; rb[p][e] = a[e] * sn[e] + b[e] * cc[e]; ss += ra[p][e] * ra[p][e] + rb[p][e] * rb[p][e]; } }
#pragma unroll
      for (int d0 = 0; d0 < 8; ++d0) { const v4u x = __builtin_bit_cast(v4u, qr[d0]);
          ss += (bflo(x.x) * bflo(x.x) + bfhi(x.x) * bfhi(x.x)) + (bflo(x.y) * bflo(x.y) + bfhi(x.y) * bfhi(x.y)) + (bflo(x.z) * bflo(x.z) + bfhi(x.z) * bfhi(x.z)) + (bflo(x.w) * bflo(x.w) + bfhi(x.w) * bfhi(x.w)); }
      { auto rr = __builtin_amdgcn_permlane32_swap(__float_as_uint(ss), __float_as_uint(ss), false, false); ss = __uint_as_float(rr[0]) + __uint_as_float(rr[1]); }
      const float rs = 1.0f / sqrtf(ss * (1.0f / QKH) + EPS);
#pragma unroll
      for (int d0 = 0; d0 < 8; ++d0) asm volatile("" : "+v"(qr[d0]));
#pragma unroll
      for (int d0 = 0; d0 < 12; ++d0) { const f32x4 g0 = *(const LAS f32x4*)(gqk + d0 * 16 + hi * 8), g1 = *(const LAS f32x4*)(gqk + d0 * 16 + hi * 8 + 4);
          float v[8];
          if (d0 < 8) { const v4u x = __builtin_bit_cast(v4u, qr[d0]); v[0] = bflo(x.x); v[1] = bfhi(x.x); v[2] = bflo(x.y); v[3] = bfhi(x.y); v[4] = bflo(x.z); v[5] = bfhi(x.z); v[6] = bflo(x.w); v[7] = bfhi(x.w); }
          else {
#pragma unroll
              for (int e = 0; e < 8; ++e) v[e] = d0 < 10 ? ra[d0 - 8][e] : rb[d0 - 10][e]; }
          v4u w; w.x = cvtpk(v[0] * rs * g0.x, v[1] * rs * g0.y); w.y = cvtpk(v[2] * rs * g0.z, v[3] * rs * g0.w); w.z = cvtpk(v[4] * rs * g1.x, v[5] * rs * g1.y); w.w = cvtpk(v[6] * rs * g1.z, v[7] * rs * g1.w);
          qr[d0] = __builtin_bit_cast(bf16x8, w); }
#endif
    }
    f32x16 o[4];
#pragma unroll
    for (int d = 0; d < 4; ++d)
#pragma unroll
        for (int r = 0; r < 16; ++r) o[d][r] = 0.f;
    const GAS unsigned char* kvb = (const GAS unsigned char*)KV + ((size_t)kvrow0 * KVW + h * 256) * 2;
    const GAS unsigned char* krb = (const GAS unsigned char*)KR + (size_t)kvrow0 * ROPE * 2;
#define AT_OFFV(pc, ln) ([&]{ const int P = (pc) * 64 + (ln); const int sub = P >> 5, within = P & 31, kk = ((sub >> 2) << 3) | (within >> 2), k = (kk & ~0xC) | ((kk & 4) << 1) | ((kk & 8) >> 1), c = (sub & 3) * 32 + (within & 3) * 8; return (unsigned)(k * KVW + NOPE + c) * 2u; }())
#define AT_OFFKN(pc, ln) ([&]{ const int P = (pc) * 64 + (ln); const int ks_ = P >> 7, r = (P >> 1) & 63, c = 2 * ks_ + ((P & 1) ^ ((r >> 3) & 1)); return (unsigned)(r * KVW + 8 * c) * 2u; }())
#define AT_OFFKR(pc, ln) ([&]{ const int P = (pc) * 64 + (ln), ks_ = P >> 7, r = (P >> 1) & 63, c = 2 * ks_ + ((P & 1) ^ ((r >> 3) & 1)); return (unsigned)(r * ROPE + 8 * c) * 2u; }())
    const GAS float* rsb = (const GAS float*)RSs + (size_t)kvrow0 * MH + h;
#if MK_ATTN_HOIST
    const unsigned okn_[2] = {AT_OFFKN(wid, lane), AT_OFFKN(wid + 8, lane)}, ov_[2] = {AT_OFFV(wid, lane), AT_OFFV(wid + 8, lane)}; const unsigned okr_ = AT_OFFKR(wid, lane);
#define AT_DMA(j, b) do { const size_t tk_ = (size_t)(j) * 64 * KVW * 2; int ln_ = lane; \
        _Pragma("unroll") for (int i = 0; i < 2; ++i) { \
            __builtin_amdgcn_global_load_lds((const GAS unsigned*)(kvb + tk_ + okn_[i]), (LAS unsigned*)(lds + AT_KN + (b) * AT_KNB + (wid + 8 * i) * 1024), 16, 0, 0); \
            __builtin_amdgcn_global_load_lds((const GAS unsigned*)(kvb + tk_ + ov_[i]), (LAS unsigned*)(lds + AT_V + (b) * AT_VB + (wid + 8 * i) * 1024), 16, 0, 0); } \
        __builtin_amdgcn_global_load_lds((const GAS unsigned*)(krb + (size_t)(j) * 64 * ROPE * 2 + okr_), (LAS unsigned*)(lds + AT_KR + (b) * AT_KRB + wid * 1024), 16, 0, 0); \
        if (wid == 0) __builtin_amdgcn_global_load_lds((const GAS unsigned*)(rsb + ((size_t)(j) * 64 + ln_) * MH), (LAS unsigned*)(lds + AT_RS + (b) * 256), 4, 0, 0); } while (0)
#else
#define AT_PC_KN(j, b, pc_) __builtin_amdgcn_global_load_lds((const GAS unsigned*)(kvb + tk_ + AT_OFFKN(pc_, ln_)), (LAS unsigned*)(lds + AT_KN + (b) * AT_KNB + (pc_) * 1024), 16, 0, 0)
#define AT_PC_V(j, b, pc_) __builtin_amdgcn_global_load_lds((const GAS unsigned*)(kvb + tk_ + AT_OFFV(pc_, ln_)), (LAS unsigned*)(lds + AT_V + (b) * AT_VB + (pc_) * 1024), 16, 0, 0)
#define AT_PC_KR(j, b, pc_) __builtin_amdgcn_global_load_lds((const GAS unsigned*)(krb + (size_t)(j) * 64 * ROPE * 2 + AT_OFFKR(pc_, ln_)), (LAS unsigned*)(lds + AT_KR + (b) * AT_KRB + (pc_) * 1024), 16, 0, 0)
#define AT_PC_RS(j, b) __builtin_amdgcn_global_load_lds((const GAS unsigned*)(rsb + ((size_t)(j) * 64 + ln_) * MH), (LAS unsigned*)(lds + AT_RS + (b) * 256), 4, 0, 0)
#define AT_DMA(j, b) do { const size_t tk_ = (size_t)(j) * 64 * KVW * 2; int ln_ = lane; asm volatile("" : "+v"(ln_)); \
        if (MK_ATTN_LC && !prompt) { if (wid >= 4) { const int w4_ = wid - 4; \
                _Pragma("unroll") for (int k_ = 0; k_ < 4; ++k_) { AT_PC_KN(j, b, w4_ + 4 * k_); AT_PC_V(j, b, w4_ + 4 * k_); } \
                _Pragma("unroll") for (int k_ = 0; k_ < 2; ++k_) AT_PC_KR(j, b, w4_ + 4 * k_); \
                if (wid == 4) AT_PC_RS(j, b); } } \
        else { _Pragma("unroll") for (int i = 0; i < 2; ++i) { AT_PC_KN(j, b, wid + 8 * i); AT_PC_V(j, b, wid + 8 * i); } \
            AT_PC_KR(j, b, wid); if (wid == 0) AT_PC_RS(j, b); } } while (0)
#endif
    AT_DMA(0, 0); asm volatile("s_waitcnt vmcnt(0)" ::: "memory"); __syncthreads();
    for (int j = 0; j < NT; ++j) {
        const int cur = j & 1;
        if (j + 1 < NT && !(dry && MK_ATTN_DRYMODE == 4)) AT_DMA(j + 1, cur ^ 1);
        if (active && j <= limit && !(dry && MK_ATTN_DRYMODE == 1)) {
            if (MK_ATTN_DELAY && prompt && wid >= 4) __builtin_amdgcn_s_sleep(MK_ATTN_DELAY);
            const LAS unsigned char* Kn = lds + AT_KN + cur * AT_KNB; const LAS unsigned char* Kr = lds + AT_KR + cur * AT_KRB; const LAS unsigned char* Rt = lds + AT_RS + cur * 256;
            int lnv_ = lane; asm volatile("" : "+v"(lnv_)); const int vb = (int)(uintptr_t)(lds + AT_V) + v_rd_base(lnv_) + cur * AT_VB;
            const int kl_ = (lnv_ & 31) * 32 + ((((lnv_ >> 5) ^ (lnv_ >> 3)) & 1) << 4);
            const LAS unsigned char* Knl = Kn + kl_; const LAS unsigned char* Krl = Kr + kl_;
#define PK4(P, BASE, OUT) do { unsigned a0 = cvtpk(P[BASE + 0], P[BASE + 1]), a1 = cvtpk(P[BASE + 2], P[BASE + 3]);   \
    unsigned b0_ = cvtpk(P[BASE + 4], P[BASE + 5]), b1_ = cvtpk(P[BASE + 6], P[BASE + 7]);                              \
    auto r0 = __builtin_amdgcn_permlane32_swap(a0, b0_, false, false); auto r1 = __builtin_amdgcn_permlane32_swap(a1, b1_, false, false); \
    v4u w_ = {r0[0], r1[0], r0[1], r1[1]}; OUT = __builtin_bit_cast(bf16x8, w_); } while (0)
#define AT_HALF(HF) do { f32x16 p0; _Pragma("unroll") for (int r = 0; r < 16; ++r) p0[r] = 0.f; \
            bf16x8 ka[4], kb[4], kc[4];     \
            _Pragma("unroll") for (int i = 0; i < 4; ++i) { ka[i] = *(const LAS bf16x8*)(Knl + i * 2048 + HF * 1024); } \
            _Pragma("unroll") for (int i = 0; i < 4; ++i) { kb[i] = *(const LAS bf16x8*)(Knl + (4 + i) * 2048 + HF * 1024); } \
            __builtin_amdgcn_sched_barrier(0); if (MK_ATTN_PRIO) __builtin_amdgcn_s_setprio(1); \
            _Pragma("unroll") for (int i = 0; i < 4; ++i) p0 = __builtin_amdgcn_mfma_f32_32x32x16_bf16(ka[i], qr[i], p0, 0, 0, 0); \
            _Pragma("unroll") for (int i = 0; i < 4; ++i) { kc[i] = *(const LAS bf16x8*)(Krl + i * 2048 + HF * 1024); } \
            __builtin_amdgcn_sched_barrier(0); \
            _Pragma("unroll") for (int i = 0; i < 4; ++i) p0 = __builtin_amdgcn_mfma_f32_32x32x16_bf16(kb[i], qr[4 + i], p0, 0, 0, 0); \
            _Pragma("unroll") for (int i = 0; i < 4; ++i) p0 = __builtin_amdgcn_mfma_f32_32x32x16_bf16(kc[i], qr[8 + i], p0, 0, 0, 0); \
            if (MK_ATTN_PRIO) __builtin_amdgcn_s_setprio(0); \
            _Pragma("unroll") for (int g = 0; g < 4; ++g) { const f32x4 rs4 = *(const LAS f32x4*)(Rt + (32 * HF + 8 * g + 4 * hi) * 4); \
                p0[4 * g + 0] *= rs4[0]; p0[4 * g + 1] *= rs4[1]; p0[4 * g + 2] *= rs4[2]; p0[4 * g + 3] *= rs4[3]; } \
            float pmax = p0[0]; _Pragma("unroll") for (int r = 1; r < 16; ++r) pmax = fmaxf(pmax, p0[r]); \
            { auto rr = __builtin_amdgcn_permlane32_swap(__float_as_uint(pmax), __float_as_uint(pmax), false, false); pmax = fmaxf(__uint_as_float(rr[0]), __uint_as_float(rr[1])); } \
            const float mn = MK_ATTN_LAZY ? ((pmax > m_reg + 8.0f) ? pmax : m_reg) : fmaxf(m_reg, pmax);     \
            const float alpha = __builtin_amdgcn_exp2f(m_reg - mn); m_reg = mn; \
            float ps = 0.f; _Pragma("unroll") for (int r = 0; r < 16; ++r) { p0[r] = __builtin_amdgcn_exp2f(p0[r] - mn); ps += p0[r]; } \
            { auto rr = __builtin_amdgcn_permlane32_swap(__float_as_uint(ps), __float_as_uint(ps), false, false); ps = __uint_as_float(rr[0]) + __uint_as_float(rr[1]); } \
            l_reg = l_reg * alpha + ps; \
            if (__any(alpha < 1.f)) { if (hi == 0) al_l[r32] = alpha; asm volatile("s_waitcnt lgkmcnt(0)" ::: "memory"); \
                _Pragma("unroll") for (int r = 0; r < 16; ++r) { const float al = al_l[crow(r, hi)]; _Pragma("unroll") for (int d = 0; d < 4; ++d) o[d][r] *= al; } } \
            bf16x8 pa0, pa1; PK4(p0, 0, pa0); PK4(p0, 8, pa1); \
            pv_pair<0, HF>(o[0], o[1], vb, pa0, pa1); pv_pair<2, HF>(o[2], o[3], vb, pa0, pa1); } while (0)
            if (prompt || wid < 2) AT_HALF(0);
            if (MK_ATTN_SB) __builtin_amdgcn_sched_barrier(0);
            if (prompt || wid >= 2) AT_HALF(1);
#undef PK4
#undef AT_HALF
        }
        asm volatile("s_waitcnt vmcnt(0)" ::: "memory");
        __syncthreads();
    }
#undef AT_DMA
#undef AT_OFFV
#undef AT_OFFKN
#undef AT_OFFKR
#undef AT_PC_KN
#undef AT_PC_V
#undef AT_PC_KR
#undef AT_PC_RS
    if (!prompt) {
        LAS float* mo = (LAS float*)(lds + AT_V) + (wid & 1) * 4096 + lane;
        LAS float* pscr = (LAS float*)(lds + AT_SCR + (wid | 2) * 256);
        if (wid == 2 || wid == 3) {
#pragma unroll
            for (int d = 0; d < 4; ++d)
#pragma unroll
                for (int r = 0; r < 16; ++r) mo[(d * 16 + r) * 64] = o[d][r];
            if (hi == 0) { pscr[r32] = m_reg; pscr[32 + r32] = l_reg; } }
        asm volatile("s_waitcnt lgkmcnt(0)" ::: "memory"); __syncthreads();
        if (wid < 2) {
            const float m2 = pscr[r32], l2 = pscr[32 + r32];
            const float mn = fmaxf(m_reg, m2), a1 = __builtin_amdgcn_exp2f(m_reg - mn), a2 = __builtin_amdgcn_exp2f(m2 - mn);
            l_reg = l_reg * a1 + l2 * a2;
            if (hi == 0) { al_l[r32] = a1; li_l[r32] = a2; } asm volatile("s_waitcnt lgkmcnt(0)" ::: "memory");
#pragma unroll
            for (int r = 0; r < 16; ++r) { const float A1 = al_l[crow(r, hi)], A2 = li_l[crow(r, hi)];
#pragma unroll
                for (int d = 0; d < 4; ++d) o[d][r] = o[d][r] * A1 + mo[(d * 16 + r) * 64] * A2; }
            asm volatile("s_waitcnt lgkmcnt(0)" ::: "memory");
        }
    }
    if ((prompt ? active : wid < 2) && !dry) {
        if (hi == 0) li_l[r32] = l_reg; asm volatile("s_waitcnt lgkmcnt(0)" ::: "memory");
        int r32b = r32, hib = hi; asm volatile("" : "+v"(r32b), "+v"(hib));
        GAS bf16* Ow = (GAS bf16*)Ob + (size_t)(qrow0 + wid * 32) * DM + h * VHD + r32b;
#pragma unroll
        for (int r = 0; r < 16; ++r) { const int orow = crow(r, hib); const float rl = __builtin_amdgcn_rcpf(li_l[orow]);
#pragma unroll
            for (int d0 = 0; d0 < 4; ++d0) Ow[(size_t)orow * DM + d0 * 32] = (bf16)(cvtpk(o[d0][r] * rl, 0.f) & 0xffffu); }
    }
    __syncthreads();
}
__device__ __forceinline__ void attn_phase(const Args& A, const Frame& F) {
    unsigned char* ws = A.ws;
    const bf16* Q = (const bf16*)(ws + WS_Q); const bf16* KV = (const bf16*)(ws + WS_BIG); const bf16* KR = (const bf16*)(ws + WS_KRALL);
    bf16* Ob = (bf16*)(ws + WS_O);
    LAS float* gqk = (LAS float*)(F.lds + LDSCTL_OFF + 1024);
    if (MK_QFUSE) { if (F.tid < QKH) gqk[F.tid] = ((const GAS float*)(ws + WS_GQK))[F.tid]; __syncthreads(); }
    for (int u0 = blockIdx.x; u0 < 1024 + 512; u0 += F.G) {
        int u = u0;
        if (F.G == 256 && MK_ATTN_IL && ((blockIdx.x >> 5) & 1)) { const int it = u0 >> 8; u = ((it + 4) % 6) * 256 + (u0 & 255); }
        int qrow0, kvrow0, NT, h, nact, lim0; bool prompt;
        if (u < 1024) {
            const int rd = u >> 8, c = u & 255, x = c & 7, k = c >> 3, m = k >> 2, i = k & 3, bh = (rd >> 1) * 64 + x * 8 + m, b = bh >> 4;
            const int qb = (rd & 1) ? i : 7 - i;
            h = bh & 15; qrow0 = b * SEQ + qb * 256; kvrow0 = b * SEQ; NT = 4 * qb + 4; nact = 8; lim0 = 4 * qb; prompt = true;
        } else { const int v = u - 1024, b = v >> 4; h = v & 15; qrow0 = MP + b * DSEQ; kvrow0 = MP + b * KVT; NT = KVT / 64; nact = 4; lim0 = NT - 1; prompt = false; }
        attn_unit(F.lds, Q, KV, KR, (const float*)(ws + WS_RS), (const float*)(ws + WS_COSM), (const float*)(ws + WS_SINM), gqk, Ob, qrow0, kvrow0, NT, h, nact, lim0, prompt, F.wave * 64 + lane_id_asm(), A.dry);
    }
}
__device__ __forceinline__ void scan_phase2(const Args& A, const Frame& F) {
    bf16* QKVG = (bf16*)(A.ws + WS_BIG);
    for (int u0 = MK_SCAN_XCD ? F.vcu : (int)blockIdx.x; u0 < 256 + 1024; u0 += F.G) {
        int u = u0;
        if (F.G == 256 && MK_SCAN_IL && ((blockIdx.x >> 3) & 1)) { const int it = u0 >> 8; u = ((it + 1) % 5) * 256 + (u0 & 255); }
        const bool pr = u < 256; const int v = pr ? u : u - 256, b = v >> 5, h = (v >> 2) & 7, jv = v & 3;
        const size_t so = (size_t)(b * RH + h) * RDK * RDV;
        scan_unit(F.lds, QKVG, pr ? (size_t)b * SEQ : (size_t)MP + (size_t)b * DSEQ, pr ? SEQ / 64 : 1, h, jv, pr ? nullptr : A.in[I_STATE] + so, A.out + (pr ? OUT_RETP : OUT_RETS) + so, F.tid, A.dry);
    }
}

#define CAS __attribute__((address_space(4)))
__device__ __forceinline__ Args load_args(const CAS Args* p) { Args a;
#pragma unroll
    for (int i = 0; i < 25; ++i) a.in[i] = p->in[i];
    a.out = p->out; a.ws = p->ws; a.ph_lo = p->ph_lo; a.ph_hi = p->ph_hi; a.dry = p->dry; a.pad = 0; return a; }
__global__ void __launch_bounds__(NWAVES * 64, 2) yoco_fwd(Args args) {
    extern __shared__ __attribute__((aligned(16))) unsigned char lds[];
    Frame F0;
    F0.lds = (LAS unsigned char*)lds;
    const int wave0 = __builtin_amdgcn_readfirstlane((int)threadIdx.x >> 6);
    F0.G = gridDim.x; { const int bx = blockIdx.x; F0.vcu = (F0.G % 8 == 0) ? (bx % 8) * (F0.G / 8) + bx / 8 : bx; }
    unsigned char* ws0 = args.ws;
    for (int u = threadIdx.x; u < (LDS_BYTES - LDSCTL_OFF) / 4; u += NWAVES * 64) ((LAS unsigned*)(F0.lds + LDSCTL_OFF))[u] = 0u;
    __syncthreads();
    XcdBarrier bar; bar.bar = (unsigned*)(ws0 + WS_CTL) + CW_BAR; bar.x = 0; bar.st = nullptr;
#if MK_ONE_LAUNCH
    bar = xcd_barrier_post((unsigned*)(ws0 + WS_CTL) + CW_BAR, (volatile LAS unsigned*)(F0.lds + MISC_OFF) + 8);
#endif
    const int lo = args.ph_lo, hi = args.ph_hi;
    int pc = 0;
#if MK_SCRAMBLE
#define MK_CID ((int)((blockIdx.x * 97u) % gridDim.x))
#else
#define MK_CID ((int)blockIdx.x)
#endif
#define CLK_T0() do { if (MK_CLKPH >= 0 && pc == MK_CLKPH && blockIdx.x == 0 && threadIdx.x == 0) { *(volatile LAS unsigned long long*)(F0.lds + MISC_OFF + 72) = wall_clock64(); *(volatile LAS unsigned long long*)(F0.lds + MISC_OFF + 80) = clock64(); } } while (0)
#define CLK_T1() do { if (MK_CLKPH >= 0 && pc == MK_CLKPH && blockIdx.x == 0 && threadIdx.x == 0) { const unsigned long long w1 = wall_clock64(), c1 = clock64(); \
        const float mhz = (float)(c1 - *(volatile LAS unsigned long long*)(F0.lds + MISC_OFF + 80)) / (float)(w1 - *(volatile LAS unsigned long long*)(F0.lds + MISC_OFF + 72)) * 100.0f; \
        *(volatile LAS float*)(F0.lds + MISC_OFF + 88) = MK_CLKMODE == 0 ? 100.0f * __builtin_rintf(mhz * 0.01f) : 100.0f * __builtin_rintf((float)(c1 - *(volatile LAS unsigned long long*)(F0.lds + MISC_OFF + 80)) * (1.0f / (13.0f * 32.0f)) * 0.01f); } } while (0)
#define BARW_T0() do { if (MK_BARWAIT && ((MK_BARMASK >> pc) & 1u) && blockIdx.x == MK_BARWAIT_BLK && threadIdx.x == 0) *(volatile LAS unsigned long long*)(F0.lds + MISC_OFF + 96) = wall_clock64(); } while (0)
#define BARW_T1() do { if (MK_BARWAIT && ((MK_BARMASK >> pc) & 1u) && blockIdx.x == MK_BARWAIT_BLK && threadIdx.x == 0) *(volatile LAS unsigned long long*)(F0.lds + MISC_OFF + 104) += wall_clock64() - *(volatile LAS unsigned long long*)(F0.lds + MISC_OFF + 96); } while (0)
#define SPIN_T0() do { if (((MK_SPINMASK >> pc) & 1u) && blockIdx.x == 0 && (wave0 == 0 && lane_id_asm() == 0)) { *(volatile LAS unsigned long long*)(F0.lds + MISC_OFF + 64) = wall_clock64(); *(volatile LAS unsigned long long*)(F0.lds + MISC_OFF + 112) = clock64(); } } while (0)
#define SPIN_WAIT() do { if (((MK_SPINMASK >> pc) & 1u) && blockIdx.x == 0) { if ((wave0 == 0 && lane_id_asm() == 0)) { const unsigned long long t0_ = *(volatile LAS unsigned long long*)(F0.lds + MISC_OFF + 64), t1_ = wall_clock64(); \
        const unsigned long long d_ = MK_SPINCLK ? (clock64() - *(volatile LAS unsigned long long*)(F0.lds + MISC_OFF + 112)) / 24 : (t1_ - t0_);     \
        if (MK_SPINEND) *(volatile LAS unsigned long long*)(F0.lds + MISC_OFF + 120) += d_; else while (wall_clock64() - t1_ < d_ * MK_SPINMUL) __builtin_amdgcn_s_sleep(8); } __syncthreads(); } } while (0)
#define PH_BEGIN if (pc >= lo && pc < hi) { SPIN_T0(); CLK_T0(); Frame F; { int t_ = wave0 * 64 + lane_id_asm(); F.lds = F0.lds; F.tid = t_; F.lane = t_ & 63; F.wave = __builtin_amdgcn_readfirstlane(t_ >> 6); F.G = F0.G; F.vcu = F0.vcu; } \
    const CAS Args* ap_ = (const CAS Args*)__builtin_amdgcn_kernarg_segment_ptr(); asm volatile("" : "+s"(ap_)); const Args args = load_args(ap_); \
    unsigned char* ws = args.ws; float* hres = args.out; \
    bf16* XN = (bf16*)(ws + WS_XN); bf16* HID = (bf16*)(ws + WS_BIG); bf16* QKVG = (bf16*)(ws + WS_BIG); (void)XN; (void)HID; (void)QKVG; (void)hres;
#if MK_ONE_LAUNCH
#define PH_END if (pc + 1 < hi) { BARW_T0(); xcd_barrier(bar, wave0); BARW_T1(); if (MK_DBLBAR) xcd_barrier(bar, wave0); } CLK_T1(); SPIN_WAIT(); } ++pc;
#else
#define PH_END } ++pc;
#endif
    typedef pg8::StaticOrder SO;
#if MK_NFOLD == 2 && MK_HBF && MK_TQ
    typedef pg8::TqOrder ResOrder;
#define RES_TQ MK_TQ
#else
    typedef pg8::SplitTailOrder ResOrder;
#define RES_TQ 0
#endif
#if MK_NFOLD == 2 && MK_HBF
    typedef EpiResid3 EpiRes;
#elif MK_NFOLD == 2
    typedef EpiResid2 EpiRes;
#else
    typedef EpiResid EpiRes;
#endif
#define SSQH(i) ((float*)(ws + WS_SSQH + (size_t)(i) * SSQH_STRIDE))
#if MK_HALFTAIL
    typedef pg8::HalfTailOrder FfnInOrder;
#else
    typedef pg8::StaticOrder FfnInOrder;
#endif

    PH_BEGIN
#ifndef DIS_PRO
 p0_prologue(args, F);
#endif
 PH_END

    for (int l = 0; l < 2; ++l) {
        for (int f = 0; f < 2; ++f) {
            if (MK_NFOLD < 2 && l + f > 0 && !(l == 1 && f == 0)) { PH_BEGIN
                norm_phase(F, hres, (f == 0 ? args.in[I_F1N] : args.in[I_F2N]) + l * DM, XN, f == 1 ? (const float*)(ws + WS_BIG) : nullptr, (l == 0) ? RIN / 2 : DM, args.dry, nullptr, MK_NFOLD ? SSQH(l == 0 ? 2 : 5) : nullptr); PH_END }
            PH_BEGIN {
                const size_t wo = l == 0 ? (f == 0 ? WS_WIN00 : WS_WIN01) : (f == 0 ? WS_WIN10 : WS_WIN11);
                pg8::Gemm g{XN, (const bf16*)(ws + wo), MT, 2 * DFF, DM, DM, 0, 0}; FfnInOrder S; S.init(MT, 2 * DFF, F.G, MK_CID); S.xt = MK_XTAIL && MK_DEFER == 2;
                EpiSwiGLU E{HID, DFF, MK_NFOLD ? SSQH(l == 0 ? (f == 0 ? 0 : 2) : (f == 0 ? 3 : 5)) : nullptr, F.lds + RING_OFF};
                pg8::gemm_phase<EpiSwiGLU, FfnInOrder, MK_ALIGN_SWIGLU, MK_SP2>(F.lds + RING_OFF, g, S, E, F.tid);
                conv_deferred(args, F, l == 0 ? (f == 0 ? 0 : 2) : (f == 0 ? 3 : (MK_DEFER == 2 ? 5 : 9))); } PH_END
            PH_BEGIN {
                const size_t wo = l == 0 ? (f == 0 ? WS_WOUT00 : WS_WOUT01) : (f == 0 ? WS_WOUT10 : WS_WOUT11);
                pg8::Gemm g{HID, (const bf16*)(ws + wo), MT, DM, DFF, DFF, MK_BLK, MK_BLK}; ResOrder S;
#if MK_NFOLD == 2 && MK_HBF && MK_TQ
                S.init(MT, DM, F.G, MK_CID);
#else
                S.init(DFF, F.G, MK_CID);
#endif
                const bool first = (l + f == 0);
#if MK_NFOLD == 2 && MK_HBF
                const bool lastg = (l == 1 && f == 1);
                EpiResid3 E{lastg ? hres : nullptr, DM, 0.5f, (float*)(ws + WS_PART), DM, first ? args.in[I_XP] : nullptr, first ? args.in[I_XS] : nullptr,
                            XN, lastg ? nullptr : SSQH(l == 0 ? (f == 0 ? 1 : 3) : 4), (LAS float*)(F.lds + LDSCTL_OFF + 1024)};
#elif MK_NFOLD == 2
                const bool lastg = (l == 1 && f == 1);
                EpiResid2 E{hres, DM, 0.5f, (float*)(ws + WS_PART), DM, first ? args.in[I_XP] : hres, first ? args.in[I_XS] : hres + (size_t)MP * DM,
                            lastg ? nullptr : XN, lastg ? nullptr : SSQH(l == 0 ? (f == 0 ? 1 : 3) : 4), (unsigned*)(ws + WS_FIXCNT) + (l * 2 + f) * 64, (LAS float*)(F.lds + LDSCTL_OFF + 1024)};
#else
                EpiResid E{hres, DM, args.dry ? 0.f : 0.5f, (float*)(ws + WS_PART), DM, first ? args.in[I_XP] : hres, first ? args.in[I_XS] : hres + (size_t)MP * DM};
#endif
                if (MK_STAGGER && ((blockIdx.x >> 3) & 3)) { const unsigned long long t0_ = wall_clock64(), d_ = (unsigned long long)(((blockIdx.x >> 3) & 3) * MK_STAGGER); while (wall_clock64() - t0_ < d_) __builtin_amdgcn_s_sleep(4); }
                pg8::gemm_phase<EpiRes, ResOrder, true, MK_SP2, RES_TQ>(F.lds + RING_OFF, g, S, E, F.tid); } PH_END
            if (MK_NFOLD == 2 && !RES_TQ && !(l == 1 && f == 1)) { PH_BEGIN
                if (MK_HBF) tail_fix_phase_b(F, XN, nullptr, (const float*)(ws + WS_PART), DM, (l + f == 0) ? args.in[I_XS] : nullptr, SSQH(l == 0 ? (f == 0 ? 1 : 3) : 4));
                else tail_fix_phase(F, hres, XN, (const float*)(ws + WS_PART), DM, (l + f == 0) ? args.in[I_XS] : nullptr, SSQH(l == 0 ? (f == 0 ? 1 : 3) : 4)); PH_END }
            if (f == 0) {
                if (MK_NFOLD < 2) { PH_BEGIN norm_phase(F, hres, args.in[I_MIXN] + l * DM, XN, (const float*)(ws + WS_PART), DM, args.dry, l == 0 ? args.in[I_XS] : nullptr, MK_NFOLD ? SSQH(l == 0 ? 1 : 4) : nullptr); PH_END }
                if (l == 0) {
                    PH_BEGIN {
                        pg8::Gemm g{XN, (const bf16*)(ws + WS_WRIN), MT, RIN, DM, DM, 0, 0}; FfnInOrder S; S.init(MT, RIN, F.G, MK_CID); S.xt = MK_XTAIL && MK_DEFER == 2;
                        EpiRet E{QKVG, RIN, (const float*)(ws + WS_COSR), (const float*)(ws + WS_SINR), MK_NFOLD ? SSQH(1) : nullptr, F.lds + RING_OFF};
                        pg8::gemm_phase<EpiRet, FfnInOrder, true, MK_SP2>(F.lds + RING_OFF, g, S, E, F.tid);
                        conv_deferred(args, F, 1); } PH_END
                    PH_BEGIN
#ifndef DIS_SCAN
 scan_phase2(args, F);
#endif
 PH_END
                    PH_BEGIN gn_gate_phase(args, F); PH_END
                    PH_BEGIN {
                        pg8::Gemm g{QKVG + 4096, (const bf16*)(ws + WS_WROUT), MT, DM, RHV, RIN, 0, 0}; ResOrder S;
#if MK_NFOLD == 2 && MK_HBF && MK_TQ
                        S.init(MT, DM, F.G, MK_CID);
#else
                        S.init(RHV, F.G, MK_CID);
#endif
#if MK_NFOLD == 2 && MK_HBF
                        EpiResid3 E{nullptr, DM, 1.0f, (float*)(ws + WS_BIG), RIN / 2, nullptr, nullptr, XN, SSQH(2), (LAS float*)(F.lds + LDSCTL_OFF + 1024)};
#elif MK_NFOLD == 2
                        EpiResid2 E{hres, DM, 1.0f, (float*)(ws + WS_BIG), RIN / 2, hres, hres + (size_t)MP * DM, XN, SSQH(2), (unsigned*)(ws + WS_FIXCNT) + 4 * 64, (LAS float*)(F.lds + LDSCTL_OFF + 1024)};
#else
                        EpiResid E{hres, DM, args.dry ? 0.f : 1.0f, (float*)(ws + WS_BIG), RIN / 2, hres, hres + (size_t)MP * DM};
#endif
                        if (MK_STAGGER && ((blockIdx.x >> 3) & 3)) { const unsigned long long t0_ = wall_clock64(), d_ = (unsigned long long)(((blockIdx.x >> 3) & 3) * MK_STAGGER); while (wall_clock64() - t0_ < d_) __builtin_amdgcn_s_sleep(4); }
                pg8::gemm_phase<EpiRes, ResOrder, true, MK_SP2, RES_TQ>(F.lds + RING_OFF, g, S, E, F.tid); } PH_END
                    if (MK_NFOLD == 2 && !RES_TQ) { PH_BEGIN if (MK_HBF) tail_fix_phase_b(F, XN, nullptr, (const float*)(ws + WS_BIG), RIN / 2, nullptr, SSQH(2)); else tail_fix_phase(F, hres, XN, (const float*)(ws + WS_BIG), RIN / 2, nullptr, SSQH(2)); PH_END }
                } else {
#if MK_QLFUSE
                    PH_BEGIN {
                        pg8::Gemm g{XN, (const bf16*)(ws + WS_WDQ), MT, QLR, DM, DM, 0, 0}; SO S; S.init(MT, QLR, F.G, MK_CID); S.xt = MK_XTAIL && MK_DEFER == 2;
                        EpiQlat E{(bf16*)(ws + WS_QLN), QLR, (float*)(ws + WS_QSSQ), (LAS float*)(F.lds + LDSCTL_OFF + 1024), MK_NFOLD ? SSQH(4) : nullptr, F.lds + RING_OFF};
                        pg8::gemm_phase<EpiQlat, SO, true, MK_SP2>(F.lds + RING_OFF, g, S, E, F.tid);
                        conv_deferred(args, F, 4); } PH_END
#else
                    PH_BEGIN {
                        pg8::Gemm g{XN, (const bf16*)(ws + WS_WDQ), MT, QLR, DM, DM, 0, 0}; SO S; S.init(MT, QLR, F.G, MK_CID);
                        EpiF32 E{(float*)(ws + WS_SMALL), QLR};
                        pg8::gemm_phase<EpiF32, SO, true, MK_SP2>(F.lds + RING_OFF, g, S, E, F.tid); } PH_END
                    PH_BEGIN qlat_norm_phase(args, F); PH_END
#endif
                    PH_BEGIN {
                        if (MK_STAGKV && ((blockIdx.x >> 3) & 1)) { const unsigned long long t0_ = wall_clock64(); while (wall_clock64() - t0_ < (unsigned long long)MK_STAGKV) __builtin_amdgcn_s_sleep(4); }
                        { pg8::Gemm g{(const bf16*)(ws + WS_QLN), (const bf16*)(ws + WS_WUQ), MT, QW, QLR, QLR, 0, 0}; SO S; S.init(MT, QW, F.G, MK_CID);
#if MK_QLFUSE
                          EpiQraw E{(bf16*)(ws + WS_Q), QW, (const float*)(ws + WS_QSSQ)};
                          pg8::gemm_phase<EpiQraw, SO, true, MK_SP2>(F.lds + RING_OFF, g, S, E, F.tid); }
#else
                          EpiBf16 E{(bf16*)(ws + WS_Q), QW};
                          pg8::gemm_phase<EpiBf16, SO, true, MK_SP2>(F.lds + RING_OFF, g, S, E, F.tid); }
#endif
                        { pg8::Gemm g{(const bf16*)(ws + WS_CALL), (const bf16*)(ws + WS_WUKV), KVROWS, KVW, KVL, KVL, 0, 0}; SO S; S.init(KVROWS, KVW, F.G, (MK_CID + (F.G == 256 ? 160 : 0)) % F.G);
                          EpiKV E{(bf16*)(ws + WS_BIG), KVW, (float*)(ws + WS_RS), (const float*)(ws + WS_SSQKR), (LAS float*)(F.lds + LDSCTL_OFF + 1024)};
                          pg8::gemm_phase<EpiKV, SO, true, MK_SP2>(F.lds + RING_OFF, g, S, E, F.tid); } } PH_END
                    if (!MK_QFUSE) { PH_BEGIN qfin_phase(args, F); PH_END }
                    PH_BEGIN
#ifndef DIS_ATTN
 attn_phase(args, F);
#endif
 PH_END
                    PH_BEGIN {
                        pg8::Gemm g{(const bf16*)(ws + WS_O), (const bf16*)(ws + WS_WO), MT, DM, DM, DM, 0, 0}; ResOrder S;
#if MK_NFOLD == 2 && MK_HBF && MK_TQ
                        S.init(MT, DM, F.G, MK_CID);
#else
                        S.init(DM, F.G, MK_CID);
#endif
#if MK_NFOLD == 2 && MK_HBF
                        EpiResid3 E{nullptr, DM, 1.0f, (float*)(ws + WS_BIG), DM, nullptr, nullptr, XN, SSQH(5), (LAS float*)(F.lds + LDSCTL_OFF + 1024)};
#elif MK_NFOLD == 2
                        EpiResid2 E{hres, DM, 1.0f, (float*)(ws + WS_BIG), DM, hres, hres + (size_t)MP * DM, XN, SSQH(5), (unsigned*)(ws + WS_FIXCNT) + 5 * 64, (LAS float*)(F.lds + LDSCTL_OFF + 1024)};
#else
                        EpiResid E{hres, DM, args.dry ? 0.f : 1.0f, (float*)(ws + WS_BIG), DM, hres, hres + (size_t)MP * DM};
#endif
                        if (MK_STAGGER && ((blockIdx.x >> 3) & 3)) { const unsigned long long t0_ = wall_clock64(), d_ = (unsigned long long)(((blockIdx.x >> 3) & 3) * MK_STAGGER); while (wall_clock64() - t0_ < d_) __builtin_amdgcn_s_sleep(4); }
                pg8::gemm_phase<EpiRes, ResOrder, true, MK_SP2, RES_TQ>(F.lds + RING_OFF, g, S, E, F.tid); } PH_END
                    if (MK_NFOLD == 2 && !RES_TQ) { PH_BEGIN if (MK_HBF) tail_fix_phase_b(F, XN, nullptr, (const float*)(ws + WS_BIG), DM, nullptr, SSQH(5)); else tail_fix_phase(F, hres, XN, (const float*)(ws + WS_BIG), DM, nullptr, SSQH(5)); PH_END }
                }
            }
        }
        if (l == 0) {
            if (MK_NFOLD < 2) { PH_BEGIN norm_phase(F, hres, args.in[I_KVN], XN, (const float*)(ws + WS_PART), DM, args.dry, nullptr, MK_NFOLD ? SSQH(3) : nullptr); PH_END }
            PH_BEGIN {
                pg8::Gemm g{XN, (const bf16*)(ws + WS_WDKV), MT, DKVP, DM, DM, 0, 0}; SO S; S.init(MT, DKVP, F.G, MK_CID);
                EpiF32 E{(float*)(ws + WS_SMALL), DKVP};
                pg8::gemm_phase<EpiF32, SO, true, MK_SP2>(F.lds + RING_OFF, g, S, E, F.tid);
                if (MK_DEFCACHE && F.G == 256 && blockIdx.x >= 216) cache_rows<8>(args, F, ((int)blockIdx.x - 216) * NWAVES + F.wave, 40 * NWAVES); } PH_END
            PH_BEGIN latent_phase(args, F); PH_END
        }
    }
    if (!RES_TQ) { PH_BEGIN if (MK_NFOLD == 2 && MK_HBF) tail_fix_phase_b(F, XN, hres, (const float*)(ws + WS_PART), DM, nullptr, nullptr); else fixup_phase(F, hres, (const float*)(ws + WS_PART), DM, args.dry); PH_END }
#undef PH_BEGIN
#undef PH_END
    if (MK_SPINEND && MK_SPINMASK && blockIdx.x == 0) { if (wave0 == 0 && lane_id_asm() == 0) { const unsigned long long d_ = *(volatile LAS unsigned long long*)(F0.lds + MISC_OFF + 120) * MK_SPINMUL, t1_ = wall_clock64(); while (wall_clock64() - t1_ < d_) __builtin_amdgcn_s_sleep(8); } __syncthreads(); }
    if (MK_BARWAIT && blockIdx.x == MK_BARWAIT_BLK) { if (threadIdx.x == 0) { const unsigned long long d_ = *(volatile LAS unsigned long long*)(F0.lds + MISC_OFF + 104) * MK_SPINMUL, t1_ = wall_clock64(); while (wall_clock64() - t1_ < d_) __builtin_amdgcn_s_sleep(8); } __syncthreads(); }
    if (MK_CLKPH >= 0 && blockIdx.x == 0 && threadIdx.x == 0) args.out[0] = *(volatile LAS float*)(F0.lds + MISC_OFF + 88);
}
constexpr int N_PHASES = 1 + (2 + 1 + 4 + 3 + 3) + (2 + 1 + 6 + 3) + 1 - (MK_QFUSE ? 1 : 0) - (MK_QLFUSE ? 1 : 0)  - ((MK_NFOLD == 2 && MK_HBF && MK_TQ) ? 6 : 0);

#if defined(MK_DEBUG)
constexpr size_t WS_DBG = 985 * MiB;
constexpr size_t WS_DBG_VS = WS_DBG, WS_DBG_VP = WS_DBG + 16 * MiB, WS_DBG_EY = WS_DBG + 20 * MiB, WS_DBG_H = WS_DBG + 21 * MiB, WS_DBG_Q = WS_DBG + 22 * MiB;
constexpr int DBG_ACC = 8192;
__device__ __forceinline__ float dbf(const bf16* p, size_t i) { return __uint_as_float((unsigned)p[i] << 16); }
__device__ __forceinline__ void dacc(unsigned char* ws, int k, float got, float exp) { float* a = (float*)(ws + WS_CTL) + DBG_ACC; atomicAdd(&a[2 * k], (got - exp) * (got - exp)); atomicAdd(&a[2 * k + 1], exp * exp); }
__device__ __forceinline__ unsigned dhash(unsigned x) { x ^= x >> 16; x *= 0x7feb352dU; x ^= x >> 15; x *= 0x846ca68bU; x ^= x >> 16; return x; }
__device__ __forceinline__ float dsilu(float a) { return a / (1.0f + __builtin_amdgcn_exp2f(-1.4426950408889634f * a)); }
__device__ __forceinline__ void dsincos(int pos, int j, int half, float& sn, float& cs) { const float inv = __builtin_amdgcn_exp2f(-(float)j / (float)half * 13.287712379549449f); sincos_d((double)pos * (double)inv, sn, cs); }
__device__ __forceinline__ int dpos(int tok) { return tok < MP ? (tok & (SEQ - 1)) : PAST + (tok & 63); }
__device__ __forceinline__ float dgamma_lg2(int h) { return lg2gamma(h); }

__global__ void dbg_k0(Args A) { const int s = blockIdx.x * blockDim.x + threadIdx.x; unsigned char* ws = A.ws;
    const int row = dhash(s) % MT, j = dhash(s + 77777) % DFF; const bf16* XN = (const bf16*)(ws + WS_XN); const float* W = A.in[I_F1IN];
    float a = 0.f, b = 0.f; for (int k = 0; k < DM; ++k) { const float x = dbf(XN, (size_t)row * DM + k); a += x * W[(size_t)k * 2 * DFF + j]; b += x * W[(size_t)k * 2 * DFF + DFF + j]; }
    dacc(ws, 0, dbf((const bf16*)(ws + WS_BIG), (size_t)row * DFF + j), dsilu(a) * b); }
__global__ void dbg_k1(Args A) { const int s = blockIdx.x * blockDim.x + threadIdx.x; unsigned char* ws = A.ws;
    const int row = dhash(s) % MT, c = dhash(s + 1234567) % DM; const bf16* HID = (const bf16*)(ws + WS_BIG); const float* W = A.in[I_F1OUT];
    float a = 0.f; for (int k = 0; k < DFF; ++k) a += dbf(HID, (size_t)row * DFF + k) * W[(size_t)k * DM + c];
    const float x = row < MP ? A.in[I_XP][(size_t)row * DM + c] : A.in[I_XS][(size_t)(row - MP) * DM + c];
    dacc(ws, 1, A.out[(size_t)row * DM + c] - x, 0.5f * a); }
__global__ void dbg_k2(Args A) { const int s = blockIdx.x * blockDim.x + threadIdx.x; unsigned char* ws = A.ws;
    const bf16* XN = (const bf16*)(ws + WS_XN); const bf16* QK = (const bf16*)(ws + WS_BIG); const float* W = A.in[I_RIN];
    const int row = dhash(s) % MT, col = dhash(s + 424242) % RIN; float exp;
    if (col < 4096) { const int h = (col >> 8) & 7, d = col & 255, j = d & 127, c1 = (col & ~255) + j, c2 = c1 + 128; float x1 = 0.f, x2 = 0.f;
        for (int k = 0; k < DM; ++k) { const float x = dbf(XN, (size_t)row * DM + k); x1 += x * W[(size_t)k * RIN + c1]; x2 += x * W[(size_t)k * RIN + c2]; }
        float sn, cs; dsincos(dpos(row), j, 128, sn, cs);
        const float r = d < 128 ? x1 * cs - x2 * sn : x1 * sn + x2 * cs; const float e = (float)((row & 63) + 1) * dgamma_lg2(h);
        exp = col < 2048 ? r * __builtin_amdgcn_exp2f(e) * 0.0625f : r * __builtin_amdgcn_exp2f(-e);
    } else { float a = 0.f; for (int k = 0; k < DM; ++k) a += dbf(XN, (size_t)row * DM + k) * W[(size_t)k * RIN + col]; exp = col < 8192 ? a : dsilu(a); }
    dacc(ws, 2, dbf(QK, (size_t)row * RIN + col), exp); }
__global__ void dbg_snapv(Args A) { unsigned char* ws = A.ws; const bf16* QK = (const bf16*)(ws + WS_BIG);
    for (size_t i = (size_t)blockIdx.x * blockDim.x + threadIdx.x; i < (size_t)MS * 4096; i += (size_t)gridDim.x * blockDim.x) { const size_t r = i >> 12, c = i & 4095; ((bf16*)(ws + WS_DBG_VS))[i] = QK[(MP + r) * RIN + 4096 + c]; }
    for (size_t i = (size_t)blockIdx.x * blockDim.x + threadIdx.x; i < (size_t)NBP * 64 * 4096; i += (size_t)gridDim.x * blockDim.x) { const size_t r = i >> 12, c = i & 4095, b = r >> 6, t = r & 63; ((bf16*)(ws + WS_DBG_VP))[i] = QK[(b * SEQ + t) * RIN + 4096 + c]; } }
__global__ void dbg_k3(Args A) { const int s = blockIdx.x * blockDim.x + threadIdx.x; unsigned char* ws = A.ws; const bf16* QK = (const bf16*)(ws + WS_BIG);
    const bool smp = (s & 1) != 0; const int h = dhash(s) & 7, dv = dhash(s + 999) & 511, t = dhash(s + 5555) & 63;
    const int b = smp ? (dhash(s + 31337) & 31) : (dhash(s + 31337) & 7); const size_t tok0 = smp ? (size_t)MP + b * 64 : (size_t)b * SEQ;
    const bf16* V = smp ? (const bf16*)(ws + WS_DBG_VS) + (size_t)b * 64 * 4096 : (const bf16*)(ws + WS_DBG_VP) + (size_t)b * 64 * 4096;
    float o = 0.f;
    for (int sidx = 0; sidx <= t; ++sidx) { float qk = 0.f; for (int d = 0; d < 256; ++d) qk += dbf(QK, (tok0 + t) * RIN + h * 256 + d) * dbf(QK, (tok0 + sidx) * RIN + 2048 + h * 256 + d);
        o += qk * dbf(V, (size_t)sidx * 4096 + h * 512 + dv); }
    if (smp) { const float* S = A.in[I_STATE] + (size_t)(b * RH + h) * RDK * RDV; for (int d = 0; d < 256; ++d) o += dbf(QK, (tok0 + t) * RIN + h * 256 + d) * S[(size_t)d * RDV + dv]; }
    dacc(ws, 3, dbf(QK, (tok0 + t) * RIN + 4096 + h * 512 + dv), o);
    if (smp) { const int dk = dhash(s + 2222) & 255; const float* S = A.in[I_STATE] + (size_t)(b * RH + h) * RDK * RDV; float u = S[(size_t)dk * RDV + dv];
        for (int sidx = 0; sidx < 64; ++sidx) u += dbf(QK, (tok0 + sidx) * RIN + 2048 + h * 256 + dk) * dbf(V, (size_t)sidx * 4096 + h * 512 + dv);
        u *= __builtin_amdgcn_exp2f(64.0f * dgamma_lg2(h)); dacc(ws, 3, A.out[OUT_RETS + (size_t)(b * RH + h) * RDK * RDV + (size_t)dk * RDV + dv], u); }
    { const int pidx = smp ? 64 + b * 8 + h : b * 8 + h; const int s2 = dhash(s + 4444) & 63; float qk = 0.f;
      for (int d = 0; d < 256; ++d) qk += dbf(QK, (tok0 + t) * RIN + h * 256 + d) * dbf(QK, (tok0 + s2) * RIN + 2048 + h * 256 + d);
      dacc(ws, 3, dbf((const bf16*)(ws + WS_DBG + 24 * MiB), (size_t)pidx * 4096 + t * 64 + s2), s2 <= t ? qk : 0.f); }
    { float mu = 0.f; for (int d = 0; d < 512; ++d) mu += dbf(QK, (tok0 + t) * RIN + 4096 + h * 512 + d); mu *= (1.0f / 512); float var = 0.f;
      for (int d = 0; d < 512; ++d) { const float x = dbf(QK, (tok0 + t) * RIN + 4096 + h * 512 + d) - mu; var += x * x; } var *= (1.0f / 512);
      const float y = dbf(QK, (tok0 + t) * RIN + 8192 + h * 512 + dv) * ((dbf(QK, (tok0 + t) * RIN + 4096 + h * 512 + dv) - mu) * __builtin_amdgcn_rsqf(var + EPS) * A.in[I_RGN][h * 512 + dv]);
      ((float*)(ws + WS_DBG_EY))[s] = y; } }
__global__ void dbg_k4(Args A) { const int s = blockIdx.x * blockDim.x + threadIdx.x; unsigned char* ws = A.ws; const bf16* QK = (const bf16*)(ws + WS_BIG);
    const bool smp = (s & 1) != 0; const int h = dhash(s) & 7, dv = dhash(s + 999) & 511, t = dhash(s + 5555) & 63;
    const int b = smp ? (dhash(s + 31337) & 31) : (dhash(s + 31337) & 7); const size_t tok0 = smp ? (size_t)MP + b * 64 : (size_t)b * SEQ;
    dacc(ws, 4, dbf(QK, (tok0 + t) * RIN + 4096 + h * 512 + dv), ((const float*)(ws + WS_DBG_EY))[s]);
    const int row = dhash(s + 10101) % MT, c = dhash(s + 20202) % DM; ((float*)(ws + WS_DBG_H))[s] = A.out[(size_t)row * DM + c]; }
__global__ void dbg_k5(Args A) { const int s = blockIdx.x * blockDim.x + threadIdx.x; unsigned char* ws = A.ws; const bf16* QK = (const bf16*)(ws + WS_BIG);
    const int row = dhash(s + 10101) % MT, c = dhash(s + 20202) % DM; const float* W = A.in[I_ROUT]; float a = 0.f;
    for (int k = 0; k < RHV; ++k) a += dbf(QK, (size_t)row * RIN + 4096 + k) * W[(size_t)k * DM + c];
    dacc(ws, 5, A.out[(size_t)row * DM + c] - ((const float*)(ws + WS_DBG_H))[s], a); }
__global__ void dbg_k6a(Args A) { const int s = blockIdx.x * blockDim.x + threadIdx.x; unsigned char* ws = A.ws; const bf16* XN = (const bf16*)(ws + WS_XN);
    const float* CKR = (const float*)(ws + WS_SMALL); const int row = dhash(s) % MT, c = dhash(s + 4321) % (KVL + ROPE); const float* W = A.in[I_WDKV];
    float a = 0.f; for (int k = 0; k < DM; ++k) a += dbf(XN, (size_t)row * DM + k) * W[(size_t)k * (KVL + ROPE) + c];
    dacc(ws, 6, CKR[(size_t)row * DKVP + c], a); }
__global__ void dbg_k6(Args A) { const int s = blockIdx.x * blockDim.x + threadIdx.x; unsigned char* ws = A.ws;
    const float* CKR = (const float*)(ws + WS_SMALL); const int row = dhash(s) % MT, c = dhash(s + 4321) % (KVL + ROPE);
    const float* r = CKR + (size_t)row * DKVP; float got, exp;
    if (c < KVL) { float ss = 0.f; for (int k = 0; k < KVL; ++k) ss += r[k] * r[k]; exp = r[c] * __builtin_amdgcn_rsqf(ss / KVL + EPS) * A.in[I_KVLN][c];
        got = row < MP ? A.out[OUT_CKVP + (size_t)row * KVL + c] : A.out[OUT_CKVS + (size_t)(row - MP) * KVL + c];
        const int kvrow = row < MP ? row : MP + ((row - MP) >> 6) * KVT + PAST + (row & 63); dacc(ws, 6, dbf((const bf16*)(ws + WS_CALL), (size_t)kvrow * KVL + c), exp);
    } else { const int j = (c - KVL) & 31; const float x1 = r[KVL + j], x2 = r[KVL + 32 + j]; float sn, cs; dsincos(dpos(row), j, 32, sn, cs);
        exp = (c - KVL) < 32 ? x1 * cs - x2 * sn : x1 * sn + x2 * cs; got = row < MP ? A.out[OUT_KRP + (size_t)row * ROPE + (c - KVL)] : A.out[OUT_KRS + (size_t)(row - MP) * ROPE + (c - KVL)]; }
    dacc(ws, 6, got, exp); }
__global__ void dbg_k7(Args A) { const int s = blockIdx.x * blockDim.x + threadIdx.x; unsigned char* ws = A.ws;
    { const bf16* QLN = (const bf16*)(ws + WS_QLN); const int row = dhash(s) % MT, c = dhash(s + 8888) % QW; const float* W = A.in[I_WUQ]; float a = 0.f;
      for (int k = 0; k < QLR; ++k) a += dbf(QLN, (size_t)row * QLR + k) * W[(size_t)k * QW + c];
      dacc(ws, 7, dbf((const bf16*)(ws + WS_Q), (size_t)row * QW + c), a); }
    { const bf16* CA = (const bf16*)(ws + WS_CALL); const int row = dhash(s + 99) % KVROWS, c = dhash(s + 7777) % KVW; const float* W = A.in[I_WUKV]; float a = 0.f;
      for (int k = 0; k < KVL; ++k) a += dbf(CA, (size_t)row * KVL + k) * W[(size_t)k * KVW + c];
      dacc(ws, 7, dbf((const bf16*)(ws + WS_BIG), (size_t)row * KVW + c), a); }
    { const int row = dhash(s + 606) % MT, hd = dhash(s + 707) & 15; for (int d = 0; d < QKH; ++d) ((bf16*)(ws + WS_DBG_Q))[(size_t)s * QKH + d] = ((const bf16*)(ws + WS_Q))[(size_t)row * QW + hd * QKH + d]; } }
__global__ void dbg_k8(Args A) { const int s = blockIdx.x * blockDim.x + threadIdx.x; unsigned char* ws = A.ws;
    { const int row = dhash(s + 606) % MT, hd = dhash(s + 707) & 15; const bf16* q = (const bf16*)(ws + WS_DBG_Q) + (size_t)s * QKH;
      float ss = 0.f; for (int d = 0; d < QKH; ++d) { float x;
          if (d < NOPE) x = dbf(q, d); else { const int j = (d - NOPE) & 31; const float x1 = dbf(q, NOPE + j), x2 = dbf(q, NOPE + 32 + j); float sn, cs; dsincos(dpos(row), j, 32, sn, cs);
              x = (d - NOPE) < 32 ? x1 * cs - x2 * sn : x1 * sn + x2 * cs; }
          ss += x * x; }
      const float rs = __builtin_amdgcn_rsqf(ss / QKH + EPS); const int d = dhash(s + 808) % QKH; float x;
      if (d < NOPE) x = dbf(q, d); else { const int j = (d - NOPE) & 31; const float x1 = dbf(q, NOPE + j), x2 = dbf(q, NOPE + 32 + j); float sn, cs; dsincos(dpos(row), j, 32, sn, cs);
          x = (d - NOPE) < 32 ? x1 * cs - x2 * sn : x1 * sn + x2 * cs; }
      dacc(ws, 8, dbf((const bf16*)(ws + WS_Q), (size_t)row * QW + hd * QKH + d), x * rs * A.in[I_QN][d] * A.in[I_KN][d] * 0.07216878364870322f * 1.4426950408889634f); }
    { const int row = dhash(s + 99) % KVROWS, hd = dhash(s + 555) & 15; const bf16* KVb = (const bf16*)(ws + WS_BIG); const bf16* KRb = (const bf16*)(ws + WS_KRALL); float ss = 0.f;
      for (int d = 0; d < NOPE; ++d) { const float x = dbf(KVb, (size_t)row * KVW + hd * 256 + d); ss += x * x; } for (int d = 0; d < ROPE; ++d) { const float x = dbf(KRb, (size_t)row * ROPE + d); ss += x * x; }
      dacc(ws, 8, ((const float*)(ws + WS_RS))[(size_t)row * MH + hd], __builtin_amdgcn_rsqf(ss / QKH + EPS)); } }
__global__ void dbg_k9(Args A) { const int s = blockIdx.x * blockDim.x + threadIdx.x; unsigned char* ws = A.ws;
    const bf16* Q = (const bf16*)(ws + WS_Q); const bf16* KVb = (const bf16*)(ws + WS_BIG); const bf16* KRb = (const bf16*)(ws + WS_KRALL); const float* RSs = (const float*)(ws + WS_RS);
    const int row = (s & 1) ? MP + (int)(dhash(s) % MS) : (int)(dhash(s) % MP); const int hd = dhash(s + 1111) & 15, d = dhash(s + 3333) & 127;
    int kv0, nk; if (row < MP) { const int b = row >> 11, t = row & 2047; kv0 = b * SEQ; nk = ((t >> 6) + 1) * 64; } else { const int b = (row - MP) >> 6; kv0 = MP + b * KVT; nk = KVT; }
    float m = -1e30f, l = 0.f, o = 0.f;
    for (int k = 0; k < nk; ++k) { float sc = 0.f; for (int e = 0; e < NOPE; ++e) sc += dbf(Q, (size_t)row * QW + hd * QKH + e) * dbf(KVb, (size_t)(kv0 + k) * KVW + hd * 256 + e);
        for (int e = 0; e < ROPE; ++e) sc += dbf(Q, (size_t)row * QW + hd * QKH + NOPE + e) * dbf(KRb, (size_t)(kv0 + k) * ROPE + e);
        sc *= RSs[(size_t)(kv0 + k) * MH + hd]; const float mn = fmaxf(m, sc), al = __builtin_amdgcn_exp2f(m - mn), p = __builtin_amdgcn_exp2f(sc - mn); l = l * al + p; o = o * al + p * dbf(KVb, (size_t)(kv0 + k) * KVW + hd * 256 + NOPE + d); m = mn; }
    dacc(ws, 9, dbf((const bf16*)(ws + WS_O), (size_t)row * DM + hd * VHD + d), o / l); }
__global__ void dbg_final(Args A) { if (threadIdx.x == 0 && blockIdx.x == 0) { const float* a = (const float*)(A.ws + WS_CTL) + DBG_ACC; unsigned bits = 0;
        for (int k = 0; k < 10; ++k) { const float e = a[2 * k], r = a[2 * k + 1]; if (!(e <= 2e-3f * r) || !(r > 0.f)) bits |= 1u << k; }
        float v = (float)(10 + (bits & 63)); for (unsigned i = 0; i < 2 + (bits >> 6); ++i) v *= 10.f; A.out[0] = v; } }
__global__ void dbg_stamp(Args A, int which) { if (threadIdx.x == 0 && blockIdx.x == 0) { ((unsigned long long*)(A.ws + WS_CTL))[4200 + which] = wall_clock64(); ((unsigned long long*)(A.ws + WS_CTL))[4210 + which] = clock64(); } }
__global__ void dbg_final_time(Args A) { if (threadIdx.x == 0 && blockIdx.x == 0) { const unsigned long long* t = (const unsigned long long*)(A.ws + WS_CTL) + 4200; const unsigned long long* c = t + 10; const float mhz = (float)(c[1] - c[0]) / (float)(t[1] - t[0]) * 100.0f; A.out[0] = 1000.0f * __builtin_floorf(mhz * (1.0f / 300.0f)); } }
#endif

extern "C" void kernel_launch(void* const* d_in, const int* in_sizes, int n_in, void* d_out, int out_size, void* d_ws, size_t ws_size, hipStream_t stream) {
    static int grid = 0;
    if (grid == 0) {
        if (n_in != 25 || out_size != (int)OUT_END || ws_size < WS_END) { fprintf(stderr, "kernel_launch: shape mismatch: n_in %d out %d ws %zu (need %zu)\n", n_in, out_size, ws_size, (size_t)WS_END); grid = -1; return; }
        int dev = 0, cus = 0, per_cu = 0;
        if (hipGetDevice(&dev) != hipSuccess || hipDeviceGetAttribute(&cus, hipDeviceAttributeMultiprocessorCount, dev) != hipSuccess) { grid = -1; return; }
        if (hipFuncSetAttribute((const void*)yoco_fwd, hipFuncAttributeMaxDynamicSharedMemorySize, LDS_BYTES) != hipSuccess) { fprintf(stderr, "kernel_launch: hipFuncSetAttribute failed\n"); grid = -1; return; }
        if (hipOccupancyMaxActiveBlocksPerMultiprocessor(&per_cu, (const void*)yoco_fwd, NWAVES * 64, LDS_BYTES) != hipSuccess || per_cu < 1) { fprintf(stderr, "kernel_launch: occupancy query says %d blocks per CU\n", per_cu); (void)hipGetLastError(); grid = -1; return; }
        grid = cus;
    }
    if (grid < 0) return;
    (void)hipMemsetAsync((char*)d_ws + WS_CTL, 0, CTL_ZERO_BYTES, stream);
    Args a{};
    for (int i = 0; i < 25; ++i) a.in[i] = (const float*)d_in[i];
    a.out = (float*)d_out; a.ws = (unsigned char*)d_ws;
    const int last = N_PHASES < MK_LAST_PHASE ? N_PHASES : MK_LAST_PHASE;
#if MK_ONE_LAUNCH
    a.ph_lo = 0; a.ph_hi = last;
    hipLaunchKernelGGL(yoco_fwd, dim3(grid), dim3(NWAVES * 64), LDS_BYTES, stream, a);
#if defined(MK_TWOPASS)
    (void)hipMemsetAsync((char*)d_ws + WS_CTL, 0, CTL_ZERO_BYTES, stream);
    a.dry = 1; hipLaunchKernelGGL(yoco_fwd, dim3(grid), dim3(NWAVES * 64), LDS_BYTES, stream, a);
#endif
#else
    for (int p = 0; p < last; ++p) { a.ph_lo = p; a.ph_hi = p + 1;
#if defined(MK_DEBUG) && defined(MK_TIMEP)
        if (p == MK_TIMEP) hipLaunchKernelGGL(dbg_stamp, dim3(1), dim3(64), 0, stream, a, 0);
#endif
        for (int rep = ((p == MK_REP || ((MK_REPMASK >> p) & 1u)) ? MK_REPN : 1); rep > 0; --rep) { a.dry = rep > 1 ? 1 : 0; hipLaunchKernelGGL(yoco_fwd, dim3(grid), dim3(NWAVES * 64), LDS_BYTES, stream, a); }
#if defined(MK_DEBUG) && defined(MK_TIMEP)
        if (p == MK_TIMEP) hipLaunchKernelGGL(dbg_stamp, dim3(1), dim3(64), 0, stream, a, 1);
        if (p == last - 1) hipLaunchKernelGGL(dbg_final_time, dim3(1), dim3(64), 0, stream, a);
        continue;
#endif
#if defined(MK_DEBUG)
        constexpr int NSB = 16;
        if (p == 1) hipLaunchKernelGGL(dbg_k0, dim3(NSB), dim3(256), 0, stream, a);
        if (p == 3) hipLaunchKernelGGL(dbg_k1, dim3(NSB), dim3(256), 0, stream, a);
        if (p == 4) { hipLaunchKernelGGL(dbg_k2, dim3(NSB), dim3(256), 0, stream, a); hipLaunchKernelGGL(dbg_snapv, dim3(1024), dim3(256), 0, stream, a); }
        if (p == 5) hipLaunchKernelGGL(dbg_k3, dim3(NSB), dim3(256), 0, stream, a);
        if (p == 6) hipLaunchKernelGGL(dbg_k4, dim3(NSB), dim3(256), 0, stream, a);
        if (p == 8) hipLaunchKernelGGL(dbg_k5, dim3(NSB), dim3(256), 0, stream, a);
        if (p == 12) hipLaunchKernelGGL(dbg_k6a, dim3(NSB), dim3(256), 0, stream, a);
        if (p == 13) hipLaunchKernelGGL(dbg_k6, dim3(NSB), dim3(256), 0, stream, a);
        if (p == 19) hipLaunchKernelGGL(dbg_k7, dim3(NSB), dim3(256), 0, stream, a);
        if (p == 20) hipLaunchKernelGGL(dbg_k8, dim3(NSB), dim3(256), 0, stream, a);
        if (p == 21) hipLaunchKernelGGL(dbg_k9, dim3(NSB), dim3(256), 0, stream, a);
        if (p == last - 1) hipLaunchKernelGGL(dbg_final, dim3(1), dim3(64), 0, stream, a);
#endif
    }
#endif
    const hipError_t le = hipPeekAtLastError();
    if (le != hipSuccess) fprintf(stderr, "kernel_launch: launch failed: %s\n", hipGetErrorName(le));
}
```
